# Optimizing an MI355X kernel written in HIP

```python
import math
import numpy as np
import jax
import jax.numpy as jnp
from jax import lax

D_MODEL = 1024
BATCH = 8
SEQ = 2048
DEPTH = 4

GRID_W = 64
CTX_LEN = 256
Q_BLOCK = 128
ROPE_THETA = 10000.0
NORM_EPS = 1e-6
NEG_INF = -1e30

MLA_HEADS = 4
MLA_NOPE = 64
MLA_ROPE = 32
MLA_V = 64
MLA_Q_RANK = 256
MLA_KV_RANK = 128
DIFF_HEADS = 4
DIFF_D = 32
NA_HEADS = 4
NA_D = 64
NA_ROWS = 8
NA_COLS = 16
NA_QCOLS = 16
NA_BAND = 2 * NA_COLS
GQA_HEADS = 4
GQA_KV_HEADS = 2
GQA_D = 64
D_FF = 2816
CONV_W = 3

MIX_SPLITS = (
    MLA_Q_RANK, MLA_KV_RANK, MLA_ROPE,
    DIFF_HEADS * 2 * DIFF_D, DIFF_HEADS * 2 * DIFF_D, DIFF_HEADS * 2 * DIFF_D,
    NA_HEADS * NA_D, NA_HEADS * NA_D, NA_HEADS * NA_D,
    GQA_HEADS * GQA_D, GQA_KV_HEADS * GQA_D, GQA_KV_HEADS * GQA_D,
)
IN_COLS = sum(MIX_SPLITS)
MIX_WIDTH = MLA_HEADS * MLA_V + DIFF_HEADS * 2 * DIFF_D + NA_HEADS * NA_D + GQA_HEADS * GQA_D

kernel_name = 'hybrid_parallel_head_dit_block'


def rmsnorm(x, g):
    xf = x.astype(jnp.float32)
    y = xf * lax.rsqrt(jnp.mean(xf * xf, axis=-1, keepdims=True) + NORM_EPS)
    return (y * g.astype(jnp.float32)).astype(x.dtype)


def modulate(x, g, shift, scale):
    return rmsnorm(x, g) * (1.0 + scale) + shift


def split_cols(p, sizes):
    idx = np.cumsum(np.array(sizes))[:-1].tolist()
    return jnp.split(p, idx, axis=-1)


def to_heads(t, h):
    b, n, _ = t.shape
    return t.reshape(b, n, h, -1).transpose(0, 2, 1, 3)


def from_heads(t):
    b, h, n, d = t.shape
    return t.transpose(0, 2, 1, 3).reshape(b, n, h * d)


def axial_rope_tables(n_tok, rot_dim):
    n_freq = rot_dim // 4
    inv = jnp.power(ROPE_THETA, -jnp.arange(n_freq, dtype=jnp.float32) / n_freq)
    t = jnp.arange(n_tok)
    row = (t // GRID_W).astype(jnp.float32)
    col = (t % GRID_W).astype(jnp.float32)
    ar = row[:, None] * inv
    ac = col[:, None] * inv
    ang = jnp.concatenate([ar, ar, ac, ac], axis=-1)
    return jnp.cos(ang), jnp.sin(ang)


def apply_axial_rope(x, cos, sin):
    a1, a2, b1, b2 = jnp.split(x, 4, axis=-1)
    rot = jnp.concatenate([-a2, a1, -b2, b1], axis=-1)
    return x * cos.astype(x.dtype) + rot * sin.astype(x.dtype)


def attend(q, k, v, scale):
    s = jnp.matmul(q, jnp.swapaxes(k, -1, -2)).astype(jnp.float32) * scale
    p = jax.nn.softmax(s, axis=-1)
    return jnp.matmul(p.astype(v.dtype), v)


def sweep_query_blocks(fn, *qs):
    n_tok = qs[0].shape[-2]
    nb = n_tok // Q_BLOCK

    def to_blocks(q):
        q = q.reshape(q.shape[:-2] + (nb, Q_BLOCK, q.shape[-1]))
        return jnp.moveaxis(q, -3, 0)

    out = lax.map(lambda blk: fn(*blk), tuple(to_blocks(q) for q in qs))
    out = jnp.moveaxis(out, 0, -3)
    return out.reshape(out.shape[:-3] + (n_tok, out.shape[-1]))


def mla_mixer(p_lat, p_ctx, q_a_g, w_uq, kv_a_g, w_ukv, q_g, k_g, cos, sin, with_ctx):
    scale = (MLA_NOPE + MLA_ROPE) ** -0.5

    def q_of(cq):
        q = to_heads(rmsnorm(cq, q_a_g) @ w_uq, MLA_HEADS)
        return rmsnorm(q, q_g)

    def kv_of(ckv, kr):
        kv = to_heads(rmsnorm(ckv, kv_a_g) @ w_ukv, MLA_HEADS)
        k_nope, v = kv[..., :MLA_NOPE], kv[..., MLA_NOPE:]
        kr = jnp.broadcast_to(kr[:, None], k_nope.shape[:-1] + (MLA_ROPE,))
        return rmsnorm(jnp.concatenate([k_nope, kr], axis=-1), k_g), v

    def rope_tail(t):
        return jnp.concatenate([t[..., :MLA_NOPE], apply_axial_rope(t[..., MLA_NOPE:], cos, sin)], axis=-1)

    cq_l, ckv_l, kr_l = p_lat
    cq_c, ckv_c, kr_c = p_ctx
    q_l = rope_tail(q_of(cq_l))
    k_l, v_l = kv_of(ckv_l, kr_l)
    k_l = rope_tail(k_l)
    k_c, v_c = kv_of(ckv_c, kr_c)
    k_all = jnp.concatenate([k_l, k_c], axis=2)
    v_all = jnp.concatenate([v_l, v_c], axis=2)
    o_l = sweep_query_blocks(lambda qb: attend(qb, k_all, v_all, scale), q_l)
    o_c = from_heads(attend(q_of(cq_c), k_c, v_c, scale)) if with_ctx else None
    return from_heads(o_l), o_c


def diff_mixer(p_lat, p_ctx, q_g, k_g, lq1, lk1, lq2, lk2, subln_g, lambda_init, cos, sin, with_ctx):
    scale = DIFF_D ** -0.5
    lq1f, lk1f = lq1.astype(jnp.float32), lk1.astype(jnp.float32)
    lq2f, lk2f = lq2.astype(jnp.float32), lk2.astype(jnp.float32)
    lam = jnp.exp(jnp.sum(lq1f * lk1f)) - jnp.exp(jnp.sum(lq2f * lk2f)) + lambda_init

    def pair(t, g):
        b, n, _ = t.shape
        t = rmsnorm(t.reshape(b, n, DIFF_HEADS, 2, DIFF_D), g).transpose(3, 0, 2, 1, 4)
        return t[0], t[1]

    def diff_attend(q1, q2, k1, k2, v):
        s1 = jnp.matmul(q1, jnp.swapaxes(k1, -1, -2)).astype(jnp.float32) * scale
        s2 = jnp.matmul(q2, jnp.swapaxes(k2, -1, -2)).astype(jnp.float32) * scale
        w = jax.nn.softmax(s1, axis=-1) - lam * jax.nn.softmax(s2, axis=-1)
        return jnp.matmul(w.astype(v.dtype), v)

    def finish(o):
        return from_heads(rmsnorm(o, subln_g) * (1.0 - lambda_init))

    q_l, k_l, v_l = p_lat
    q_c, k_c, v_c = p_ctx
    q1l, q2l = pair(q_l, q_g)
    k1l, k2l = pair(k_l, k_g)
    q1l, q2l = apply_axial_rope(q1l, cos, sin), apply_axial_rope(q2l, cos, sin)
    k1l, k2l = apply_axial_rope(k1l, cos, sin), apply_axial_rope(k2l, cos, sin)
    k1c, k2c = pair(k_c, k_g)
    vl = to_heads(v_l, DIFF_HEADS)
    vc = to_heads(v_c, DIFF_HEADS)
    k1a = jnp.concatenate([k1l, k1c], axis=2)
    k2a = jnp.concatenate([k2l, k2c], axis=2)
    va = jnp.concatenate([vl, vc], axis=2)
    o_l = sweep_query_blocks(lambda a, b: diff_attend(a, b, k1a, k2a, va), q1l, q2l)
    if with_ctx:
        q1c, q2c = pair(q_c, q_g)
        o_c = finish(diff_attend(q1c, q2c, k1c, k2c, vc))
    else:
        o_c = None
    return finish(o_l), o_c


def na_mixer(p_lat, p_ctx, q_g, k_g, rpb, with_ctx):
    scale = NA_D ** -0.5
    q_l, k_l, v_l = [to_heads(t, NA_HEADS) for t in p_lat]
    q_c, k_c, v_c = [to_heads(t, NA_HEADS) for t in p_ctx]
    q_l, k_l = rmsnorm(q_l, q_g), rmsnorm(k_l, k_g)
    q_c, k_c = rmsnorm(q_c, q_g), rmsnorm(k_c, k_g)
    b, h, n_tok, d = q_l.shape
    rows = n_tok // GRID_W
    wr = min(NA_ROWS, rows)
    ncb = GRID_W // NA_QCOLS
    n_loc = wr * NA_BAND

    r = jnp.arange(rows)
    row_start = jnp.clip(r - wr // 2, 0, rows - wr)
    row_idx = row_start[:, None] + jnp.arange(wr)
    qcol = jnp.arange(ncb)[:, None] * NA_QCOLS + jnp.arange(NA_QCOLS)
    band_start = jnp.clip(jnp.arange(ncb) * NA_QCOLS - NA_COLS // 2, 0, GRID_W - NA_BAND)
    col_idx = band_start[:, None] + jnp.arange(NA_BAND)
    win_start = jnp.clip(qcol - NA_COLS // 2, 0, GRID_W - NA_COLS)
    valid = (col_idx[:, None, :] >= win_start[..., None]) & (col_idx[:, None, :] < win_start[..., None] + NA_COLS)
    valid = jnp.broadcast_to(valid[:, :, None, :], (ncb, NA_QCOLS, wr, NA_BAND)).reshape(ncb, NA_QCOLS, n_loc)
    row_off = row_idx - r[:, None] + (NA_ROWS - 1)
    col_off = jnp.clip(col_idx[:, None, :] - qcol[..., None] + (NA_COLS - 1), 0, 2 * NA_COLS - 2)
    bias = rpb[:, row_off[:, None, None, :, None], col_off[None, :, :, None, :]]
    bias = bias.reshape(h, rows, ncb, NA_QCOLS, n_loc).astype(jnp.float32)

    def band(t):
        g = t.reshape(b, h, rows, GRID_W, d)[:, :, row_idx[:, None, :, None], col_idx[None, :, None, :]]
        return g.reshape(b, h, rows, ncb, n_loc, d)

    kb, vb = band(k_l), band(v_l)
    qb = q_l.reshape(b, h, rows, ncb, NA_QCOLS, d)
    s_loc = jnp.einsum('bhrjqd,bhrjkd->bhrjqk', qb, kb).astype(jnp.float32) * scale + bias[None]
    s_loc = jnp.where(valid, s_loc, NEG_INF)
    s_ctx = jnp.einsum('bhrjqd,bhcd->bhrjqc', qb, k_c).astype(jnp.float32) * scale
    p = jax.nn.softmax(jnp.concatenate([s_loc, s_ctx], axis=-1), axis=-1).astype(v_l.dtype)
    o = (jnp.einsum('bhrjqk,bhrjkd->bhrjqd', p[..., :n_loc], vb)
         + jnp.einsum('bhrjqc,bhcd->bhrjqd', p[..., n_loc:], v_c))
    o_l = from_heads(o.reshape(b, h, n_tok, d))
    o_c = from_heads(attend(q_c, k_c, v_c, scale)) if with_ctx else None
    return o_l, o_c


def gqa_mixer(p_lat, p_ctx, q_g, k_g, cos, sin, with_ctx):
    scale = GQA_D ** -0.5
    rep = GQA_HEADS // GQA_KV_HEADS

    def q_of(t):
        b, n, _ = t.shape
        q = rmsnorm(t.reshape(b, n, GQA_KV_HEADS, rep, GQA_D), q_g)
        return q.transpose(0, 2, 3, 1, 4)

    def k_of(t):
        return rmsnorm(to_heads(t, GQA_KV_HEADS), k_g)

    q_l, k_l, v_l = p_lat
    q_c, k_c, v_c = p_ctx
    ql = apply_axial_rope(q_of(q_l), cos, sin)
    kl = apply_axial_rope(k_of(k_l), cos, sin)[:, :, None]
    kc = k_of(k_c)[:, :, None]
    vl = to_heads(v_l, GQA_KV_HEADS)[:, :, None]
    vc = to_heads(v_c, GQA_KV_HEADS)[:, :, None]
    k_all = jnp.concatenate([kl, kc], axis=-2)
    v_all = jnp.concatenate([vl, vc], axis=-2)
    o = sweep_query_blocks(lambda qb: attend(qb, k_all, v_all, scale), ql)
    b, _, _, n_tok, d = o.shape
    o_l = from_heads(o.reshape(b, GQA_HEADS, n_tok, d))
    if with_ctx:
        oc = attend(q_of(q_c), kc, vc, scale)
        o_c = from_heads(oc.reshape(oc.shape[0], GQA_HEADS, oc.shape[3], d))
    else:
        o_c = None
    return o_l, o_c


def conv_ffn(h, w_up, conv_w, conv_b, w_down):
    u = h @ w_up
    n_tok = u.shape[1]
    pad = CONV_W // 2
    up = jnp.pad(u, ((0, 0), (pad, pad), (0, 0)))
    u = sum(up[:, i:i + n_tok] * conv_w[i] for i in range(CONV_W)) + conv_b
    a, g = jnp.split(u, 2, axis=-1)
    return (jax.nn.silu(g) * a) @ w_down


def setup_inputs(seed: int = 0) -> dict:
    key = jax.random.key(seed)
    ks = iter(jax.random.split(key, 40))
    L, D = DEPTH, D_MODEL

    def nrm(shape, s):
        return jax.random.normal(next(ks), shape, jnp.float32) * s

    def gain(shape):
        return 1.0 + nrm(shape, 0.05)

    return {
        'x': nrm((BATCH, SEQ, D), 1.0),
        'c': nrm((BATCH, D), 1.0),
        'ctx': nrm((BATCH, CTX_LEN, D), 1.0),
        'c_ctx': nrm((D,), 1.0),
        'w_mod': nrm((L, D, 6 * D), 0.5 * D ** -0.5),
        'b_mod': nrm((L, 6 * D), 0.01),
        'g_mix': gain((L, D)),
        'w_in': nrm((L, D, IN_COLS), D ** -0.5),
        'w_out': nrm((L, MIX_WIDTH, D), MIX_WIDTH ** -0.5),
        'mla_q_a_g': gain((L, MLA_Q_RANK)),
        'mla_w_uq': nrm((L, MLA_Q_RANK, MLA_HEADS * (MLA_NOPE + MLA_ROPE)), MLA_Q_RANK ** -0.5),
        'mla_kv_a_g': gain((L, MLA_KV_RANK)),
        'mla_w_ukv': nrm((L, MLA_KV_RANK, MLA_HEADS * (MLA_NOPE + MLA_V)), MLA_KV_RANK ** -0.5),
        'mla_q_g': gain((L, MLA_NOPE + MLA_ROPE)),
        'mla_k_g': gain((L, MLA_NOPE + MLA_ROPE)),
        'diff_q_g': gain((L, DIFF_D)),
        'diff_k_g': gain((L, DIFF_D)),
        'diff_lq1': nrm((L, DIFF_D), 0.1),
        'diff_lk1': nrm((L, DIFF_D), 0.1),
        'diff_lq2': nrm((L, DIFF_D), 0.1),
        'diff_lk2': nrm((L, DIFF_D), 0.1),
        'diff_subln_g': gain((L, 2 * DIFF_D)),
        'na_q_g': gain((L, NA_D)),
        'na_k_g': gain((L, NA_D)),
        'na_rpb': nrm((L, NA_HEADS, 2 * NA_ROWS - 1, 2 * NA_COLS - 1), 0.1),
        'gqa_q_g': gain((L, GQA_D)),
        'gqa_k_g': gain((L, GQA_D)),
        'g_ffn': gain((L, D)),
        'w_up': nrm((L, D, 2 * D_FF), D ** -0.5),
        'conv_w': nrm((L, CONV_W, 2 * D_FF), CONV_W ** -0.5),
        'conv_b': nrm((L, 2 * D_FF), 0.01),
        'w_down': nrm((L, D_FF, D), D_FF ** -0.5),
    }


def reference(x, c, ctx, c_ctx, w_mod, b_mod, g_mix, w_in, w_out,
              mla_q_a_g, mla_w_uq, mla_kv_a_g, mla_w_ukv, mla_q_g, mla_k_g,
              diff_q_g, diff_k_g, diff_lq1, diff_lk1, diff_lq2, diff_lk2, diff_subln_g,
              na_q_g, na_k_g, na_rpb, gqa_q_g, gqa_k_g,
              g_ffn, w_up, conv_w, conv_b, w_down):
    n_tok = x.shape[1]
    cos_a, sin_a = axial_rope_tables(n_tok, MLA_ROPE)
    cos_b, sin_b = axial_rope_tables(n_tok, DIFF_D)
    cos_d, sin_d = axial_rope_tables(n_tok, GQA_D)
    sc_lat = jax.nn.silu(c)
    sc_ctx = jax.nn.silu(c_ctx)
    for l in range(DEPTH):
        with_ctx = l < DEPTH - 1
        lambda_init = 0.8 - 0.6 * math.exp(-0.3 * l)
        m_lat = (sc_lat @ w_mod[l] + b_mod[l])[:, None, :]
        m_ctx = sc_ctx @ w_mod[l] + b_mod[l]
        sh1, s1, g1, sh2, s2, g2 = jnp.split(m_lat, 6, axis=-1)
        csh1, cs1, cg1, csh2, cs2, cg2 = jnp.split(m_ctx, 6, axis=-1)

        p_lat = split_cols(modulate(x, g_mix[l], sh1, s1) @ w_in[l], MIX_SPLITS)
        p_ctx = split_cols(modulate(ctx, g_mix[l], csh1, cs1) @ w_in[l], MIX_SPLITS)

        oa = mla_mixer(p_lat[0:3], p_ctx[0:3], mla_q_a_g[l], mla_w_uq[l], mla_kv_a_g[l], mla_w_ukv[l],
                       mla_q_g[l], mla_k_g[l], cos_a, sin_a, with_ctx)
        ob = diff_mixer(p_lat[3:6], p_ctx[3:6], diff_q_g[l], diff_k_g[l], diff_lq1[l], diff_lk1[l],
                        diff_lq2[l], diff_lk2[l], diff_subln_g[l], lambda_init, cos_b, sin_b, with_ctx)
        oc = na_mixer(p_lat[6:9], p_ctx[6:9], na_q_g[l], na_k_g[l], na_rpb[l], with_ctx)
        od = gqa_mixer(p_lat[9:12], p_ctx[9:12], gqa_q_g[l], gqa_k_g[l], cos_d, sin_d, with_ctx)

        mix_lat = jnp.concatenate([oa[0], ob[0], oc[0], od[0]], axis=-1) @ w_out[l]
        x = x + g1 * mix_lat
        x = x + g2 * conv_ffn(modulate(x, g_ffn[l], sh2, s2), w_up[l], conv_w[l], conv_b[l], w_down[l])
        if with_ctx:
            mix_ctx = jnp.concatenate([oa[1], ob[1], oc[1], od[1]], axis=-1) @ w_out[l]
            ctx = ctx + cg1 * mix_ctx
            ctx = ctx + cg2 * conv_ffn(modulate(ctx, g_ffn[l], csh2, cs2), w_up[l], conv_w[l], conv_b[l], w_down[l])
    return x
```

```cpp
#include <hip/hip_runtime.h>
#include <cstdio>
#include <cstdint>
__device__ __forceinline__ int otid(int wv) { int l; asm volatile("v_mbcnt_lo_u32_b32 %0, -1, 0\n\tv_mbcnt_hi_u32_b32 %0, -1, %0" : "=v"(l)); return wv * 64 + l; }
namespace pg8 {
#define PG8_LAS __attribute__((address_space(3)))
typedef unsigned short bf16_t;
typedef short bf16x8 __attribute__((ext_vector_type(8)));
typedef float f32x4 __attribute__((ext_vector_type(4)));
typedef unsigned u32x4 __attribute__((ext_vector_type(4)));
constexpr int BM = 256, BK = 64, HALF = 128, HTB = HALF * BK * 2  , STAGE_BYTES = 8 * HTB, NXCD = 8, WGM = 8;

__host__ __device__ __forceinline__ int lds_byte(int r, int c) { const int st = (r >> 4) * 2 + (c >> 5), rr = r & 15, cc = c & 31, ob = rr * 64 + cc * 2; return st * 1024 + (ob ^ (((ob >> 9) & 1) << 5)); }
__host__ __device__ __forceinline__ void stage_rc(int b, int& R, int& C) { const int st = b / 1024, sb = b % 1024, swz = sb ^ (((sb >> 9) & 1) << 5); R = (st >> 1) * 16 + swz / 64; C = (st & 1) * 32 + (swz % 64) / 2; }
__host__ __device__ __forceinline__ int perm32(int rho) { const int n = rho >> 4, i = rho & 15; return 8 * (i >> 2) + 4 * n + (i & 3); }

struct Unit { int pm, pn; };
struct Gemm { const bf16_t* A; const bf16_t* Bt; int M, N, K; };

struct StaticOrder {
    int nM, nN, nwg, G, c;
    __host__ __device__ void init(int M, int N, int G_, int c_) { nM = M / BM; nN = N / BM; nwg = nM * nN; G = G_; c = c_; }
    __host__ __device__ bool next(int i, Unit& u) const {
        const long L = (long)i * G + c; if (L >= nwg) return false;
        int wgid = (int)L; { const int q = nwg / NXCD, r = nwg % NXCD, xcd = wgid % NXCD, off = wgid / NXCD; wgid = (xcd < r ? xcd * (q + 1) : r * (q + 1) + (xcd - r) * q) + off; }
        const int nig = WGM * nN, gid = wgid / nig, fm = gid * WGM, gsz = (nM - fm) < WGM ? (nM - fm) : WGM;
        u.pm = fm + ((wgid % nig) % gsz); u.pn = (wgid % nig) / gsz; return true;
    }
    __device__ __forceinline__ void a_ready(const Unit&) const {}
    __device__ __forceinline__ void done(const Unit&) const {}
};

__device__ __forceinline__ unsigned cvt_pk_bf16(float lo, float hi) { unsigned r; asm volatile("v_cvt_pk_bf16_f32 %0, %1, %2" : "=v"(r) : "v"(lo), "v"(hi)); return r; }
typedef float f32x2 __attribute__((ext_vector_type(2)));
__device__ __forceinline__ f32x2 gelu_pk(f32x2 v) {
    const f32x2 av = __builtin_elementwise_abs(v), d = av * 0.2316418882f + 1.0f;
    f32x2 t; t.x = __builtin_amdgcn_rcpf(d.x); t.y = __builtin_amdgcn_rcpf(d.y);
    f32x2 q = t * 0.5307027145f + (-0.7265760135f); q = q * t + 0.7107068705f; q = q * t + (-0.142248368f); q = q * t + 0.127414796f; q = q * t;
    const f32x2 s = (v * v) * (-0.72134752044f);
    f32x2 e; e.x = __builtin_amdgcn_exp2f(s.x); e.y = __builtin_amdgcn_exp2f(s.y);
    const f32x2 m = v * (q * e), r = v - m;
    f32x2 o; o.x = v.x < 0.f ? m.x : r.x; o.y = v.y < 0.f ? m.y : r.y; return o;
}

template <int ACT  > struct EpiBf16 {
    static constexpr bool PERM = true, AFTER_DRAIN = false; static_assert(ACT == 0 || ACT == 1, "EpiBf16: ACT is 0 (none) or 1 (gelu_pk)");
    bf16_t* O; int ldc; const float* bias; int split_cols; size_t split_stride; float scale0;
    __device__ __forceinline__ void operator()(const f32x4 (&acc)[2][2][4][2], const Unit& u, int wr, int wc, int fr, int fq) const {
        const int row0 = u.pm * BM + wr * 64 + fr; int colt = u.pn * BM; bf16_t* base = O;
        float sc = 1.f; if (split_cols) { const int t = colt / split_cols; base += (size_t)t * split_stride; colt -= t * split_cols; if (t == 0) sc = scale0; }
        const int col0 = colt + wc * 32 + 8 * fq, bcol0 = u.pn * BM + wc * 32 + 8 * fq;
        f32x4 bv[2][2];
#pragma unroll
        for (int bj = 0; bj < 2; ++bj)
#pragma unroll
            for (int n = 0; n < 2; ++n) bv[bj][n] = bias ? *(const f32x4*)(bias + bcol0 + bj * HALF + 4 * n) : (f32x4){0.f, 0.f, 0.f, 0.f};
#pragma unroll
        for (int ai = 0; ai < 2; ++ai)
#pragma unroll
            for (int m = 0; m < 4; ++m) { bf16_t* rowp = base + (size_t)(row0 + ai * HALF + m * 16) * ldc + col0;
#pragma unroll
                for (int bj = 0; bj < 2; ++bj) { f32x4 v0 = acc[ai][bj][m][0] + bv[bj][0], v1 = acc[ai][bj][m][1] + bv[bj][1];
                    if (ACT == 1) { f32x2 a = gelu_pk((f32x2){v0[0], v0[1]}), b = gelu_pk((f32x2){v0[2], v0[3]}), c = gelu_pk((f32x2){v1[0], v1[1]}), d = gelu_pk((f32x2){v1[2], v1[3]});
                        v0 = (f32x4){a.x, a.y, b.x, b.y}; v1 = (f32x4){c.x, c.y, d.x, d.y}; }
                    v0 = v0 * sc; v1 = v1 * sc; u32x4 w; w.x = cvt_pk_bf16(v0[0], v0[1]); w.y = cvt_pk_bf16(v0[2], v0[3]); w.z = cvt_pk_bf16(v1[0], v1[1]); w.w = cvt_pk_bf16(v1[2], v1[3]);
                    *(u32x4*)(rowp + bj * HALF) = w; } }
    }
};

struct PanelStats {
    unsigned* xbuf;
    unsigned* cnt;
    unsigned* tmo;
    int ntn; float eps;
    unsigned code;
    __device__ __forceinline__ bool run(const f32x4 (&v)[2][2][4][2], const Unit& u, int wr, int wc, int fr, int fq, PG8_LAS unsigned char* lds, int wid, int lane) const {
        typedef float f32x2v __attribute__((ext_vector_type(2)));
        PG8_LAS f32x2v* P = (PG8_LAS f32x2v*)lds;
        PG8_LAS f32x2v* S = (PG8_LAS f32x2v*)(lds + 8192);
        PG8_LAS unsigned* flag = (PG8_LAS unsigned*)(lds + 8192 + 2048);
#pragma unroll
        for (int ai = 0; ai < 2; ++ai)
#pragma unroll
            for (int m = 0; m < 4; ++m) {
                float s = 0.f;
#pragma unroll
                for (int bj = 0; bj < 2; ++bj)
#pragma unroll
                    for (int n = 0; n < 2; ++n) { const f32x4 x = v[ai][bj][m][n]; s += (x[0] + x[1]) + (x[2] + x[3]); }
                s += __shfl_xor(s, 16); s += __shfl_xor(s, 32);
                const float mw = s * (1.0f / 64.0f); float q = 0.f;
#pragma unroll
                for (int bj = 0; bj < 2; ++bj)
#pragma unroll
                    for (int n = 0; n < 2; ++n) { const f32x4 d = v[ai][bj][m][n] - mw; q += (d[0] * d[0] + d[1] * d[1]) + (d[2] * d[2] + d[3] * d[3]); }
                q += __shfl_xor(q, 16); q += __shfl_xor(q, 32);
                if (fq == 0) P[(ai * HALF + wr * 64 + m * 16 + fr) * 4 + wc] = (f32x2v){mw, q};
            }
        asm volatile("s_waitcnt lgkmcnt(0)" ::: "memory"); __builtin_amdgcn_s_barrier(); asm volatile("" ::: "memory");
#if defined(BROKEN_EXCHANGE_NO_WAIT)
#warning BROKEN CONTROL BUILD: the row-statistics exchange does not wait; results are wrong by design
        if (blockIdx.x >= 64) { const long long t0_ = clock64(); while (clock64() - t0_ < 60000) __builtin_amdgcn_s_sleep(8); }
#endif
        const int row = wid * 32 + (lane & 31);
        if (lane < 32) {
            const f32x2v a = P[row * 4 + 0], b = P[row * 4 + 1], c = P[row * 4 + 2], d = P[row * 4 + 3];
            const float mt = (a.x + b.x + c.x + d.x) * 0.25f;
            const float da = a.x - mt, db = b.x - mt, dc = c.x - mt, dd = d.x - mt;
            const float m2 = (a.y + b.y) + (c.y + d.y) + 64.0f * ((da * da + db * db) + (dc * dc + dd * dd));
            unsigned long long* slot = (unsigned long long*)xbuf + ((size_t)(u.pm * BM + row) * 4 + u.pn);
            __hip_atomic_store(slot, ((unsigned long long)__float_as_uint(m2) << 32) | __float_as_uint(mt), __ATOMIC_RELAXED, __HIP_MEMORY_SCOPE_AGENT);
        }
        asm volatile("s_waitcnt vmcnt(0)" ::: "memory");
        if (lane == 0) __hip_atomic_fetch_add(cnt + 64 * u.pm, 1u, __ATOMIC_RELAXED, __HIP_MEMORY_SCOPE_AGENT);
        if (wid == 0) {
            bool dead = false; const unsigned long long t0 = __builtin_amdgcn_s_memrealtime(); const unsigned want = 8u * (unsigned)ntn;
            for (;;) {
#if defined(BROKEN_EXCHANGE_NO_WAIT)
                break;
#endif
                if ((unsigned)__builtin_amdgcn_readfirstlane(__hip_atomic_load(cnt + 64 * u.pm, __ATOMIC_RELAXED, __HIP_MEMORY_SCOPE_AGENT)) >= want) break;
                if (__builtin_amdgcn_s_memrealtime() - t0 > 2000000ull) {
                    if (lane == 0) { unsigned expect = 0u; __hip_atomic_compare_exchange_strong(tmo + 1, &expect, code | (unsigned)(u.pm & 0xff), __ATOMIC_RELAXED, __ATOMIC_RELAXED, __HIP_MEMORY_SCOPE_AGENT);
                                     __hip_atomic_store(tmo, 1u, __ATOMIC_RELAXED, __HIP_MEMORY_SCOPE_AGENT); }
                    dead = true; break; }
                __builtin_amdgcn_s_sleep(2);
            }
            __builtin_amdgcn_fence(__ATOMIC_ACQUIRE, "agent");
            if (lane == 0) flag[0] = dead ? 1u : 0u;
        }
        asm volatile("s_waitcnt vmcnt(0) lgkmcnt(0)" ::: "memory"); __builtin_amdgcn_s_barrier(); asm volatile("" ::: "memory");
        const bool bad = flag[0] != 0u;
        if (lane < 32) {
            const unsigned long long* slot = (const unsigned long long*)xbuf + (size_t)(u.pm * BM + row) * 4; float mt[4], m2[4]; float ms = 0.f;
#pragma unroll
            for (int t = 0; t < 4; ++t) { if (t < ntn) { const unsigned long long w = __hip_atomic_load(slot + t, __ATOMIC_RELAXED, __HIP_MEMORY_SCOPE_AGENT); mt[t] = __uint_as_float((unsigned)w); m2[t] = __uint_as_float((unsigned)(w >> 32)); } else { mt[t] = 0.f; m2[t] = 0.f; } ms += mt[t]; }
            const float mean = ms / (float)ntn; float q = 0.f;
#pragma unroll
            for (int t = 0; t < 4; ++t) if (t < ntn) { const float dm = mt[t] - mean; q += m2[t] + 256.0f * dm * dm; }
            S[row] = (f32x2v){mean, 1.0f / sqrtf(q / (256.0f * (float)ntn) + eps)};
        }
        asm volatile("s_waitcnt lgkmcnt(0)" ::: "memory"); __builtin_amdgcn_s_barrier(); asm volatile("" ::: "memory");
        return bad;
    }
};
struct EpiLnRes {
    static constexpr bool PERM = false, AFTER_DRAIN = true;
    const float* base; float* out; int ldc; const float* bias; PanelStats st; unsigned poison;
    __device__ __forceinline__ void fused(f32x4 (&acc)[2][2][4][2], const Unit& u, int wr, int wc, int fr, int fq, PG8_LAS unsigned char* lds, int wid, int lane) const {
        typedef float f32x2v __attribute__((ext_vector_type(2)));
        const PG8_LAS f32x2v* S = (const PG8_LAS f32x2v*)(lds + 8192);
        const int col0 = u.pn * BM + wc * 32 + 4 * fq;
#pragma unroll
        for (int bj = 0; bj < 2; ++bj)
#pragma unroll
            for (int n = 0; n < 2; ++n) { const f32x4 bv = bias ? *(const f32x4*)(bias + col0 + bj * HALF + n * 16) : (f32x4){0.f, 0.f, 0.f, 0.f};
#pragma unroll
                for (int ai = 0; ai < 2; ++ai)
#pragma unroll
                    for (int m = 0; m < 4; ++m) acc[ai][bj][m][n] += bv; }
        f32x4 pre[4][2][2];
#pragma unroll
        for (int m = 0; m < 4; ++m) { const size_t off = (size_t)(u.pm * BM + wr * 64 + m * 16 + fr) * ldc + col0;
#pragma unroll
            for (int bj = 0; bj < 2; ++bj)
#pragma unroll
                for (int n = 0; n < 2; ++n) pre[m][bj][n] = *(const f32x4*)(base + off + bj * HALF + n * 16); }
        const bool bad = st.run(acc, u, wr, wc, fr, fq, lds, wid, lane) || poison != 0u;
        const float qnan = __builtin_nanf("");
#pragma unroll
        for (int ai = 0; ai < 2; ++ai)
#pragma unroll
            for (int m = 0; m < 4; ++m) { const int r = ai * HALF + wr * 64 + m * 16 + fr; const f32x2v sr = S[r]; const size_t off = (size_t)(u.pm * BM + r) * ldc + col0;
#pragma unroll
                for (int bj = 0; bj < 2; ++bj)
#pragma unroll
                    for (int n = 0; n < 2; ++n) { const f32x4 bs = ai == 0 ? pre[m][bj][n] : *(const f32x4*)(base + off + bj * HALF + n * 16); f32x4 o = bs + (acc[ai][bj][m][n] - sr.x) * sr.y;
                        if (bad) o = (f32x4){qnan, qnan, qnan, qnan}; *(f32x4*)(out + off + bj * HALF + n * 16) = o; }
                if (m & 1) asm volatile("" ::: "memory"); }
    }
};
struct EpiLnResLn {
    static constexpr bool PERM = false, AFTER_DRAIN = true;
    const float* base; float* out; bf16_t* xn; int ldc; const float* bias; PanelStats st1, st2; unsigned poison;
    __device__ __forceinline__ void fused(f32x4 (&acc)[2][2][4][2], const Unit& u, int wr, int wc, int fr, int fq, PG8_LAS unsigned char* lds, int wid, int lane) const {
        typedef float f32x2v __attribute__((ext_vector_type(2))); typedef unsigned u32x2v __attribute__((ext_vector_type(2)));
        const PG8_LAS f32x2v* S = (const PG8_LAS f32x2v*)(lds + 8192);
        const int col0 = u.pn * BM + wc * 32 + 4 * fq;
#pragma unroll
        for (int bj = 0; bj < 2; ++bj)
#pragma unroll
            for (int n = 0; n < 2; ++n) { const f32x4 bv = bias ? *(const f32x4*)(bias + col0 + bj * HALF + n * 16) : (f32x4){0.f, 0.f, 0.f, 0.f};
#pragma unroll
                for (int ai = 0; ai < 2; ++ai)
#pragma unroll
                    for (int m = 0; m < 4; ++m) acc[ai][bj][m][n] += bv; }
        bool bad = st1.run(acc, u, wr, wc, fr, fq, lds, wid, lane) || poison != 0u;
        const float qnan = __builtin_nanf("");
#pragma unroll
        for (int ai = 0; ai < 2; ++ai)
#pragma unroll
            for (int m = 0; m < 4; ++m) { const int r = ai * HALF + wr * 64 + m * 16 + fr; const f32x2v sr = S[r]; const size_t off = (size_t)(u.pm * BM + r) * ldc + col0;
#pragma unroll
                for (int bj = 0; bj < 2; ++bj)
#pragma unroll
                    for (int n = 0; n < 2; ++n) { const f32x4 bs = *(const f32x4*)(base + off + bj * HALF + n * 16); acc[ai][bj][m][n] = bs + (acc[ai][bj][m][n] - sr.x) * sr.y; }
                asm volatile("" : "+v"(acc[ai][0][m][0]), "+v"(acc[ai][0][m][1]), "+v"(acc[ai][1][m][0]), "+v"(acc[ai][1][m][1]));
                if (m & 1) asm volatile("" ::: "memory"); }
        const bool bad1 = bad;
        bad = st2.run(acc, u, wr, wc, fr, fq, lds, wid, lane) || bad;
#pragma unroll
        for (int ai = 0; ai < 2; ++ai)
#pragma unroll
            for (int m = 0; m < 4; ++m) { const int r = ai * HALF + wr * 64 + m * 16 + fr; const f32x2v sr = S[r]; const size_t off = (size_t)(u.pm * BM + r) * ldc + col0;
#pragma unroll
                for (int bj = 0; bj < 2; ++bj)
#pragma unroll
                    for (int n = 0; n < 2; ++n) { const f32x4 x1 = acc[ai][bj][m][n]; *(f32x4*)(out + off + bj * HALF + n * 16) = bad1 ? (f32x4){qnan, qnan, qnan, qnan} : x1;
                        const f32x4 o = (x1 - sr.x) * sr.y; u32x2v w; w.x = cvt_pk_bf16(o[0], o[1]); w.y = cvt_pk_bf16(o[2], o[3]);
                        if (bad) { w.x = 0x7fc07fc0u; w.y = 0x7fc07fc0u; } *(u32x2v*)(xn + off + bj * HALF + n * 16) = w; }
                asm volatile("" ::: "memory"); }
    }
};

template <class Epi, class Sched, bool ALIGN_EPI = false, bool SP2 = false>
__device__ __forceinline__ void gemm_phase(PG8_LAS unsigned char* lds, const Gemm g, const Sched& S, const Epi& E, const int wv) {
    const int tid = otid(wv), wid = __builtin_amdgcn_readfirstlane(tid >> 6), lane = tid & 63, wr = wid >> 2, wc = wid & 3, fr = lane & 15, fq = lane >> 4;
    const int K = g.K, nt = K / BK;
    unsigned voffA[2], voffB[2];
#pragma unroll
    for (int i = 0; i < 2; ++i) { int R, C; stage_rc(tid * 16 + i * 8192, R, C); const int Rb = Epi::PERM ? ((R & ~31) + perm32(R & 31)) : R;
        voffA[i] = (unsigned)(R * K + C) * 2u; voffB[i] = (unsigned)(Rb * K + C) * 2u; }
    const size_t kstep = (size_t)(BK * 2);
    const size_t hstep = (size_t)HALF * K * 2;
    const size_t tstep = 2 * hstep;
    const unsigned ldsw = (unsigned)wid * 1024u;
    const int aoff = lds_byte(wr * 64 + fr, fq * 8), boff = lds_byte(wc * 32 + fr, fq * 8);
#define PG8_SA(b, h) (((b) * 2 + (h)) * HTB)
#define PG8_SB(b, h) ((4 + (b) * 2 + (h)) * HTB)
#define PG8_STAGE(bufoff, gbase, voff) do { _Pragma("unroll") for (int _i = 0; _i < 2; ++_i) \
        __builtin_amdgcn_global_load_lds((const unsigned*)((const char*)(gbase) + (voff)[_i]), (PG8_LAS unsigned*)(lds + (bufoff) + ldsw + _i * 8192), 16, 0, 0); } while (0)
#define PG8_LDA(dst, b, h) do { _Pragma("unroll") for (int m = 0; m < 4; ++m) _Pragma("unroll") for (int k = 0; k < 2; ++k) dst[m][k] = *(const PG8_LAS bf16x8*)(lds + PG8_SA(b, h) + aoff + m * 2048 + k * 1024); } while (0)
#define PG8_LDB(dst, b, h) do { _Pragma("unroll") for (int n = 0; n < 2; ++n) _Pragma("unroll") for (int k = 0; k < 2; ++k) dst[n][k] = *(const PG8_LAS bf16x8*)(lds + PG8_SB(b, h) + boff + n * 2048 + k * 1024); } while (0)
#define PG8_MMA(ai, bj, At, Bt) do { __builtin_amdgcn_s_setprio(1); _Pragma("unroll") for (int m = 0; m < 4; ++m) _Pragma("unroll") for (int n = 0; n < 2; ++n) _Pragma("unroll") for (int k = 0; k < 2; ++k) \
        acc[ai][bj][m][n] = __builtin_amdgcn_mfma_f32_16x16x32_bf16(Bt[n][k], At[m][k], acc[ai][bj][m][n], 0, 0, 0); __builtin_amdgcn_s_setprio(0); } while (0)
#define PG8_WAIT_V(n) asm volatile("s_waitcnt vmcnt(" #n ")" ::: "memory")
#define PG8_WAIT_L(n) asm volatile("s_waitcnt lgkmcnt(" #n ")" ::: "memory")
#define PG8_BAR __builtin_amdgcn_s_barrier()
#define PG8_SCHED __builtin_amdgcn_sched_barrier(0)
    Unit cur, nxt; int ui = 0;
    if (!S.next(0, cur)) return;
    f32x4 acc[2][2][4][2];
#pragma unroll
    for (int a = 0; a < 2; ++a)
#pragma unroll
        for (int b = 0; b < 2; ++b)
#pragma unroll
            for (int m = 0; m < 4; ++m)
#pragma unroll
                for (int n = 0; n < 2; ++n) acc[a][b][m][n] = (f32x4){0.f, 0.f, 0.f, 0.f};
    bf16x8 At[4][2], B0[2][2], B1[2][2];
    const char* cA = (const char*)g.A + (size_t)cur.pm * tstep; const char* cB = (const char*)g.Bt + (size_t)cur.pn * tstep;
    S.a_ready(cur);
    if constexpr (SP2) {
        PG8_STAGE(PG8_SB(0, 0), cB, voffB); PG8_STAGE(PG8_SB(0, 1), cB + hstep, voffB); PG8_STAGE(PG8_SA(0, 0), cA, voffA); PG8_STAGE(PG8_SA(0, 1), cA + hstep, voffA);
        if (wr == 1) PG8_BAR;
        PG8_WAIT_V(2); PG8_BAR;
        PG8_STAGE(PG8_SB(1, 0), cB + kstep, voffB); PG8_STAGE(PG8_SA(1, 0), cA + kstep, voffA); PG8_STAGE(PG8_SB(1, 1), cB + hstep + kstep, voffB);
        PG8_WAIT_V(6); PG8_BAR;
    } else {
        PG8_STAGE(PG8_SB(0, 0), cB, voffB); PG8_STAGE(PG8_SA(0, 0), cA, voffA); PG8_STAGE(PG8_SB(0, 1), cB + hstep, voffB); PG8_STAGE(PG8_SA(0, 1), cA + hstep, voffA);
        if (wr == 1) PG8_BAR;
        PG8_WAIT_V(4); PG8_BAR;
        PG8_STAGE(PG8_SB(1, 0), cB + kstep, voffB); PG8_STAGE(PG8_SA(1, 0), cA + kstep, voffA); PG8_STAGE(PG8_SB(1, 1), cB + hstep + kstep, voffB);
        PG8_WAIT_V(6); PG8_BAR;
    }
    for (;;) {
        const bool has_next = S.next(ui + 1, nxt);
        const char* nA = has_next ? (const char*)g.A + (size_t)nxt.pm * tstep : cA; const char* nB = has_next ? (const char*)g.Bt + (size_t)nxt.pn * tstep : cB;
        for (int t = 0; t < nt; t += 2) {
            const bool last = (t == nt - 2);
            const char* a1 = cA + (size_t)(t + 1) * kstep;
            const char* a2 = last ? nA : cA + (size_t)(t + 2) * kstep; const char* b2 = last ? nB : cB + (size_t)(t + 2) * kstep;
            const char* a3 = a2 + kstep; const char* b3 = b2 + kstep;
            if (last && has_next) S.a_ready(nxt);
            if constexpr (SP2) {
            PG8_LDB(B0, 0, 0); PG8_LDB(B1, 0, 1); PG8_SCHED; PG8_LDA(At, 0, 0); PG8_STAGE(PG8_SA(1, 1), a1 + hstep, voffA);
            PG8_WAIT_V(8); PG8_WAIT_L(0); PG8_BAR; PG8_MMA(0, 0, At, B0); PG8_MMA(0, 1, At, B1); PG8_BAR; PG8_SCHED;
            PG8_LDA(At, 0, 1); PG8_STAGE(PG8_SB(0, 0), b2, voffB); PG8_STAGE(PG8_SB(0, 1), b2 + hstep, voffB); PG8_STAGE(PG8_SA(0, 0), a2, voffA);
            PG8_WAIT_V(8); PG8_WAIT_L(0); PG8_BAR; PG8_MMA(1, 0, At, B0); PG8_MMA(1, 1, At, B1); PG8_BAR; PG8_SCHED;
            PG8_LDB(B0, 1, 0); PG8_LDB(B1, 1, 1); PG8_SCHED; PG8_LDA(At, 1, 0); PG8_STAGE(PG8_SA(0, 1), a2 + hstep, voffA);
            PG8_WAIT_V(8); PG8_WAIT_L(0); PG8_BAR; PG8_MMA(0, 0, At, B0); PG8_MMA(0, 1, At, B1); PG8_BAR; PG8_SCHED;
            PG8_LDA(At, 1, 1); PG8_STAGE(PG8_SB(1, 0), b3, voffB); PG8_STAGE(PG8_SB(1, 1), b3 + hstep, voffB); PG8_STAGE(PG8_SA(1, 0), a3, voffA);
            PG8_WAIT_V(8); PG8_WAIT_L(0); PG8_BAR; PG8_MMA(1, 0, At, B0); PG8_MMA(1, 1, At, B1); PG8_BAR; PG8_SCHED;
            } else {
            PG8_LDB(B0, 0, 0); PG8_SCHED; PG8_LDA(At, 0, 0); PG8_STAGE(PG8_SA(1, 1), a1 + hstep, voffA);
            PG8_WAIT_L(8); PG8_BAR; PG8_WAIT_L(0); PG8_MMA(0, 0, At, B0); PG8_BAR; PG8_SCHED;
            PG8_LDB(B1, 0, 1); PG8_STAGE(PG8_SB(0, 0), b2, voffB);
            PG8_BAR; PG8_WAIT_L(0); PG8_MMA(0, 1, At, B1); PG8_BAR;
            PG8_LDA(At, 0, 1); PG8_STAGE(PG8_SA(0, 0), a2, voffA);
            PG8_BAR; PG8_WAIT_L(0); PG8_MMA(1, 0, At, B0); PG8_BAR; PG8_SCHED;
            PG8_STAGE(PG8_SB(0, 1), b2 + hstep, voffB);
            PG8_WAIT_V(6); PG8_BAR; PG8_MMA(1, 1, At, B1); PG8_BAR;
            PG8_LDB(B0, 1, 0); PG8_SCHED; PG8_LDA(At, 1, 0); PG8_STAGE(PG8_SA(0, 1), a2 + hstep, voffA);
            PG8_WAIT_L(8); PG8_BAR; PG8_WAIT_L(0); PG8_MMA(0, 0, At, B0); PG8_BAR; PG8_SCHED;
            PG8_LDB(B1, 1, 1); PG8_STAGE(PG8_SB(1, 0), b3, voffB);
            PG8_BAR; PG8_WAIT_L(0); PG8_MMA(0, 1, At, B1); PG8_BAR;
            PG8_LDA(At, 1, 1); PG8_STAGE(PG8_SA(1, 0), a3, voffA);
            PG8_BAR; PG8_WAIT_L(0); PG8_MMA(1, 0, At, B0); PG8_BAR; PG8_SCHED;
            PG8_STAGE(PG8_SB(1, 1), b3 + hstep, voffB);
            PG8_WAIT_V(6); PG8_BAR; PG8_MMA(1, 1, At, B1); PG8_BAR;
            }
        }
        if constexpr (ALIGN_EPI) { if (wr == 0) PG8_BAR; }
        if constexpr (!Epi::AFTER_DRAIN) { E(acc, cur, wr, wc, fr, fq); S.done(cur); }
        if (!has_next) break;
#pragma unroll
        for (int a = 0; a < 2; ++a)
#pragma unroll
            for (int b = 0; b < 2; ++b)
#pragma unroll
                for (int m = 0; m < 4; ++m)
#pragma unroll
                    for (int n = 0; n < 2; ++n) acc[a][b][m][n] = (f32x4){0.f, 0.f, 0.f, 0.f};
        cur = nxt; cA = nA; cB = nB; ++ui;
        if constexpr (ALIGN_EPI) { if (wr == 1) PG8_BAR; }
    }
    PG8_WAIT_V(0);
    if constexpr (!ALIGN_EPI) { if (wr == 0) PG8_BAR; }
    PG8_BAR;
    if constexpr (Epi::AFTER_DRAIN) { E.fused(acc, cur, wr, wc, fr, fq, lds, wid, lane); S.done(cur); }
#undef PG8_SA
#undef PG8_SB
#undef PG8_STAGE
#undef PG8_LDA
#undef PG8_LDB
#undef PG8_MMA
#undef PG8_WAIT_V
#undef PG8_WAIT_L
#undef PG8_BAR
#undef PG8_SCHED
}
}

#ifndef PG8_SP2
#define PG8_SP2 true
#endif
#ifndef PG8_ALIGN
#define PG8_ALIGN true
#endif
#define GAS __attribute__((address_space(1)))
#define LAS __attribute__((address_space(3)))
typedef unsigned short bf16;
typedef unsigned v4u __attribute__((ext_vector_type(4)));
typedef float f32x4 __attribute__((ext_vector_type(4)));
typedef short bf16x8 __attribute__((ext_vector_type(8)));
typedef GAS unsigned gu32;
typedef GAS unsigned long long gu64;
#define RLX_AGENT __ATOMIC_RELAXED, __HIP_MEMORY_SCOPE_AGENT
#define LDS_WAIT() asm volatile("s_waitcnt lgkmcnt(0)" ::: "memory")
#define VM_WAIT() asm volatile("s_waitcnt vmcnt(0)" ::: "memory")
__device__ __forceinline__ unsigned long long rt() { return __builtin_amdgcn_s_memrealtime(); }
__device__ __forceinline__ unsigned f2bf(float f) { unsigned u = __builtin_bit_cast(unsigned, f); return (u + 0x7fffu + ((u >> 16) & 1u)) >> 16; }
__device__ __forceinline__ unsigned pk2(float lo, float hi) { return f2bf(lo) | (f2bf(hi) << 16); }

#define XB_TMO      128
#define XB_XCNT(j)  (256  + 64 * (j))
#define XB_XSUB(j)  (1280 + 64 * (j))
#define XB_XGEN(j)  (2304 + 64 * (j))
#define XB_TOP      3328
#define XB_TOPGEN   3392
#define XCD_BAR_WORDS 3456
#define XB_SPIN_CAP (1u << 18)

__device__ __forceinline__ unsigned xb_ld(unsigned* p)              { return __hip_atomic_load(p, __ATOMIC_RELAXED, __HIP_MEMORY_SCOPE_AGENT); }
__device__ __forceinline__ unsigned xb_add(unsigned* p, unsigned v) { return __hip_atomic_fetch_add(p, v, __ATOMIC_RELAXED, __HIP_MEMORY_SCOPE_AGENT); }
__device__ __forceinline__ unsigned xb_xcc_id() { return (unsigned)__builtin_amdgcn_s_getreg((3 << 11) | 20) & 0xFu; }
#define XB_SPIN(cond, bar) do { unsigned _sp = 0; while (cond) { __builtin_amdgcn_s_sleep(1); \
    if ((++_sp & 255u) == 0u) { if (xb_ld(&(bar)[XB_TMO])) break; if (_sp > XB_SPIN_CAP) { atomicAdd(&(bar)[XB_TMO], 1u); break; } } } } while (0)

struct XcdBarrier {
    unsigned* bar; unsigned x;
    volatile LAS unsigned* st;
    int wv;
};

__device__ __forceinline__ XcdBarrier xcd_barrier_post(unsigned* bar, volatile LAS unsigned* st) {
    XcdBarrier b; b.bar = bar; b.x = xb_xcc_id(); b.st = st;
    if (threadIdx.x == 0) (void)xb_add(&bar[XB_XCNT(b.x)], 1u);
    return b;
}
__device__ __forceinline__ void xcd_barrier_complete(unsigned* bar, unsigned x, unsigned& nloc, unsigned& nx) {
    const unsigned G = gridDim.x * gridDim.y * gridDim.z;
    unsigned sum, cnt, mine, sp = 0u;
    for (;;) {
        sum = 0u; cnt = 0u; mine = 0u;
#pragma unroll
        for (unsigned j = 0; j < 16; ++j) { const unsigned c = xb_ld(&bar[XB_XCNT(j)]); sum += c; cnt += (c > 0u) ? 1u : 0u; mine = (j == x) ? c : mine; }
        if (sum == G) break;
        __builtin_amdgcn_s_sleep(1);
        if ((++sp & 255u) == 0u) { if (xb_ld(&bar[XB_TMO])) break; if (sp > XB_SPIN_CAP) { atomicAdd(&bar[XB_TMO], 1u); break; } }
    }
    nloc = mine > 0u ? mine : 1u; nx = cnt > 0u ? cnt : 1u;
}

__device__ __forceinline__ void xcd_barrier(const XcdBarrier& b) {
    asm volatile("s_waitcnt vmcnt(0)" ::: "memory");
    __syncthreads();
    if (otid(b.wv) == 0) {
        unsigned* bar = b.bar;
        __builtin_amdgcn_s_waitcnt(0);
        unsigned nloc = b.st[0], nx = b.st[1];
        if (nloc == 0u) { xcd_barrier_complete(bar, b.x, nloc, nx); b.st[0] = nloc; b.st[1] = nx; }
        const unsigned old = xb_add(&bar[XB_XSUB(b.x)], 1u);
        const unsigned gen = old / nloc;
        if (old + 1u == (gen + 1u) * nloc) {
            __builtin_amdgcn_fence(__ATOMIC_RELEASE, "agent");
            asm volatile("s_waitcnt vmcnt(0)" ::: "memory");
            const unsigned og = xb_add(&bar[XB_TOP], 1u);
            const unsigned tg = og / nx;
            if (og + 1u == (tg + 1u) * nx) xb_add(&bar[XB_TOPGEN], 1u);
            else XB_SPIN(xb_ld(&bar[XB_TOPGEN]) == tg, bar);
            __builtin_amdgcn_fence(__ATOMIC_ACQUIRE, "agent");
            xb_add(&bar[XB_XGEN(b.x)], 1u);
            asm volatile("s_waitcnt vmcnt(0)" ::: "memory");
        } else {
            XB_SPIN(xb_ld(&bar[XB_XGEN(b.x)]) == gen, bar);
            __builtin_amdgcn_fence(__ATOMIC_ACQUIRE, "agent");
            asm volatile("s_waitcnt vmcnt(0)" ::: "memory");
        }
    }
    __syncthreads();
}


constexpr int NB = 8, SEQ = 2048, CTXL = 256, DM = 1024, NL = 4;
constexpr int ML = NB * SEQ, MC = NB * CTXL, MT = ML + MC;
constexpr int NIN = 2464, NINP = 2560, DFF = 2816, NUP = 5632, KMLA = 384, NMLA = 1024;
constexpr int NKEY = SEQ + CTXL, NKT = NKEY / 64;
constexpr float EPS = 1e-6f;
constexpr float LOG2E = 1.4426950408889634f;
constexpr int PC_CQ = 0, PC_CKV = 256, PC_KR = 384, PC_DQ = 512, PC_DK = 768, PC_DV = 1024, PC_NQ = 1280, PC_NK = 1536, PC_NV = 1792, PC_GQ = 2048, PC_GK = 2304, PC_GV = 2432;

constexpr size_t MiB = 1u << 20;
constexpr size_t WS_CTL = 0, CTL_ZERO_BYTES = 1 * MiB;
constexpr size_t WS_MODS = 1 * MiB;
constexpr size_t WS_ROPE32 = 2 * MiB;
constexpr size_t WS_ROPE64 = 2 * MiB + 262144;
constexpr size_t WS_W = 3 * MiB;
constexpr size_t W_IN = 0, W_OUT = W_IN + (size_t)NINP * DM * 2, W_UP = W_OUT + (size_t)DM * DM * 2, W_DOWN = W_UP + (size_t)NUP * DM * 2, W_MLA = W_DOWN + (size_t)DM * DFF * 2, W_LAYER = W_MLA + (size_t)NMLA * KMLA * 2;
static_assert(W_LAYER == 25427968, "weights per layer");
constexpr size_t WS_XC = 100 * MiB;
constexpr size_t WS_R2 = 108 * MiB;
constexpr size_t WS_XN = WS_R2, WS_MLAP = WS_R2, WS_CQKV = WS_R2 + 36 * MiB;
constexpr size_t WS_R1 = 158 * MiB;
constexpr size_t WS_P = WS_R1, WS_QKV = WS_R1 + 90 * MiB, WS_MIX = WS_R1, WS_ACT = WS_R1, WS_HALO = WS_R1 + 100 * MiB;
constexpr size_t WS_END = WS_R1 + 198 * MiB;
static_assert(WS_W + NL * W_LAYER <= WS_XC, "weights fit");
static_assert((size_t)MT * NINP * 2 <= 90 * MiB && (size_t)MT * DFF * 2 <= 100 * MiB && (size_t)72 * 4 * NUP * 4 <= 8 * MiB, "R1 map");
constexpr size_t E_QA = 0, E_KA = E_QA + (size_t)NB * 4 * NKEY * 96, E_VA = E_KA + (size_t)NB * 4 * NKEY * 96, E_QD = E_VA + (size_t)NB * 4 * NKEY * 64,
                 E_KD = E_QD + (size_t)NB * 8 * NKEY * 32, E_VD = E_KD + (size_t)NB * 8 * NKEY * 32, E_QN = E_VD + (size_t)NB * 4 * NKEY * 64, E_KN = E_QN + (size_t)NB * 4 * NKEY * 64,
                 E_VN = E_KN + (size_t)NB * 4 * NKEY * 64, E_QG = E_VN + (size_t)NB * 4 * NKEY * 64, E_KG = E_QG + (size_t)NB * 4 * NKEY * 64, E_VG = E_KG + (size_t)NB * 2 * NKEY * 64,
                 E_END = E_VG + (size_t)NB * 2 * NKEY * 64;
static_assert(E_END * 2 <= 108 * MiB, "QKV map");
constexpr int CW_TMO = 0, CW_CODE = 1, CW_BAR = 4096;

constexpr int RING_OFF = 0, RING_BYTES = 131072;
constexpr int LDSCTL_OFF = RING_BYTES, MISC_OFF = LDSCTL_OFF + 320;
constexpr int EX_OFF = RING_BYTES + 1024;
constexpr int LDS_BYTES = 147456;
static_assert(EX_OFF + 8192 <= LDS_BYTES, "LDS map");
constexpr int NWAVES = 8;

typedef float f32x2v __attribute__((ext_vector_type(2)));
typedef unsigned u32x2v __attribute__((ext_vector_type(2)));

__device__ __forceinline__ float bf2f(unsigned short v) { return __uint_as_float((unsigned)v << 16); }
__device__ __forceinline__ float bflo(unsigned w) { return __uint_as_float(w << 16); }
__device__ __forceinline__ float bfhi(unsigned w) { return __uint_as_float(w & 0xffff0000u); }
__device__ __forceinline__ float wave_sum(float v) {
#pragma unroll
    for (int o = 1; o < 64; o <<= 1) v += __shfl_xor(v, o);
    return v;
}
__device__ __forceinline__ float silu_f(float x) { return x / (1.f + __expf(-x)); }

__device__ __forceinline__ size_t q_off(int H, int DK, int b, int h, int q) { return ((size_t)(b * H + h) * NKEY + q) * DK; }
__device__ __forceinline__ size_t k_off(int H, int DK, int b, int h, int key, int d) { return ((((size_t)(b * H + h) * NKT + (key >> 6)) * (DK >> 3) + (d >> 3)) * 64 + (key & 63)) * 8 + (d & 7); }
__device__ __forceinline__ size_t v_off(int H, int b, int h, int key, int dv) {
    const int kk = key & 63, s = kk >> 4, i = kk & 15, hh = (i >> 2) & 1, j = (i & 3) + 4 * (i >> 3);
    return ((((size_t)(b * H + h) * NKT + (key >> 6)) * 8 + (s * 2 + hh)) * 64 + dv) * 8 + j;
}

constexpr int PT_OFF = LDSCTL_OFF + 512;
struct Ctx {
    LAS unsigned char* lds;
    int tid, lane, wave, G, gw, NGW;
};
extern __shared__ __attribute__((aligned(16))) unsigned char lds_raw[];
__device__ __forceinline__ Ctx make_ctx(const int wv) {
    unsigned zl = 0; asm volatile("" : "+s"(zl));
    Ctx C; C.lds = (LAS unsigned char*)lds_raw + zl;
    const int t = otid(wv);
    C.tid = t; C.lane = t & 63; C.wave = wv;
    C.G = gridDim.x; { const int bx = blockIdx.x; const int vcu = (C.G % 8 == 0) ? (bx % 8) * (C.G / 8) + bx / 8 : bx; C.gw = vcu * NWAVES + C.wave; } C.NGW = C.G * NWAVES;
    return C;
}
__device__ __forceinline__ unsigned long long ptab(const Ctx& C, int i) {
    const unsigned long long p = ((const LAS unsigned long long*)(C.lds + PT_OFF))[i];
    const unsigned lo = __builtin_amdgcn_readfirstlane((unsigned)p), hi = __builtin_amdgcn_readfirstlane((unsigned)(p >> 32));
    return ((unsigned long long)hi << 32) | lo;
}
__device__ __forceinline__ const float* inp(const Ctx& C, int i) { return (const float*)ptab(C, i); }
__device__ __forceinline__ float* outp(const Ctx& C) { return (float*)ptab(C, 32); }
__device__ __forceinline__ unsigned char* wsp(const Ctx& C) { return (unsigned char*)ptab(C, 33); }
__device__ __forceinline__ bf16* wptr(const Ctx& C, int l, size_t off) { return (bf16*)(wsp(C) + WS_W + (size_t)l * W_LAYER + off); }
__device__ __forceinline__ float lambda_init(int l) { return l == 0 ? 0.2f : l == 1 ? (float)(0.8 - 0.6 * 0.7408182206817179) : l == 2 ? (float)(0.8 - 0.6 * 0.5488116360940264) : (float)(0.8 - 0.6 * 0.4065696597405991); }

namespace pg8 {
struct EpiResGate {
    static constexpr bool PERM = false, AFTER_DRAIN = false;
    const float* base_lat; const float* base_ctx; float* out_lat; float* out_ctx; const float* gate;
    __device__ __forceinline__ void operator()(const f32x4 (&acc)[2][2][4][2], const Unit& u, int wr, int wc, int fr, int fq) const {
        const bool lat = u.pm < 64; const int bidx = lat ? (u.pm >> 3) : 8;
        const size_t rowt = lat ? (size_t)u.pm * BM : (size_t)(u.pm - 64) * BM;
        const float* base = (lat ? base_lat : base_ctx) + rowt * DM; float* out = (lat ? out_lat : out_ctx) + rowt * DM;
        const int row0 = wr * 64 + fr, col0 = u.pn * BM + wc * 32 + 4 * fq;
        f32x4 gv[2][2];
#pragma unroll
        for (int bj = 0; bj < 2; ++bj)
#pragma unroll
            for (int n = 0; n < 2; ++n) gv[bj][n] = *(const f32x4*)(gate + (size_t)bidx * 6144 + col0 + bj * HALF + n * 16);
#pragma unroll
        for (int ai = 0; ai < 2; ++ai)
#pragma unroll
            for (int m = 0; m < 4; ++m) { const size_t off = (size_t)(row0 + ai * HALF + m * 16) * DM + col0;
#pragma unroll
                for (int bj = 0; bj < 2; ++bj)
#pragma unroll
                    for (int n = 0; n < 2; ++n) { const f32x4 bs = *(const f32x4*)(base + off + bj * HALF + n * 16); *(f32x4*)(out + off + bj * HALF + n * 16) = bs + gv[bj][n] * acc[ai][bj][m][n]; }
                if (m & 1) asm volatile("" ::: "memory"); }
    }
};
__device__ __forceinline__ f32x4 shf4(const f32x4 v, int src) { f32x4 r; r[0] = __shfl(v[0], src); r[1] = __shfl(v[1], src); r[2] = __shfl(v[2], src); r[3] = __shfl(v[3], src); return r; }
__device__ __forceinline__ f32x4 sel4(bool c, const f32x4 a, const f32x4 b) { f32x4 r; r[0] = c ? a[0] : b[0]; r[1] = c ? a[1] : b[1]; r[2] = c ? a[2] : b[2]; r[3] = c ? a[3] : b[3]; return r; }
__device__ __forceinline__ float silu1(float x) { return x * __builtin_amdgcn_rcpf(1.f + __expf(-x)); }
struct EpiConvGate {
    static constexpr bool PERM = true, AFTER_DRAIN = false;
    bf16_t* ACT; float* HALO; const float* cw; const float* cb; PG8_LAS float* EX;
    __device__ __forceinline__ void operator()(const f32x4 (&acc)[2][2][4][2], const Unit& u, int wr, int wc, int fr, int fq) const {
        const int lane = fq * 16 + fr;
        const int jc = u.pn * 128 + wc * 32 + 8 * fq;
        if (fr == 0) {
#pragma unroll
            for (int ai = 0; ai < 2; ++ai)
#pragma unroll
                for (int bj = 0; bj < 2; ++bj)
#pragma unroll
                    for (int n = 0; n < 2; ++n) *(PG8_LAS f32x4*)(EX + ((((wr * 4 + wc) * 2 + ai) * 2 + 0) * 64 + bj * 32 + 8 * fq + 4 * n)) = acc[ai][bj][0][n];
        }
        if (fr == 15) {
#pragma unroll
            for (int ai = 0; ai < 2; ++ai)
#pragma unroll
                for (int bj = 0; bj < 2; ++bj)
#pragma unroll
                    for (int n = 0; n < 2; ++n) *(PG8_LAS f32x4*)(EX + ((((wr * 4 + wc) * 2 + ai) * 2 + 1) * 64 + bj * 32 + 8 * fq + 4 * n)) = acc[ai][bj][3][n];
        }
        asm volatile("s_waitcnt lgkmcnt(0)" ::: "memory"); __builtin_amdgcn_s_barrier(); asm volatile("" ::: "memory");
        if (u.pm < 64) {
            float* hb = HALO + (size_t)u.pm * 4 * NUP;
            if (wr == 0 && fr < 2) {
#pragma unroll
                for (int bj = 0; bj < 2; ++bj)
#pragma unroll
                    for (int n = 0; n < 2; ++n) *(f32x4*)(hb + (size_t)fr * NUP + bj * DFF + jc + 4 * n) = acc[0][bj][0][n];
            }
            if (wr == 1 && fr >= 14) {
#pragma unroll
                for (int bj = 0; bj < 2; ++bj)
#pragma unroll
                    for (int n = 0; n < 2; ++n) *(f32x4*)(hb + (size_t)(fr - 12) * NUP + bj * DFF + jc + 4 * n) = acc[1][bj][3][n];
            }
        }
        const int srcR = (lane & 48) | ((lane - 1) & 15), srcL = (lane & 48) | ((lane + 1) & 15);
        const bool f0 = fr == 0, f15 = fr == 15;
#pragma unroll
        for (int ai = 0; ai < 2; ++ai) {
            const int g = 2 * ai + wr;
            const int gp = g - 1, gn = g + 1;
            unsigned pk[4][4];
#pragma unroll
            for (int n = 0; n < 2; ++n)
#pragma unroll
                for (int ep = 0; ep < 2; ++ep) {
                    float cv[2][2][4];
#pragma unroll
                    for (int bj = 0; bj < 2; ++bj) {
                        const int c = bj * DFF + jc + 4 * n + 2 * ep;
                        const f32x2v w0 = *(const f32x2v*)(cw + c), w1 = *(const f32x2v*)(cw + NUP + c), w2 = *(const f32x2v*)(cw + 2 * NUP + c), bb = *(const f32x2v*)(cb + c);
                        f32x2v bprev = {0.f, 0.f}, bnext = {0.f, 0.f};
                        if (gp >= 0) bprev = *(const PG8_LAS f32x2v*)(EX + (((((gp & 1) * 4 + wc) * 2 + (gp >> 1)) * 2 + 1) * 64 + bj * 32 + 8 * fq + 4 * n + 2 * ep));
                        if (gn <= 3) bnext = *(const PG8_LAS f32x2v*)(EX + (((((gn & 1) * 4 + wc) * 2 + (gn >> 1)) * 2 + 0) * 64 + bj * 32 + 8 * fq + 4 * n + 2 * ep));
#pragma unroll
                        for (int e2 = 0; e2 < 2; ++e2) {
                            const int e = 2 * ep + e2;
                            float r[4], l[4];
#pragma unroll
                            for (int m = 0; m < 4; ++m) { r[m] = __shfl(acc[ai][bj][m][n][e], srcR); l[m] = __shfl(acc[ai][bj][m][n][e], srcL); }
#pragma unroll
                            for (int m = 0; m < 4; ++m) {
                                const float pv = f0 ? (m > 0 ? r[m > 0 ? m - 1 : 0] : bprev[e2]) : r[m];
                                const float nx = f15 ? (m < 3 ? l[m < 3 ? m + 1 : 3] : bnext[e2]) : l[m];
                                cv[bj][e2][m] = w0[e2] * pv + w1[e2] * acc[ai][bj][m][n][e] + w2[e2] * nx + bb[e2];
                            }
                        }
                    }
#pragma unroll
                    for (int m = 0; m < 4; ++m) pk[m][n * 2 + ep] = cvt_pk_bf16(silu1(cv[1][0][m]) * cv[0][0][m], silu1(cv[1][1][m]) * cv[0][1][m]);
                    __builtin_amdgcn_sched_barrier(0);
                }
#pragma unroll
            for (int m = 0; m < 4; ++m) {
                const size_t row = (size_t)u.pm * BM + ai * HALF + wr * 64 + m * 16 + fr;
                u32x4 w; w.x = pk[m][0]; w.y = pk[m][1]; w.z = pk[m][2]; w.w = pk[m][3];
                *(u32x4*)(ACT + row * DFF + jc) = w;
            }
            __builtin_amdgcn_sched_barrier(0);
        }
    }
};
}

__device__ __forceinline__ void transpose_item(const float* W, int N, int k0, int n0, bf16* WT, int ldt, int kcol0, int orow0, LAS float* scr, int lane) {
#pragma unroll 8
    for (int i = 0; i < 32; ++i) { const int kk = 2 * i + (lane >> 5); scr[kk * 33 + (lane & 31)] = W[(size_t)(k0 + kk) * N + n0 + (lane & 31)]; }
    LDS_WAIT(); asm volatile("" ::: "memory");
    const int c = lane & 7;
#pragma unroll
    for (int j = 0; j < 4; ++j) { const int n = (lane >> 3) + 8 * j; const LAS float* s = scr + (8 * c) * 33 + n;
        v4u o; o.x = pk2(s[0 * 33], s[1 * 33]); o.y = pk2(s[2 * 33], s[3 * 33]); o.z = pk2(s[4 * 33], s[5 * 33]); o.w = pk2(s[6 * 33], s[7 * 33]);
        *(GAS v4u*)(WT + (size_t)(orow0 + n) * ldt + kcol0 + k0 + 8 * c) = o; }
    LDS_WAIT(); asm volatile("" ::: "memory");
}
__device__ __forceinline__ void phase_prologue(const int wv) {
    const Ctx C = make_ctx(wv);
    {
        LAS float* S = (LAS float*)(C.lds);
        LAS float* red = (LAS float*)(C.lds + 40960);
        const float* cin = inp(C, 1); const float* cctx = inp(C, 3); const float* wmod = inp(C, 4); const float* bmod = inp(C, 5);
        for (int i = C.tid; i < 9 * 1024; i += 512) { const int r = i >> 10, k = i & 1023; const float v = (r < 8) ? cin[r * 1024 + k] : cctx[k]; S[i] = v / (1.f + expf(-v)); }
        __syncthreads();
        for (int it = blockIdx.x; it < NL * 192; it += C.G) {
            const int l = it / 192, col0 = (it % 192) * 32;
            const float* W = wmod + (size_t)l * 1024 * 6144 + col0 + (C.lane & 31);
            float acc[9];
#pragma unroll
            for (int r = 0; r < 9; ++r) acc[r] = 0.f;
            const int kb = C.wave * 128 + (C.lane >> 5);
#pragma unroll 4
            for (int i = 0; i < 64; ++i) { const int k = kb + 2 * i; const float w = W[(size_t)k * 6144];
#pragma unroll
                for (int r = 0; r < 9; ++r) acc[r] += S[r * 1024 + k] * w; }
#pragma unroll
            for (int r = 0; r < 9; ++r) acc[r] += __shfl_xor(acc[r], 32);
            if (C.lane < 32) {
#pragma unroll
                for (int r = 0; r < 9; ++r) red[(C.wave * 9 + r) * 32 + C.lane] = acc[r];
            }
            __syncthreads();
            if (C.tid < 288) { const int r = C.tid >> 5, cc = C.tid & 31; float s = 0.f;
#pragma unroll
                for (int w = 0; w < 8; ++w) s += red[(w * 9 + r) * 32 + cc];
                ((float*)(wsp(C) + WS_MODS))[(size_t)(l * 9 + r) * 6144 + col0 + cc] = s + bmod[l * 6144 + col0 + cc]; }
            __syncthreads();
        }
    }
    {
        LAS float* scr = (LAS float*)(C.lds + 49152 + C.wave * 9216);
        constexpr int I_IN = 16 * 77, I_OUT = 16 * 32, I_UP = 16 * 176, I_DN = 44 * 32, I_UQ = 4 * 12, I_UKV = 2 * 16, I_L = I_IN + I_OUT + I_UP + I_DN + I_UQ + I_UKV;
        for (int it = C.gw; it < NL * I_L; it += C.NGW) {
            const int l = it / I_L; int r = it % I_L;
            if (r < I_IN) { const int kb = r / 77, nb = r % 77, n0 = nb * 32; transpose_item(inp(C, 7) + (size_t)l * DM * NIN, NIN, kb * 64, n0, wptr(C, l, W_IN), DM, 0, n0 < 416 ? n0 : n0 + 96, scr, C.lane); continue; } r -= I_IN;
            if (r < I_OUT) { const int kb = r / 32, nb = r % 32; transpose_item(inp(C, 8) + (size_t)l * DM * DM, DM, kb * 64, nb * 32, wptr(C, l, W_OUT), DM, 0, nb * 32, scr, C.lane); continue; } r -= I_OUT;
            if (r < I_UP) { const int kb = r / 176, nb = r % 176, n0 = nb * 32, bj = n0 >= DFF ? 1 : 0, j0 = n0 - bj * DFF;
                transpose_item(inp(C, 28) + (size_t)l * DM * NUP, NUP, kb * 64, n0, wptr(C, l, W_UP), DM, 0, 256 * (j0 >> 7) + 128 * bj + (j0 & 127), scr, C.lane); continue; } r -= I_UP;
            if (r < I_DN) { const int kb = r / 32, nb = r % 32; transpose_item(inp(C, 31) + (size_t)l * DFF * DM, DM, kb * 64, nb * 32, wptr(C, l, W_DOWN), DFF, 0, nb * 32, scr, C.lane); continue; } r -= I_DN;
            if (r < I_UQ) { const int kb = r / 12, nb = r % 12; transpose_item(inp(C, 10) + (size_t)l * 256 * 384, 384, kb * 64, nb * 32, wptr(C, l, W_MLA), KMLA, 0, nb * 32, scr, C.lane); continue; } r -= I_UQ;
            { const int kb = r / 16, nb = r % 16; transpose_item(inp(C, 12) + (size_t)l * 128 * 512, 512, kb * 64, nb * 32, wptr(C, l, W_MLA), KMLA, 256, 512 + nb * 32, scr, C.lane); }
        }
        const int gt = C.gw * 64 + C.lane, NGT = C.NGW * 64;
        const v4u z = {0u, 0u, 0u, 0u};
        for (int i = gt; i < NL * 96 * 128; i += NGT) { const int l = i / (96 * 128), r = i % (96 * 128); *(GAS v4u*)(wptr(C, l, W_IN) + (size_t)(416 + r / 128) * DM + (r % 128) * 8) = z; }
        for (int i = gt; i < NL * 1024 * 48; i += NGT) { const int l = i / (1024 * 48), r = (i / 48) % 1024, k = (i % 48) * 8;
            const bool zero = (r < 384) ? (k >= 256) : (r < 512) ? true : (k < 256);
            if (zero) *(GAS v4u*)(wptr(C, l, W_MLA) + (size_t)r * KMLA + k) = z; }
        float* r32 = (float*)(wsp(C) + WS_ROPE32); float* r64 = (float*)(wsp(C) + WS_ROPE64);
        for (int i = gt; i < 2048 * 48; i += NGT) {
            const int pos = i / 48, e = i % 48; const float row = (float)(pos >> 6), col = (float)(pos & 63);
            if (e < 16) { const int f = e & 7; const float inv = powf(10000.f, -(float)f / 8.f); const float a = (e < 8 ? row : col) * inv; r32[(pos * 16 + e) * 2] = cosf(a); r32[(pos * 16 + e) * 2 + 1] = sinf(a); }
            else { const int e2 = e - 16, f = e2 & 15; const float inv = powf(10000.f, -(float)f / 16.f); const float a = (e2 < 16 ? row : col) * inv; r64[(pos * 32 + e2) * 2] = cosf(a); r64[(pos * 32 + e2) * 2 + 1] = sinf(a); }
        }
    }
}

__device__ __forceinline__ void phase_norm(const int wv, int l, int which, int nrows) {
    const Ctx C = make_ctx(wv);
    const bool first = (l == 0 && which == 1);
    const float* xl = first ? inp(C, 0) : outp(C); const float* xc = first ? inp(C, 2) : ((float*)(wsp(C) + WS_XC));
    const float* gv = (which == 1 ? inp(C, 6) : inp(C, 27)) + l * DM;
    f32x4 g4[4];
#pragma unroll
    for (int j = 0; j < 4; ++j) g4[j] = *(const f32x4*)(gv + 4 * C.lane + 256 * j);
    for (int R = C.gw; R < nrows; R += C.NGW) {
        const float* src = R < ML ? xl + (size_t)R * DM : xc + (size_t)(R - ML) * DM;
        const int bidx = R < ML ? (R >> 11) : 8;
        const float* md = ((float*)(wsp(C) + WS_MODS)) + (size_t)(l * 9 + bidx) * 6144 + (which == 1 ? 0 : 3072);
        f32x4 v[4]; float ss = 0.f;
#pragma unroll
        for (int j = 0; j < 4; ++j) { v[j] = *(const f32x4*)(src + 4 * C.lane + 256 * j); ss += (v[j][0] * v[j][0] + v[j][1] * v[j][1]) + (v[j][2] * v[j][2] + v[j][3] * v[j][3]); }
        const float rs = 1.f / sqrtf(wave_sum(ss) * (1.f / DM) + EPS);
#pragma unroll
        for (int j = 0; j < 4; ++j) {
            const f32x4 sh = *(const f32x4*)(md + 4 * C.lane + 256 * j), sc = *(const f32x4*)(md + 1024 + 4 * C.lane + 256 * j);
            const f32x4 y = (v[j] * rs) * g4[j] * (sc + 1.f) + sh;
            u32x2v w; w.x = pk2(y[0], y[1]); w.y = pk2(y[2], y[3]);
            *(u32x2v*)(((bf16*)(wsp(C) + WS_XN)) + (size_t)R * DM + 4 * C.lane + 256 * j) = w;
        }
    }
}

__device__ __forceinline__ void row_info(int R, int& b, int& qi, int& pos) {
    if (R < ML) { b = R >> 11; qi = R & 2047; pos = qi; } else { const int r = R - ML; b = r >> 8; qi = 2048 + (r & 255); pos = -1; }
}
__device__ __forceinline__ float red_xor(float v, int maxo) { for (int o = 1; o <= maxo; o <<= 1) v += __shfl_xor(v, o); return v; }

__device__ __forceinline__ void phase_prep1(const int wv, int l) {
    const Ctx C = make_ctx(wv);
    LAS unsigned short* st = (LAS unsigned short*)(C.lds + C.wave * 8192);
    bf16* Q = ((bf16*)(wsp(C) + WS_QKV));
    const float* rope32 = (const float*)(wsp(C) + WS_ROPE32); const float* rope64 = (const float*)(wsp(C) + WS_ROPE64);
    const float C32 = 0.17677669529663687f * LOG2E, C64 = 0.125f * LOG2E;
    for (int R = C.gw; R < MT; R += C.NGW) {
        int b, qi, pos; row_info(R, b, qi, pos);
        {   const GAS v4u* src = (const GAS v4u*)(((bf16*)(wsp(C) + WS_P)) + (size_t)R * NINP);
#pragma unroll
            for (int i = 0; i < 5; ++i) ((LAS v4u*)st)[C.lane + 64 * i] = src[C.lane + 64 * i];
            LDS_WAIT(); asm volatile("" ::: "memory"); }
        const int lane = C.lane;
        float v[4];
        {   float ss = 0.f;
#pragma unroll
            for (int e = 0; e < 4; ++e) { v[e] = bf2f(st[PC_CQ + 4 * lane + e]); ss += v[e] * v[e]; }
            const float rs = 1.f / sqrtf(wave_sum(ss) * (1.f / 256.f) + EPS); const float* g = inp(C, 9) + l * 256 + 4 * lane;
            u32x2v w; w.x = pk2(v[0] * rs * g[0], v[1] * rs * g[1]); w.y = pk2(v[2] * rs * g[2], v[3] * rs * g[3]);
            *(u32x2v*)(((bf16*)(wsp(C) + WS_CQKV)) + (size_t)R * KMLA + 4 * lane) = w; }
        {   float ss = 0.f;
#pragma unroll
            for (int e = 0; e < 2; ++e) { v[e] = bf2f(st[PC_CKV + 2 * lane + e]); ss += v[e] * v[e]; }
            const float rs = 1.f / sqrtf(wave_sum(ss) * (1.f / 128.f) + EPS); const float* g = inp(C, 11) + l * 128 + 2 * lane;
            *(unsigned*)(((bf16*)(wsp(C) + WS_CQKV)) + (size_t)R * KMLA + 256 + 2 * lane) = pk2(v[0] * rs * g[0], v[1] * rs * g[1]); }
#pragma unroll
        for (int qk = 0; qk < 2; ++qk) {
            float ss = 0.f;
#pragma unroll
            for (int e = 0; e < 4; ++e) { v[e] = bf2f(st[(qk ? PC_DK : PC_DQ) + 4 * lane + e]); ss += v[e] * v[e]; }
            ss = red_xor(ss, 4);
            const float rs = 1.f / sqrtf(ss * (1.f / 32.f) + EPS);
            const int gi = lane >> 3, lg = lane & 7, d0 = 4 * lg; const float* g = inp(C, qk ? 16 : 15) + l * 32 + d0;
            float y[4];
#pragma unroll
            for (int e = 0; e < 4; ++e) y[e] = v[e] * rs * g[e];
#pragma unroll
            for (int e = 0; e < 4; ++e) { const float pr = __shfl_xor(y[e], 2);
                if (pos >= 0) { const int ti = ((lg & 4) ? 8 : 0) + 4 * (lg & 1) + e; const float cs = rope32[(pos * 16 + ti) * 2], sn = rope32[(pos * 16 + ti) * 2 + 1];
                    v[e] = (lg & 2) ? y[e] * cs + pr * sn : y[e] * cs - pr * sn; } else v[e] = y[e]; }
            if (qk == 0) { u32x2v w; w.x = pk2(v[0] * C32, v[1] * C32); w.y = pk2(v[2] * C32, v[3] * C32); *(u32x2v*)(Q + E_QD + q_off(8, 32, b, gi, qi) + d0) = w; }
            else { u32x2v w; w.x = pk2(v[0], v[1]); w.y = pk2(v[2], v[3]); *(u32x2v*)(Q + E_KD + k_off(8, 32, b, gi, qi, d0)) = w; }
        }
#pragma unroll
        for (int t = 0; t < 2; ++t) {
            const int h = lane >> 4, dv0 = 4 * (lane & 15);
#pragma unroll
            for (int e = 0; e < 4; ++e) (Q + (t ? E_VN : E_VD))[v_off(4, b, h, qi, dv0 + e)] = st[(t ? PC_NV : PC_DV) + 4 * lane + e];
        }
#pragma unroll
        for (int qk = 0; qk < 2; ++qk) {
            float ss = 0.f;
#pragma unroll
            for (int e = 0; e < 4; ++e) { v[e] = bf2f(st[(qk ? PC_NK : PC_NQ) + 4 * lane + e]); ss += v[e] * v[e]; }
            ss = red_xor(ss, 8);
            const float rs = 1.f / sqrtf(ss * (1.f / 64.f) + EPS);
            const int h = lane >> 4, d0 = 4 * (lane & 15); const float* g = inp(C, qk ? 23 : 22) + l * 64 + d0;
#pragma unroll
            for (int e = 0; e < 4; ++e) v[e] = v[e] * rs * g[e];
            if (qk == 0) { u32x2v w; w.x = pk2(v[0] * C64, v[1] * C64); w.y = pk2(v[2] * C64, v[3] * C64); *(u32x2v*)(Q + E_QN + q_off(4, 64, b, h, qi) + d0) = w; }
            else { u32x2v w; w.x = pk2(v[0], v[1]); w.y = pk2(v[2], v[3]); *(u32x2v*)(Q + E_KN + k_off(4, 64, b, h, qi, d0)) = w; }
        }
        {   float ss = 0.f;
#pragma unroll
            for (int e = 0; e < 4; ++e) { v[e] = bf2f(st[PC_GQ + 4 * lane + e]); ss += v[e] * v[e]; }
            ss = red_xor(ss, 8);
            const float rs = 1.f / sqrtf(ss * (1.f / 64.f) + EPS);
            const int h = lane >> 4, lh = lane & 15, d0 = 4 * lh; const float* g = inp(C, 25) + l * 64 + d0;
            float y[4];
#pragma unroll
            for (int e = 0; e < 4; ++e) y[e] = v[e] * rs * g[e];
#pragma unroll
            for (int e = 0; e < 4; ++e) { const float pr = __shfl_xor(y[e], 4);
                if (pos >= 0) { const int ti = ((lh & 8) ? 16 : 0) + 4 * (lh & 3) + e; const float cs = rope64[(pos * 32 + ti) * 2], sn = rope64[(pos * 32 + ti) * 2 + 1];
                    v[e] = (lh & 4) ? y[e] * cs + pr * sn : y[e] * cs - pr * sn; } else v[e] = y[e]; }
            u32x2v w; w.x = pk2(v[0] * C64, v[1] * C64); w.y = pk2(v[2] * C64, v[3] * C64); *(u32x2v*)(Q + E_QG + q_off(4, 64, b, h, qi) + d0) = w; }
        {   float ss = 0.f;
#pragma unroll
            for (int e = 0; e < 2; ++e) { v[e] = bf2f(st[PC_GK + 2 * lane + e]); ss += v[e] * v[e]; }
            ss = red_xor(ss, 16);
            const float rs = 1.f / sqrtf(ss * (1.f / 64.f) + EPS);
            const int h = lane >> 5, ll = lane & 31, d0 = 2 * ll; const float* g = inp(C, 26) + l * 64 + d0;
            float y[2];
#pragma unroll
            for (int e = 0; e < 2; ++e) y[e] = v[e] * rs * g[e];
#pragma unroll
            for (int e = 0; e < 2; ++e) { const float pr = __shfl_xor(y[e], 8);
                if (pos >= 0) { const int ti = ((ll & 16) ? 16 : 0) + 2 * (ll & 7) + e; const float cs = rope64[(pos * 32 + ti) * 2], sn = rope64[(pos * 32 + ti) * 2 + 1];
                    v[e] = (ll & 8) ? y[e] * cs + pr * sn : y[e] * cs - pr * sn; } else v[e] = y[e]; }
            *(unsigned*)(Q + E_KG + k_off(2, 64, b, h, qi, d0)) = pk2(v[0], v[1]); }
        {   const int h = lane >> 5, dv0 = 2 * (lane & 31);
#pragma unroll
            for (int e = 0; e < 2; ++e) (Q + E_VG)[v_off(2, b, h, qi, dv0 + e)] = st[PC_GV + 2 * lane + e]; }
        LDS_WAIT(); asm volatile("" ::: "memory");
    }
}

__device__ __forceinline__ void phase_prep2(const int wv, int l) {
    const Ctx C = make_ctx(wv);
    LAS unsigned short* st = (LAS unsigned short*)(C.lds + C.wave * 8192);
    bf16* Q = ((bf16*)(wsp(C) + WS_QKV));
    const float* rope32 = (const float*)(wsp(C) + WS_ROPE32);
    const float C96 = 0.10206207261596575f * LOG2E;
    for (int R = C.gw; R < MT; R += C.NGW) {
        int b, qi, pos; row_info(R, b, qi, pos);
        {   const GAS v4u* src = (const GAS v4u*)(((bf16*)(wsp(C) + WS_MLAP)) + (size_t)R * NMLA);
            ((LAS v4u*)st)[C.lane] = src[C.lane]; ((LAS v4u*)st)[C.lane + 64] = src[C.lane + 64];
            if (C.lane < 4) ((LAS v4u*)st)[128 + C.lane] = ((const GAS v4u*)(((bf16*)(wsp(C) + WS_P)) + (size_t)R * NINP + PC_KR))[C.lane];
            LDS_WAIT(); asm volatile("" ::: "memory"); }
        const int lane = C.lane, h = lane >> 4, li = lane & 15;
#pragma unroll
        for (int qk = 0; qk < 2; ++qk) {
            float v[6]; float ss = 0.f;
#pragma unroll
            for (int e = 0; e < 6; ++e) { v[e] = qk == 0 ? bf2f(st[h * 96 + li + 16 * e]) : (e < 4 ? bf2f(st[512 + h * 128 + li + 16 * e]) : bf2f(st[1024 + li + 16 * (e - 4)])); ss += v[e] * v[e]; }
            ss = red_xor(ss, 8);
            const float rs = 1.f / sqrtf(ss * (1.f / 96.f) + EPS); const float* g = inp(C, qk ? 14 : 13) + l * 96 + li;
#pragma unroll
            for (int e = 0; e < 6; ++e) v[e] = v[e] * rs * g[16 * e];
#pragma unroll
            for (int e = 4; e < 6; ++e) { const float pr = __shfl_xor(v[e], 8);
                if (pos >= 0) { const int ti = (e == 5 ? 8 : 0) + (li & 7); const float cs = rope32[(pos * 16 + ti) * 2], sn = rope32[(pos * 16 + ti) * 2 + 1];
                    v[e] = (li & 8) ? v[e] * cs + pr * sn : v[e] * cs - pr * sn; } }
            if (qk == 0) {
#pragma unroll
                for (int e = 0; e < 6; ++e) (Q + E_QA)[q_off(4, 96, b, h, qi) + li + 16 * e] = (bf16)f2bf(v[e] * C96);
            } else {
#pragma unroll
                for (int e = 0; e < 6; ++e) (Q + E_KA)[k_off(4, 96, b, h, qi, li + 16 * e)] = (bf16)f2bf(v[e]);
            }
        }
#pragma unroll
        for (int e = 0; e < 4; ++e) (Q + E_VA)[v_off(4, b, h, qi, li + 16 * e)] = st[512 + h * 128 + 64 + li + 16 * e];
        LDS_WAIT(); asm volatile("" ::: "memory");
    }
}

template <int DK, int HQ, int HK, int HV, bool NA>
__device__ __forceinline__ void naive_attn_one(const bf16* Qb, const bf16* Kb, const bf16* Vb, const float* rpb, int b, int hq, int hk, int hv, int qi, float (&o)[64]) {
    float q[DK];
    { const bf16* qp = Qb + q_off(HQ, DK, b, hq, qi);
#pragma unroll
      for (int c = 0; c < DK / 8; ++c) { const v4u w = *(const v4u*)(qp + 8 * c); q[8 * c] = bflo(w.x); q[8 * c + 1] = bfhi(w.x); q[8 * c + 2] = bflo(w.y); q[8 * c + 3] = bfhi(w.y); q[8 * c + 4] = bflo(w.z); q[8 * c + 5] = bfhi(w.z); q[8 * c + 6] = bflo(w.w); q[8 * c + 7] = bfhi(w.w); } }
    float m = -1e30f, ls = 0.f;
#pragma unroll
    for (int d = 0; d < 64; ++d) o[d] = 0.f;
    const bool isctx = qi >= SEQ;
    const int r = qi >> 6, qc = qi & 63;
    const int rs0 = min(max(r - 4, 0), 24), ws0 = min(max(qc - 8, 0), 48);
    const int nloc = isctx ? 0 : (NA ? 128 : SEQ);
    const int ntot = nloc + CTXL;
    for (int it = 0; it < ntot; ++it) {
        int key; float bias = 0.f;
        if (it < nloc) {
            if (NA) { const int kr = rs0 + (it >> 4), kc = ws0 + (it & 15); key = kr * 64 + kc; bias = rpb[(kr - r + 7) * 31 + min(max(kc - qc + 15, 0), 30)] * LOG2E; }
            else key = it;
        } else key = SEQ + (it - nloc);
        float s = bias;
#pragma unroll
        for (int c = 0; c < DK / 8; ++c) { const v4u w = *(const v4u*)(Kb + k_off(HK, DK, b, hk, key, 8 * c));
            s += q[8 * c] * bflo(w.x) + q[8 * c + 1] * bfhi(w.x) + q[8 * c + 2] * bflo(w.y) + q[8 * c + 3] * bfhi(w.y) + q[8 * c + 4] * bflo(w.z) + q[8 * c + 5] * bfhi(w.z) + q[8 * c + 6] * bflo(w.w) + q[8 * c + 7] * bfhi(w.w); }
        if (s > m) { const float a = exp2f(m - s); ls *= a;
#pragma unroll
            for (int d = 0; d < 64; ++d) o[d] *= a;
            m = s; }
        const float p = exp2f(s - m); ls += p;
        const bf16* vp = Vb + v_off(HV, b, hv, key, 0);
#pragma unroll
        for (int d = 0; d < 64; ++d) { o[d] += p * bf2f(vp[8 * d]); if ((d & 15) == 15) asm volatile("" ::: "memory"); }
    }
    const float inv = 1.f / ls;
#pragma unroll
    for (int d = 0; d < 64; ++d) o[d] *= inv;
}
__device__ __forceinline__ void store_mix(const Ctx& C, int b, int qi, int col0, const float (&o)[64]) {
    const size_t R = qi < SEQ ? (size_t)b * SEQ + qi : (size_t)ML + b * CTXL + (qi - SEQ);
    bf16* dst = ((bf16*)(wsp(C) + WS_MIX)) + R * DM + col0;
#pragma unroll
    for (int d = 0; d < 64; d += 8) { v4u w; w.x = pk2(o[d], o[d + 1]); w.y = pk2(o[d + 2], o[d + 3]); w.z = pk2(o[d + 4], o[d + 5]); w.w = pk2(o[d + 6], o[d + 7]); *(v4u*)(dst + d) = w; }
}
__device__ __forceinline__ void phase_attn_naive(const int wv, int l) {
    const Ctx C = make_ctx(wv);
    const bf16* Q = ((bf16*)(wsp(C) + WS_QKV));
    const int gt = C.gw * 64 + C.lane, NGT = C.NGW * 64;
    constexpr int PER = NB * 4 * NKEY;
    for (int idx = gt; idx < 5 * PER; idx += NGT) {
        const int mixer = idx < 3 * PER ? idx / PER : 3;
        const int r0 = mixer < 3 ? idx % PER : (idx - 3 * PER) >> 1, pair = idx & 1;
        const int b = r0 / (4 * NKEY), h = (r0 / NKEY) % 4, qi = r0 % NKEY;
        if (l == NL - 1 && qi >= SEQ) continue;
        float o[64];
        if (mixer == 0) { naive_attn_one<96, 4, 4, 4, false>(Q + E_QA, Q + E_KA, Q + E_VA, nullptr, b, h, h, h, qi, o); store_mix(C, b, qi, h * 64, o); }
        else if (mixer == 1) { naive_attn_one<64, 4, 4, 4, true>(Q + E_QN, Q + E_KN, Q + E_VN, inp(C, 24) + (size_t)(l * 4 + h) * 15 * 31, b, h, h, h, qi, o); store_mix(C, b, qi, 512 + h * 64, o); }
        else if (mixer == 2) { naive_attn_one<64, 4, 2, 2, false>(Q + E_QG, Q + E_KG, Q + E_VG, nullptr, b, h, h >> 1, h >> 1, qi, o); store_mix(C, b, qi, 768 + h * 64, o); }
        else {
            naive_attn_one<32, 8, 8, 4, false>(Q + E_QD, Q + E_KD, Q + E_VD, nullptr, b, 2 * h + pair, 2 * h + pair, h, qi, o);
            float s1 = 0.f, s2 = 0.f;
            for (int d = 0; d < 32; ++d) { s1 += inp(C, 17)[l * 32 + d] * inp(C, 18)[l * 32 + d]; s2 += inp(C, 19)[l * 32 + d] * inp(C, 20)[l * 32 + d]; }
            const float li = lambda_init(l), lam = expf(s1) - expf(s2) + li;
            float ss = 0.f;
#pragma unroll
            for (int d = 0; d < 64; ++d) { const float other = __shfl_xor(o[d], 1); o[d] = o[d] - lam * other; ss += o[d] * o[d]; }
            const float rs = 1.f / sqrtf(ss * (1.f / 64.f) + EPS);
#pragma unroll
            for (int d = 0; d < 64; ++d) o[d] = o[d] * rs * inp(C, 21)[l * 64 + d] * (1.f - li);
            if (pair == 0) store_mix(C, b, qi, 256 + h * 64, o);
        }
    }
}

__device__ __forceinline__ void phase_fixup(const int wv, int l) {
    const Ctx C = make_ctx(wv);
    const int gt = C.gw * 64 + C.lane, NGT = C.NGW * 64;
    const float* cw = inp(C, 29) + (size_t)l * 3 * NUP; const float* cb = inp(C, 30) + (size_t)l * NUP;
    for (int idx = gt; idx < 56 * 2 * DFF; idx += NGT) {
        const int j = idx % DFF, w = (idx / DFF) & 1, bi = idx / (2 * DFF), pm = (bi / 7) * 8 + (bi % 7);
        const float* h0 = ((float*)(wsp(C) + WS_HALO)) + (size_t)pm * 4 * NUP; const float* h1 = h0 + 4 * NUP;
        float cva[2];
#pragma unroll
        for (int t = 0; t < 2; ++t) { const int c = t * DFF + j;
            const float up = w == 0 ? h0[2 * NUP + c] : h0[3 * NUP + c], uc = w == 0 ? h0[3 * NUP + c] : h1[c], un = w == 0 ? h1[c] : h1[NUP + c];
            cva[t] = cw[c] * up + cw[NUP + c] * uc + cw[2 * NUP + c] * un + cb[c]; }
        const size_t row = (size_t)pm * 256 + 255 + w;
        ((bf16*)(wsp(C) + WS_ACT))[row * DFF + j] = (bf16)f2bf(pg8::silu1(cva[1]) * cva[0]);
    }
}

#ifndef MK_PER_PHASE
#define MK_PER_PHASE 1
#endif
constexpr int PH_PRO = 0, PH_NORM0 = 1, PH_L0 = 2, PH_PER_LAYER = 11;
constexpr int N_PHASES = PH_L0 + NL * PH_PER_LAYER - 1;
struct Args { const float* in[32]; float* out; unsigned char* ws; int ph_lo, ph_hi; };

__global__ void __launch_bounds__(NWAVES * 64, 2) fwd_kernel(Args args) {
    const int wv = __builtin_amdgcn_readfirstlane((int)threadIdx.x >> 6);
    const Ctx C = make_ctx(wv);
    for (int u = C.tid; u < 1024 / 4; u += NWAVES * 64) ((LAS unsigned*)(C.lds + LDSCTL_OFF))[u] = 0u;
    __syncthreads();
    if (C.tid < 34) ((LAS unsigned long long*)(C.lds + PT_OFF))[C.tid] = ((const __attribute__((address_space(4))) unsigned long long*)__builtin_amdgcn_kernarg_segment_ptr())[C.tid];
    volatile LAS unsigned* MISC = (volatile LAS unsigned*)(C.lds + MISC_OFF);
    __syncthreads();
    gu32* ctl = (gu32*)(wsp(C) + WS_CTL);
    XcdBarrier bar; bar.bar = (unsigned*)(ctl + CW_BAR); bar.x = 0; bar.st = nullptr; bar.wv = wv;
    const bool multi = (args.ph_hi - args.ph_lo) > 1;
    if (multi) { bar = xcd_barrier_post((unsigned*)(ctl + CW_BAR), MISC + 8); bar.wv = wv; }

    for (int ph = args.ph_lo; ph < args.ph_hi; ++ph) {
        if (ph == PH_PRO) phase_prologue(wv);
        else if (ph == PH_NORM0) phase_norm(wv, 0, 1, MT);
        else {
            const int l = (ph - PH_L0) / PH_PER_LAYER, s = (ph - PH_L0) % PH_PER_LAYER;
            const int Mrows = (l == NL - 1) ? ML : MT;
            if (s == 0 || s == 2) {
                const bool mla = s == 2;
                pg8::Gemm g{mla ? (bf16*)(wsp(C) + WS_CQKV) : (bf16*)(wsp(C) + WS_XN), wptr(C, l, mla ? W_MLA : W_IN), MT, mla ? NMLA : NINP, mla ? KMLA : DM}; pg8::StaticOrder S; S.init(MT, mla ? NMLA : NINP, C.G, (int)blockIdx.x);
                pg8::EpiBf16<0> E{mla ? (bf16*)(wsp(C) + WS_MLAP) : (bf16*)(wsp(C) + WS_P), mla ? NMLA : NINP, nullptr, 0, 0, 1.f};
                pg8::gemm_phase<pg8::EpiBf16<0>, pg8::StaticOrder, true, true>(C.lds + RING_OFF, g, S, E, wv);
            } else if (s == 1) phase_prep1(wv, l);
            else if (s == 3) phase_prep2(wv, l);
            else if (s == 4) phase_attn_naive(wv, l);
            else if (s == 5 || s == 9) {
                const bool dn = s == 9;
                pg8::Gemm g{dn ? (bf16*)(wsp(C) + WS_ACT) : (bf16*)(wsp(C) + WS_MIX), wptr(C, l, dn ? W_DOWN : W_OUT), Mrows, DM, dn ? DFF : DM}; pg8::StaticOrder S; S.init(Mrows, DM, C.G, (int)blockIdx.x);
                const bool first = (l == 0 && !dn);
                pg8::EpiResGate E{first ? inp(C, 0) : outp(C), first ? inp(C, 2) : (float*)(wsp(C) + WS_XC), outp(C), (float*)(wsp(C) + WS_XC), (float*)(wsp(C) + WS_MODS) + (size_t)l * 9 * 6144 + (dn ? 5120 : 2048)};
                pg8::gemm_phase<pg8::EpiResGate, pg8::StaticOrder, true, true>(C.lds + RING_OFF, g, S, E, wv);
            } else if (s == 6) phase_norm(wv, l, 2, Mrows);
            else if (s == 7) {
                pg8::Gemm g{(bf16*)(wsp(C) + WS_XN), wptr(C, l, W_UP), Mrows, NUP, DM}; pg8::StaticOrder S; S.init(Mrows, NUP, C.G, (int)blockIdx.x);
                pg8::EpiConvGate E{(bf16*)(wsp(C) + WS_ACT), (float*)(wsp(C) + WS_HALO), inp(C, 29) + (size_t)l * 3 * NUP, inp(C, 30) + (size_t)l * NUP, (PG8_LAS float*)(C.lds + EX_OFF)};
                pg8::gemm_phase<pg8::EpiConvGate, pg8::StaticOrder, true, true>(C.lds + RING_OFF, g, S, E, wv);
            } else if (s == 8) phase_fixup(wv, l);
            else phase_norm(wv, l + 1, 1, MT);
        }
        if (ph + 1 < args.ph_hi) { XcdBarrier bb = bar; asm volatile("" : "+s"(bb.bar), "+s"(bb.x)); xcd_barrier(bb); }
    }
}

extern "C" void kernel_launch(void* const* d_in, const int* in_sizes, int n_in, void* d_out, int out_size, void* d_ws, size_t ws_size, hipStream_t stream) {
    static int grid = 0;
    if (grid == 0) {
        if (n_in != 32 || out_size != ML * DM || ws_size < WS_END) { fprintf(stderr, "kernel_launch: unexpected shapes (n_in %d out %d ws %zu)\n", n_in, out_size, ws_size); grid = -1; return; }
        int dev = 0, cus = 0;
        if (hipGetDevice(&dev) != hipSuccess || hipDeviceGetAttribute(&cus, hipDeviceAttributeMultiprocessorCount, dev) != hipSuccess) { grid = -1; return; }
        if (hipFuncSetAttribute((const void*)fwd_kernel, hipFuncAttributeMaxDynamicSharedMemorySize, LDS_BYTES) != hipSuccess) { fprintf(stderr, "kernel_launch: hipFuncSetAttribute failed\n"); grid = -1; return; }
        (void)hipGetLastError();
        grid = cus;
    }
    if (grid < 0) return;
    (void)hipMemsetAsync((char*)d_ws + WS_CTL, 0, CTL_ZERO_BYTES, stream);
    Args a{};
    for (int i = 0; i < 32; ++i) a.in[i] = (const float*)d_in[i];
    a.out = (float*)d_out; a.ws = (unsigned char*)d_ws;
#if MK_PER_PHASE
    for (int ph = 0; ph < N_PHASES; ++ph) { a.ph_lo = ph; a.ph_hi = ph + 1; hipLaunchKernelGGL(fwd_kernel, dim3(grid), dim3(NWAVES * 64), LDS_BYTES, stream, a); }
#else
    a.ph_lo = 0; a.ph_hi = N_PHASES; hipLaunchKernelGGL(fwd_kernel, dim3(grid), dim3(NWAVES * 64), LDS_BYTES, stream, a);
#endif
}
```

```cpp
#include <hip/hip_runtime.h>
#include <cstdio>
#include <cstdint>
__device__ __forceinline__ int otid(int wv) { int l; asm volatile("v_mbcnt_lo_u32_b32 %0, -1, 0\n\tv_mbcnt_hi_u32_b32 %0, -1, %0" : "=v"(l)); return wv * 64 + l; }
namespace pg8 {
#define PG8_LAS __attribute__((address_space(3)))
typedef unsigned short bf16_t;
typedef short bf16x8 __attribute__((ext_vector_type(8)));
typedef float f32x4 __attribute__((ext_vector_type(4)));
typedef unsigned u32x4 __attribute__((ext_vector_type(4)));
constexpr int BM = 256, BK = 64, HALF = 128, HTB = HALF * BK * 2  , STAGE_BYTES = 8 * HTB, NXCD = 8, WGM = 8;

__host__ __device__ __forceinline__ int lds_byte(int r, int c) { const int st = (r >> 4) * 2 + (c >> 5), rr = r & 15, cc = c & 31, ob = rr * 64 + cc * 2; return st * 1024 + (ob ^ (((ob >> 9) & 1) << 5)); }
__host__ __device__ __forceinline__ void stage_rc(int b, int& R, int& C) { const int st = b / 1024, sb = b % 1024, swz = sb ^ (((sb >> 9) & 1) << 5); R = (st >> 1) * 16 + swz / 64; C = (st & 1) * 32 + (swz % 64) / 2; }
__host__ __device__ __forceinline__ int perm32(int rho) { const int n = rho >> 4, i = rho & 15; return 8 * (i >> 2) + 4 * n + (i & 3); }

struct Unit { int pm, pn; };
struct Gemm { const bf16_t* A; const bf16_t* Bt; int M, N, K; };

struct StaticOrder {
    int nM, nN, nwg, G, c;
    __host__ __device__ void init(int M, int N, int G_, int c_) { nM = M / BM; nN = N / BM; nwg = nM * nN; G = G_; c = c_; }
    __host__ __device__ bool next(int i, Unit& u) const {
        const long L = (long)i * G + c; if (L >= nwg) return false;
        int wgid = (int)L; { const int q = nwg / NXCD, r = nwg % NXCD, xcd = wgid % NXCD, off = wgid / NXCD; wgid = (xcd < r ? xcd * (q + 1) : r * (q + 1) + (xcd - r) * q) + off; }
        const int nig = WGM * nN, gid = wgid / nig, fm = gid * WGM, gsz = (nM - fm) < WGM ? (nM - fm) : WGM;
        u.pm = fm + ((wgid % nig) % gsz); u.pn = (wgid % nig) / gsz; return true;
    }
    __device__ __forceinline__ void a_ready(const Unit&) const {}
    __device__ __forceinline__ void done(const Unit&) const {}
};

__device__ __forceinline__ unsigned cvt_pk_bf16(float lo, float hi) { unsigned r; asm volatile("v_cvt_pk_bf16_f32 %0, %1, %2" : "=v"(r) : "v"(lo), "v"(hi)); return r; }
typedef float f32x2 __attribute__((ext_vector_type(2)));
__device__ __forceinline__ f32x2 gelu_pk(f32x2 v) {
    const f32x2 av = __builtin_elementwise_abs(v), d = av * 0.2316418882f + 1.0f;
    f32x2 t; t.x = __builtin_amdgcn_rcpf(d.x); t.y = __builtin_amdgcn_rcpf(d.y);
    f32x2 q = t * 0.5307027145f + (-0.7265760135f); q = q * t + 0.7107068705f; q = q * t + (-0.142248368f); q = q * t + 0.127414796f; q = q * t;
    const f32x2 s = (v * v) * (-0.72134752044f);
    f32x2 e; e.x = __builtin_amdgcn_exp2f(s.x); e.y = __builtin_amdgcn_exp2f(s.y);
    const f32x2 m = v * (q * e), r = v - m;
    f32x2 o; o.x = v.x < 0.f ? m.x : r.x; o.y = v.y < 0.f ? m.y : r.y; return o;
}

template <int ACT  > struct EpiBf16 {
    static constexpr bool PERM = true, AFTER_DRAIN = false; static_assert(ACT == 0 || ACT == 1, "EpiBf16: ACT is 0 (none) or 1 (gelu_pk)");
    bf16_t* O; int ldc; const float* bias; int split_cols; size_t split_stride; float scale0;
    __device__ __forceinline__ void operator()(const f32x4 (&acc)[2][2][4][2], const Unit& u, int wr, int wc, int fr, int fq) const {
        const int row0 = u.pm * BM + wr * 64 + fr; int colt = u.pn * BM; bf16_t* base = O;
        float sc = 1.f; if (split_cols) { const int t = colt / split_cols; base += (size_t)t * split_stride; colt -= t * split_cols; if (t == 0) sc = scale0; }
        const int col0 = colt + wc * 32 + 8 * fq, bcol0 = u.pn * BM + wc * 32 + 8 * fq;
        f32x4 bv[2][2];
#pragma unroll
        for (int bj = 0; bj < 2; ++bj)
#pragma unroll
            for (int n = 0; n < 2; ++n) bv[bj][n] = bias ? *(const f32x4*)(bias + bcol0 + bj * HALF + 4 * n) : (f32x4){0.f, 0.f, 0.f, 0.f};
#pragma unroll
        for (int ai = 0; ai < 2; ++ai)
#pragma unroll
            for (int m = 0; m < 4; ++m) { bf16_t* rowp = base + (size_t)(row0 + ai * HALF + m * 16) * ldc + col0;
#pragma unroll
                for (int bj = 0; bj < 2; ++bj) { f32x4 v0 = acc[ai][bj][m][0] + bv[bj][0], v1 = acc[ai][bj][m][1] + bv[bj][1];
                    if (ACT == 1) { f32x2 a = gelu_pk((f32x2){v0[0], v0[1]}), b = gelu_pk((f32x2){v0[2], v0[3]}), c = gelu_pk((f32x2){v1[0], v1[1]}), d = gelu_pk((f32x2){v1[2], v1[3]});
                        v0 = (f32x4){a.x, a.y, b.x, b.y}; v1 = (f32x4){c.x, c.y, d.x, d.y}; }
                    v0 = v0 * sc; v1 = v1 * sc; u32x4 w; w.x = cvt_pk_bf16(v0[0], v0[1]); w.y = cvt_pk_bf16(v0[2], v0[3]); w.z = cvt_pk_bf16(v1[0], v1[1]); w.w = cvt_pk_bf16(v1[2], v1[3]);
                    *(u32x4*)(rowp + bj * HALF) = w; } }
    }
};

struct PanelStats {
    unsigned* xbuf;
    unsigned* cnt;
    unsigned* tmo;
    int ntn; float eps;
    unsigned code;
    __device__ __forceinline__ bool run(const f32x4 (&v)[2][2][4][2], const Unit& u, int wr, int wc, int fr, int fq, PG8_LAS unsigned char* lds, int wid, int lane) const {
        typedef float f32x2v __attribute__((ext_vector_type(2)));
        PG8_LAS f32x2v* P = (PG8_LAS f32x2v*)lds;
        PG8_LAS f32x2v* S = (PG8_LAS f32x2v*)(lds + 8192);
        PG8_LAS unsigned* flag = (PG8_LAS unsigned*)(lds + 8192 + 2048);
#pragma unroll
        for (int ai = 0; ai < 2; ++ai)
#pragma unroll
            for (int m = 0; m < 4; ++m) {
                float s = 0.f;
#pragma unroll
                for (int bj = 0; bj < 2; ++bj)
#pragma unroll
                    for (int n = 0; n < 2; ++n) { const f32x4 x = v[ai][bj][m][n]; s += (x[0] + x[1]) + (x[2] + x[3]); }
                s += __shfl_xor(s, 16); s += __shfl_xor(s, 32);
                const float mw = s * (1.0f / 64.0f); float q = 0.f;
#pragma unroll
                for (int bj = 0; bj < 2; ++bj)
#pragma unroll
                    for (int n = 0; n < 2; ++n) { const f32x4 d = v[ai][bj][m][n] - mw; q += (d[0] * d[0] + d[1] * d[1]) + (d[2] * d[2] + d[3] * d[3]); }
                q += __shfl_xor(q, 16); q += __shfl_xor(q, 32);
                if (fq == 0) P[(ai * HALF + wr * 64 + m * 16 + fr) * 4 + wc] = (f32x2v){mw, q};
            }
        asm volatile("s_waitcnt lgkmcnt(0)" ::: "memory"); __builtin_amdgcn_s_barrier(); asm volatile("" ::: "memory");
#if defined(BROKEN_EXCHANGE_NO_WAIT)
#warning BROKEN CONTROL BUILD: the row-statistics exchange does not wait; results are wrong by design
        if (blockIdx.x >= 64) { const long long t0_ = clock64(); while (clock64() - t0_ < 60000) __builtin_amdgcn_s_sleep(8); }
#endif
        const int row = wid * 32 + (lane & 31);
        if (lane < 32) {
            const f32x2v a = P[row * 4 + 0], b = P[row * 4 + 1], c = P[row * 4 + 2], d = P[row * 4 + 3];
            const float mt = (a.x + b.x + c.x + d.x) * 0.25f;
            const float da = a.x - mt, db = b.x - mt, dc = c.x - mt, dd = d.x - mt;
            const float m2 = (a.y + b.y) + (c.y + d.y) + 64.0f * ((da * da + db * db) + (dc * dc + dd * dd));
            unsigned long long* slot = (unsigned long long*)xbuf + ((size_t)(u.pm * BM + row) * 4 + u.pn);
            __hip_atomic_store(slot, ((unsigned long long)__float_as_uint(m2) << 32) | __float_as_uint(mt), __ATOMIC_RELAXED, __HIP_MEMORY_SCOPE_AGENT);
        }
        asm volatile("s_waitcnt vmcnt(0)" ::: "memory");
        if (lane == 0) __hip_atomic_fetch_add(cnt + 64 * u.pm, 1u, __ATOMIC_RELAXED, __HIP_MEMORY_SCOPE_AGENT);
        if (wid == 0) {
            bool dead = false; const unsigned long long t0 = __builtin_amdgcn_s_memrealtime(); const unsigned want = 8u * (unsigned)ntn;
            for (;;) {
#if defined(BROKEN_EXCHANGE_NO_WAIT)
                break;
#endif
                if ((unsigned)__builtin_amdgcn_readfirstlane(__hip_atomic_load(cnt + 64 * u.pm, __ATOMIC_RELAXED, __HIP_MEMORY_SCOPE_AGENT)) >= want) break;
                if (__builtin_amdgcn_s_memrealtime() - t0 > 2000000ull) {
                    if (lane == 0) { unsigned expect = 0u; __hip_atomic_compare_exchange_strong(tmo + 1, &expect, code | (unsigned)(u.pm & 0xff), __ATOMIC_RELAXED, __ATOMIC_RELAXED, __HIP_MEMORY_SCOPE_AGENT);
                                     __hip_atomic_store(tmo, 1u, __ATOMIC_RELAXED, __HIP_MEMORY_SCOPE_AGENT); }
                    dead = true; break; }
                __builtin_amdgcn_s_sleep(2);
            }
            __builtin_amdgcn_fence(__ATOMIC_ACQUIRE, "agent");
            if (lane == 0) flag[0] = dead ? 1u : 0u;
        }
        asm volatile("s_waitcnt vmcnt(0) lgkmcnt(0)" ::: "memory"); __builtin_amdgcn_s_barrier(); asm volatile("" ::: "memory");
        const bool bad = flag[0] != 0u;
        if (lane < 32) {
            const unsigned long long* slot = (const unsigned long long*)xbuf + (size_t)(u.pm * BM + row) * 4; float mt[4], m2[4]; float ms = 0.f;
#pragma unroll
            for (int t = 0; t < 4; ++t) { if (t < ntn) { const unsigned long long w = __hip_atomic_load(slot + t, __ATOMIC_RELAXED, __HIP_MEMORY_SCOPE_AGENT); mt[t] = __uint_as_float((unsigned)w); m2[t] = __uint_as_float((unsigned)(w >> 32)); } else { mt[t] = 0.f; m2[t] = 0.f; } ms += mt[t]; }
            const float mean = ms / (float)ntn; float q = 0.f;
#pragma unroll
            for (int t = 0; t < 4; ++t) if (t < ntn) { const float dm = mt[t] - mean; q += m2[t] + 256.0f * dm * dm; }
            S[row] = (f32x2v){mean, 1.0f / sqrtf(q / (256.0f * (float)ntn) + eps)};
        }
        asm volatile("s_waitcnt lgkmcnt(0)" ::: "memory"); __builtin_amdgcn_s_barrier(); asm volatile("" ::: "memory");
        return bad;
    }
};
struct EpiLnRes {
    static constexpr bool PERM = false, AFTER_DRAIN = true;
    const float* base; float* out; int ldc; const float* bias; PanelStats st; unsigned poison;
    __device__ __forceinline__ void fused(f32x4 (&acc)[2][2][4][2], const Unit& u, int wr, int wc, int fr, int fq, PG8_LAS unsigned char* lds, int wid, int lane) const {
        typedef float f32x2v __attribute__((ext_vector_type(2)));
        const PG8_LAS f32x2v* S = (const PG8_LAS f32x2v*)(lds + 8192);
        const int col0 = u.pn * BM + wc * 32 + 4 * fq;
#pragma unroll
        for (int bj = 0; bj < 2; ++bj)
#pragma unroll
            for (int n = 0; n < 2; ++n) { const f32x4 bv = bias ? *(const f32x4*)(bias + col0 + bj * HALF + n * 16) : (f32x4){0.f, 0.f, 0.f, 0.f};
#pragma unroll
                for (int ai = 0; ai < 2; ++ai)
#pragma unroll
                    for (int m = 0; m < 4; ++m) acc[ai][bj][m][n] += bv; }
        f32x4 pre[4][2][2];
#pragma unroll
        for (int m = 0; m < 4; ++m) { const size_t off = (size_t)(u.pm * BM + wr * 64 + m * 16 + fr) * ldc + col0;
#pragma unroll
            for (int bj = 0; bj < 2; ++bj)
#pragma unroll
                for (int n = 0; n < 2; ++n) pre[m][bj][n] = *(const f32x4*)(base + off + bj * HALF + n * 16); }
        const bool bad = st.run(acc, u, wr, wc, fr, fq, lds, wid, lane) || poison != 0u;
        const float qnan = __builtin_nanf("");
#pragma unroll
        for (int ai = 0; ai < 2; ++ai)
#pragma unroll
            for (int m = 0; m < 4; ++m) { const int r = ai * HALF + wr * 64 + m * 16 + fr; const f32x2v sr = S[r]; const size_t off = (size_t)(u.pm * BM + r) * ldc + col0;
#pragma unroll
                for (int bj = 0; bj < 2; ++bj)
#pragma unroll
                    for (int n = 0; n < 2; ++n) { const f32x4 bs = ai == 0 ? pre[m][bj][n] : *(const f32x4*)(base + off + bj * HALF + n * 16); f32x4 o = bs + (acc[ai][bj][m][n] - sr.x) * sr.y;
                        if (bad) o = (f32x4){qnan, qnan, qnan, qnan}; *(f32x4*)(out + off + bj * HALF + n * 16) = o; }
                if (m & 1) asm volatile("" ::: "memory"); }
    }
};
struct EpiLnResLn {
    static constexpr bool PERM = false, AFTER_DRAIN = true;
    const float* base; float* out; bf16_t* xn; int ldc; const float* bias; PanelStats st1, st2; unsigned poison;
    __device__ __forceinline__ void fused(f32x4 (&acc)[2][2][4][2], const Unit& u, int wr, int wc, int fr, int fq, PG8_LAS unsigned char* lds, int wid, int lane) const {
        typedef float f32x2v __attribute__((ext_vector_type(2))); typedef unsigned u32x2v __attribute__((ext_vector_type(2)));
        const PG8_LAS f32x2v* S = (const PG8_LAS f32x2v*)(lds + 8192);
        const int col0 = u.pn * BM + wc * 32 + 4 * fq;
#pragma unroll
        for (int bj = 0; bj < 2; ++bj)
#pragma unroll
            for (int n = 0; n < 2; ++n) { const f32x4 bv = bias ? *(const f32x4*)(bias + col0 + bj * HALF + n * 16) : (f32x4){0.f, 0.f, 0.f, 0.f};
#pragma unroll
                for (int ai = 0; ai < 2; ++ai)
#pragma unroll
                    for (int m = 0; m < 4; ++m) acc[ai][bj][m][n] += bv; }
        bool bad = st1.run(acc, u, wr, wc, fr, fq, lds, wid, lane) || poison != 0u;
        const float qnan = __builtin_nanf("");
#pragma unroll
        for (int ai = 0; ai < 2; ++ai)
#pragma unroll
            for (int m = 0; m < 4; ++m) { const int r = ai * HALF + wr * 64 + m * 16 + fr; const f32x2v sr = S[r]; const size_t off = (size_t)(u.pm * BM + r) * ldc + col0;
#pragma unroll
                for (int bj = 0; bj < 2; ++bj)
#pragma unroll
                    for (int n = 0; n < 2; ++n) { const f32x4 bs = *(const f32x4*)(base + off + bj * HALF + n * 16); acc[ai][bj][m][n] = bs + (acc[ai][bj][m][n] - sr.x) * sr.y; }
                asm volatile("" : "+v"(acc[ai][0][m][0]), "+v"(acc[ai][0][m][1]), "+v"(acc[ai][1][m][0]), "+v"(acc[ai][1][m][1]));
                if (m & 1) asm volatile("" ::: "memory"); }
        const bool bad1 = bad;
        bad = st2.run(acc, u, wr, wc, fr, fq, lds, wid, lane) || bad;
#pragma unroll
        for (int ai = 0; ai < 2; ++ai)
#pragma unroll
            for (int m = 0; m < 4; ++m) { const int r = ai * HALF + wr * 64 + m * 16 + fr; const f32x2v sr = S[r]; const size_t off = (size_t)(u.pm * BM + r) * ldc + col0;
#pragma unroll
                for (int bj = 0; bj < 2; ++bj)
#pragma unroll
                    for (int n = 0; n < 2; ++n) { const f32x4 x1 = acc[ai][bj][m][n]; *(f32x4*)(out + off + bj * HALF + n * 16) = bad1 ? (f32x4){qnan, qnan, qnan, qnan} : x1;
                        const f32x4 o = (x1 - sr.x) * sr.y; u32x2v w; w.x = cvt_pk_bf16(o[0], o[1]); w.y = cvt_pk_bf16(o[2], o[3]);
                        if (bad) { w.x = 0x7fc07fc0u; w.y = 0x7fc07fc0u; } *(u32x2v*)(xn + off + bj * HALF + n * 16) = w; }
                asm volatile("" ::: "memory"); }
    }
};

template <class Epi, class Sched, bool ALIGN_EPI = false, bool SP2 = false>
__device__ __forceinline__ void gemm_phase(PG8_LAS unsigned char* lds, const Gemm g, const Sched& S, const Epi& E, const int wv) {
    const int tid = otid(wv), wid = __builtin_amdgcn_readfirstlane(tid >> 6), lane = tid & 63, wr = wid >> 2, wc = wid & 3, fr = lane & 15, fq = lane >> 4;
    const int K = g.K, nt = K / BK;
    unsigned voffA[2], voffB[2];
#pragma unroll
    for (int i = 0; i < 2; ++i) { int R, C; stage_rc(tid * 16 + i * 8192, R, C); const int Rb = Epi::PERM ? ((R & ~31) + perm32(R & 31)) : R;
        voffA[i] = (unsigned)(R * K + C) * 2u; voffB[i] = (unsigned)(Rb * K + C) * 2u; }
    const size_t kstep = (size_t)(BK * 2);
    const size_t hstep = (size_t)HALF * K * 2;
    const size_t tstep = 2 * hstep;
    const unsigned ldsw = (unsigned)wid * 1024u;
    const int aoff = lds_byte(wr * 64 + fr, fq * 8), boff = lds_byte(wc * 32 + fr, fq * 8);
#define PG8_SA(b, h) (((b) * 2 + (h)) * HTB)
#define PG8_SB(b, h) ((4 + (b) * 2 + (h)) * HTB)
#define PG8_STAGE(bufoff, gbase, voff) do { _Pragma("unroll") for (int _i = 0; _i < 2; ++_i) \
        __builtin_amdgcn_global_load_lds((const unsigned*)((const char*)(gbase) + (voff)[_i]), (PG8_LAS unsigned*)(lds + (bufoff) + ldsw + _i * 8192), 16, 0, 0); } while (0)
#define PG8_LDA(dst, b, h) do { _Pragma("unroll") for (int m = 0; m < 4; ++m) _Pragma("unroll") for (int k = 0; k < 2; ++k) dst[m][k] = *(const PG8_LAS bf16x8*)(lds + PG8_SA(b, h) + aoff + m * 2048 + k * 1024); } while (0)
#define PG8_LDB(dst, b, h) do { _Pragma("unroll") for (int n = 0; n < 2; ++n) _Pragma("unroll") for (int k = 0; k < 2; ++k) dst[n][k] = *(const PG8_LAS bf16x8*)(lds + PG8_SB(b, h) + boff + n * 2048 + k * 1024); } while (0)
#define PG8_MMA(ai, bj, At, Bt) do { __builtin_amdgcn_s_setprio(1); _Pragma("unroll") for (int m = 0; m < 4; ++m) _Pragma("unroll") for (int n = 0; n < 2; ++n) _Pragma("unroll") for (int k = 0; k < 2; ++k) \
        acc[ai][bj][m][n] = __builtin_amdgcn_mfma_f32_16x16x32_bf16(Bt[n][k], At[m][k], acc[ai][bj][m][n], 0, 0, 0); __builtin_amdgcn_s_setprio(0); } while (0)
#define PG8_WAIT_V(n) asm volatile("s_waitcnt vmcnt(" #n ")" ::: "memory")
#define PG8_WAIT_L(n) asm volatile("s_waitcnt lgkmcnt(" #n ")" ::: "memory")
#define PG8_BAR __builtin_amdgcn_s_barrier()
#define PG8_SCHED __builtin_amdgcn_sched_barrier(0)
    Unit cur, nxt; int ui = 0;
    if (!S.next(0, cur)) return;
    f32x4 acc[2][2][4][2];
#pragma unroll
    for (int a = 0; a < 2; ++a)
#pragma unroll
        for (int b = 0; b < 2; ++b)
#pragma unroll
            for (int m = 0; m < 4; ++m)
#pragma unroll
                for (int n = 0; n < 2; ++n) acc[a][b][m][n] = (f32x4){0.f, 0.f, 0.f, 0.f};
    bf16x8 At[4][2], B0[2][2], B1[2][2];
    const char* cA = (const char*)g.A + (size_t)cur.pm * tstep; const char* cB = (const char*)g.Bt + (size_t)cur.pn * tstep;
    S.a_ready(cur);
    if constexpr (SP2) {
        PG8_STAGE(PG8_SB(0, 0), cB, voffB); PG8_STAGE(PG8_SB(0, 1), cB + hstep, voffB); PG8_STAGE(PG8_SA(0, 0), cA, voffA); PG8_STAGE(PG8_SA(0, 1), cA + hstep, voffA);
        if (wr == 1) PG8_BAR;
        PG8_WAIT_V(2); PG8_BAR;
        PG8_STAGE(PG8_SB(1, 0), cB + kstep, voffB); PG8_STAGE(PG8_SA(1, 0), cA + kstep, voffA); PG8_STAGE(PG8_SB(1, 1), cB + hstep + kstep, voffB);
        PG8_WAIT_V(6); PG8_BAR;
    } else {
        PG8_STAGE(PG8_SB(0, 0), cB, voffB); PG8_STAGE(PG8_SA(0, 0), cA, voffA); PG8_STAGE(PG8_SB(0, 1), cB + hstep, voffB); PG8_STAGE(PG8_SA(0, 1), cA + hstep, voffA);
        if (wr == 1) PG8_BAR;
        PG8_WAIT_V(4); PG8_BAR;
        PG8_STAGE(PG8_SB(1, 0), cB + kstep, voffB); PG8_STAGE(PG8_SA(1, 0), cA + kstep, voffA); PG8_STAGE(PG8_SB(1, 1), cB + hstep + kstep, voffB);
        PG8_WAIT_V(6); PG8_BAR;
    }
    for (;;) {
        const bool has_next = S.next(ui + 1, nxt);
        const char* nA = has_next ? (const char*)g.A + (size_t)nxt.pm * tstep : cA; const char* nB = has_next ? (const char*)g.Bt + (size_t)nxt.pn * tstep : cB;
        for (int t = 0; t < nt; t += 2) {
            const bool last = (t == nt - 2);
            const char* a1 = cA + (size_t)(t + 1) * kstep;
            const char* a2 = last ? nA : cA + (size_t)(t + 2) * kstep; const char* b2 = last ? nB : cB + (size_t)(t + 2) * kstep;
            const char* a3 = a2 + kstep; const char* b3 = b2 + kstep;
            if (last && has_next) S.a_ready(nxt);
            if constexpr (SP2) {
            PG8_LDB(B0, 0, 0); PG8_LDB(B1, 0, 1); PG8_SCHED; PG8_LDA(At, 0, 0); PG8_STAGE(PG8_SA(1, 1), a1 + hstep, voffA);
            PG8_WAIT_V(8); PG8_WAIT_L(0); PG8_BAR; PG8_MMA(0, 0, At, B0); PG8_MMA(0, 1, At, B1); PG8_BAR; PG8_SCHED;
            PG8_LDA(At, 0, 1); PG8_STAGE(PG8_SB(0, 0), b2, voffB); PG8_STAGE(PG8_SB(0, 1), b2 + hstep, voffB); PG8_STAGE(PG8_SA(0, 0), a2, voffA);
            PG8_WAIT_V(8); PG8_WAIT_L(0); PG8_BAR; PG8_MMA(1, 0, At, B0); PG8_MMA(1, 1, At, B1); PG8_BAR; PG8_SCHED;
            PG8_LDB(B0, 1, 0); PG8_LDB(B1, 1, 1); PG8_SCHED; PG8_LDA(At, 1, 0); PG8_STAGE(PG8_SA(0, 1), a2 + hstep, voffA);
            PG8_WAIT_V(8); PG8_WAIT_L(0); PG8_BAR; PG8_MMA(0, 0, At, B0); PG8_MMA(0, 1, At, B1); PG8_BAR; PG8_SCHED;
            PG8_LDA(At, 1, 1); PG8_STAGE(PG8_SB(1, 0), b3, voffB); PG8_STAGE(PG8_SB(1, 1), b3 + hstep, voffB); PG8_STAGE(PG8_SA(1, 0), a3, voffA);
            PG8_WAIT_V(8); PG8_WAIT_L(0); PG8_BAR; PG8_MMA(1, 0, At, B0); PG8_MMA(1, 1, At, B1); PG8_BAR; PG8_SCHED;
            } else {
            PG8_LDB(B0, 0, 0); PG8_SCHED; PG8_LDA(At, 0, 0); PG8_STAGE(PG8_SA(1, 1), a1 + hstep, voffA);
            PG8_WAIT_L(8); PG8_BAR; PG8_WAIT_L(0); PG8_MMA(0, 0, At, B0); PG8_BAR; PG8_SCHED;
            PG8_LDB(B1, 0, 1); PG8_STAGE(PG8_SB(0, 0), b2, voffB);
            PG8_BAR; PG8_WAIT_L(0); PG8_MMA(0, 1, At, B1); PG8_BAR;
            PG8_LDA(At, 0, 1); PG8_STAGE(PG8_SA(0, 0), a2, voffA);
            PG8_BAR; PG8_WAIT_L(0); PG8_MMA(1, 0, At, B0); PG8_BAR; PG8_SCHED;
            PG8_STAGE(PG8_SB(0, 1), b2 + hstep, voffB);
            PG8_WAIT_V(6); PG8_BAR; PG8_MMA(1, 1, At, B1); PG8_BAR;
            PG8_LDB(B0, 1, 0); PG8_SCHED; PG8_LDA(At, 1, 0); PG8_STAGE(PG8_SA(0, 1), a2 + hstep, voffA);
            PG8_WAIT_L(8); PG8_BAR; PG8_WAIT_L(0); PG8_MMA(0, 0, At, B0); PG8_BAR; PG8_SCHED;
            PG8_LDB(B1, 1, 1); PG8_STAGE(PG8_SB(1, 0), b3, voffB);
            PG8_BAR; PG8_WAIT_L(0); PG8_MMA(0, 1, At, B1); PG8_BAR;
            PG8_LDA(At, 1, 1); PG8_STAGE(PG8_SA(1, 0), a3, voffA);
            PG8_BAR; PG8_WAIT_L(0); PG8_MMA(1, 0, At, B0); PG8_BAR; PG8_SCHED;
            PG8_STAGE(PG8_SB(1, 1), b3 + hstep, voffB);
            PG8_WAIT_V(6); PG8_BAR; PG8_MMA(1, 1, At, B1); PG8_BAR;
            }
        }
        if constexpr (ALIGN_EPI) { if (wr == 0) PG8_BAR; }
        if constexpr (!Epi::AFTER_DRAIN) { E(acc, cur, wr, wc, fr, fq); S.done(cur); }
        if (!has_next) break;
#pragma unroll
        for (int a = 0; a < 2; ++a)
#pragma unroll
            for (int b = 0; b < 2; ++b)
#pragma unroll
                for (int m = 0; m < 4; ++m)
#pragma unroll
                    for (int n = 0; n < 2; ++n) acc[a][b][m][n] = (f32x4){0.f, 0.f, 0.f, 0.f};
        cur = nxt; cA = nA; cB = nB; ++ui;
        if constexpr (ALIGN_EPI) { if (wr == 1) PG8_BAR; }
    }
    PG8_WAIT_V(0);
    if constexpr (!ALIGN_EPI) { if (wr == 0) PG8_BAR; }
    PG8_BAR;
    if constexpr (Epi::AFTER_DRAIN) { E.fused(acc, cur, wr, wc, fr, fq, lds, wid, lane); S.done(cur); }
#undef PG8_SA
#undef PG8_SB
#undef PG8_STAGE
#undef PG8_LDA
#undef PG8_LDB
#undef PG8_MMA
#undef PG8_WAIT_V
#undef PG8_WAIT_L
#undef PG8_BAR
#undef PG8_SCHED
}
}

#ifndef PG8_SP2
#define PG8_SP2 true
#endif
#ifndef PG8_ALIGN
#define PG8_ALIGN true
#endif
#define GAS __attribute__((address_space(1)))
#define LAS __attribute__((address_space(3)))
typedef unsigned short bf16;
typedef unsigned v4u __attribute__((ext_vector_type(4)));
typedef float f32x4 __attribute__((ext_vector_type(4)));
typedef short bf16x8 __attribute__((ext_vector_type(8)));
typedef GAS unsigned gu32;
typedef GAS unsigned long long gu64;
#define RLX_AGENT __ATOMIC_RELAXED, __HIP_MEMORY_SCOPE_AGENT
#define LDS_WAIT() asm volatile("s_waitcnt lgkmcnt(0)" ::: "memory")
#define VM_WAIT() asm volatile("s_waitcnt vmcnt(0)" ::: "memory")
__device__ __forceinline__ unsigned long long rt() { return __builtin_amdgcn_s_memrealtime(); }
__device__ __forceinline__ unsigned f2bf(float f) { unsigned u = __builtin_bit_cast(unsigned, f); return (u + 0x7fffu + ((u >> 16) & 1u)) >> 16; }
__device__ __forceinline__ unsigned pk2(float lo, float hi) { return f2bf(lo) | (f2bf(hi) << 16); }

#define XB_TMO      128
#define XB_XCNT(j)  (256  + 64 * (j))
#define XB_XSUB(j)  (1280 + 64 * (j))
#define XB_XGEN(j)  (2304 + 64 * (j))
#define XB_TOP      3328
#define XB_TOPGEN   3392
#define XCD_BAR_WORDS 3456
#define XB_SPIN_CAP (1u << 18)

__device__ __forceinline__ unsigned xb_ld(unsigned* p)              { return __hip_atomic_load(p, __ATOMIC_RELAXED, __HIP_MEMORY_SCOPE_AGENT); }
__device__ __forceinline__ unsigned xb_add(unsigned* p, unsigned v) { return __hip_atomic_fetch_add(p, v, __ATOMIC_RELAXED, __HIP_MEMORY_SCOPE_AGENT); }
__device__ __forceinline__ unsigned xb_xcc_id() { return (unsigned)__builtin_amdgcn_s_getreg((3 << 11) | 20) & 0xFu; }
#define XB_SPIN(cond, bar) do { unsigned _sp = 0; while (cond) { __builtin_amdgcn_s_sleep(1); \
    if ((++_sp & 255u) == 0u) { if (xb_ld(&(bar)[XB_TMO])) break; if (_sp > XB_SPIN_CAP) { atomicAdd(&(bar)[XB_TMO], 1u); break; } } } } while (0)

struct XcdBarrier {
    unsigned* bar; unsigned x;
    volatile LAS unsigned* st;
    int wv;
};

__device__ __forceinline__ XcdBarrier xcd_barrier_post(unsigned* bar, volatile LAS unsigned* st) {
    XcdBarrier b; b.bar = bar; b.x = xb_xcc_id(); b.st = st;
    if (threadIdx.x == 0) (void)xb_add(&bar[XB_XCNT(b.x)], 1u);
    return b;
}
__device__ __forceinline__ void xcd_barrier_complete(unsigned* bar, unsigned x, unsigned& nloc, unsigned& nx) {
    const unsigned G = gridDim.x * gridDim.y * gridDim.z;
    unsigned sum, cnt, mine, sp = 0u;
    for (;;) {
        sum = 0u; cnt = 0u; mine = 0u;
#pragma unroll
        for (unsigned j = 0; j < 16; ++j) { const unsigned c = xb_ld(&bar[XB_XCNT(j)]); sum += c; cnt += (c > 0u) ? 1u : 0u; mine = (j == x) ? c : mine; }
        if (sum == G) break;
        __builtin_amdgcn_s_sleep(1);
        if ((++sp & 255u) == 0u) { if (xb_ld(&bar[XB_TMO])) break; if (sp > XB_SPIN_CAP) { atomicAdd(&bar[XB_TMO], 1u); break; } }
    }
    nloc = mine > 0u ? mine : 1u; nx = cnt > 0u ? cnt : 1u;
}

__device__ __forceinline__ void xcd_barrier(const XcdBarrier& b) {
    asm volatile("s_waitcnt vmcnt(0)" ::: "memory");
    __syncthreads();
    if (otid(b.wv) == 0) {
        unsigned* bar = b.bar;
        __builtin_amdgcn_s_waitcnt(0);
        unsigned nloc = b.st[0], nx = b.st[1];
        if (nloc == 0u) { xcd_barrier_complete(bar, b.x, nloc, nx); b.st[0] = nloc; b.st[1] = nx; }
        const unsigned old = xb_add(&bar[XB_XSUB(b.x)], 1u);
        const unsigned gen = old / nloc;
        if (old + 1u == (gen + 1u) * nloc) {
            __builtin_amdgcn_fence(__ATOMIC_RELEASE, "agent");
            asm volatile("s_waitcnt vmcnt(0)" ::: "memory");
            const unsigned og = xb_add(&bar[XB_TOP], 1u);
            const unsigned tg = og / nx;
            if (og + 1u == (tg + 1u) * nx) xb_add(&bar[XB_TOPGEN], 1u);
            else XB_SPIN(xb_ld(&bar[XB_TOPGEN]) == tg, bar);
            __builtin_amdgcn_fence(__ATOMIC_ACQUIRE, "agent");
            xb_add(&bar[XB_XGEN(b.x)], 1u);
            asm volatile("s_waitcnt vmcnt(0)" ::: "memory");
        } else {
            XB_SPIN(xb_ld(&bar[XB_XGEN(b.x)]) == gen, bar);
            __builtin_amdgcn_fence(__ATOMIC_ACQUIRE, "agent");
            asm volatile("s_waitcnt vmcnt(0)" ::: "memory");
        }
    }
    __syncthreads();
}


constexpr int NB = 8, SEQ = 2048, CTXL = 256, DM = 1024, NL = 4;
constexpr int ML = NB * SEQ, MC = NB * CTXL, MT = ML + MC;
constexpr int NIN = 2464, NINP = 2560, DFF = 2816, NUP = 5632, KMLA = 384, NMLA = 1024;
constexpr int NKEY = SEQ + CTXL, NKT = NKEY / 64;
constexpr float EPS = 1e-6f;
constexpr float LOG2E = 1.4426950408889634f;
constexpr int PC_CQ = 0, PC_CKV = 256, PC_KR = 384, PC_DQ = 512, PC_DK = 768, PC_DV = 1024, PC_NQ = 1280, PC_NK = 1536, PC_NV = 1792, PC_GQ = 2048, PC_GK = 2304, PC_GV = 2432;

constexpr size_t MiB = 1u << 20;
constexpr size_t WS_CTL = 0, CTL_ZERO_BYTES = 1 * MiB;
constexpr size_t WS_MODS = 1 * MiB;
constexpr size_t WS_ROPE32 = 2 * MiB;
constexpr size_t WS_ROPE64 = 2 * MiB + 262144;
constexpr size_t WS_W = 3 * MiB;
constexpr size_t W_IN = 0, W_OUT = W_IN + (size_t)NINP * DM * 2, W_UP = W_OUT + (size_t)DM * DM * 2, W_DOWN = W_UP + (size_t)NUP * DM * 2, W_MLA = W_DOWN + (size_t)DM * DFF * 2, W_LAYER = W_MLA + (size_t)NMLA * KMLA * 2;
static_assert(W_LAYER == 25427968, "weights per layer");
constexpr size_t WS_XC = 100 * MiB;
constexpr size_t WS_R2 = 108 * MiB;
constexpr size_t WS_XN = WS_R2, WS_MLAP = WS_R2, WS_CQKV = WS_R2 + 36 * MiB;
constexpr size_t WS_R1 = 158 * MiB;
constexpr size_t WS_P = WS_R1, WS_QKV = WS_R1 + 90 * MiB, WS_MIX = WS_R1, WS_ACT = WS_R1, WS_HALO = WS_R1 + 100 * MiB;
constexpr size_t WS_END = WS_R1 + 198 * MiB;
static_assert(WS_W + NL * W_LAYER <= WS_XC, "weights fit");
static_assert((size_t)MT * NINP * 2 <= 90 * MiB && (size_t)MT * DFF * 2 <= 100 * MiB && (size_t)72 * 4 * NUP * 4 <= 8 * MiB, "R1 map");
constexpr size_t E_QA = 0, E_KA = E_QA + (size_t)NB * 4 * NKEY * 96, E_VA = E_KA + (size_t)NB * 4 * NKEY * 96, E_QD = E_VA + (size_t)NB * 4 * NKEY * 64,
                 E_KD = E_QD + (size_t)NB * 8 * NKEY * 32, E_VD = E_KD + (size_t)NB * 8 * NKEY * 32, E_QN = E_VD + (size_t)NB * 4 * NKEY * 64, E_KN = E_QN + (size_t)NB * 4 * NKEY * 64,
                 E_VN = E_KN + (size_t)NB * 4 * NKEY * 64, E_QG = E_VN + (size_t)NB * 4 * NKEY * 64, E_KG = E_QG + (size_t)NB * 4 * NKEY * 64, E_VG = E_KG + (size_t)NB * 2 * NKEY * 64,
                 E_END = E_VG + (size_t)NB * 2 * NKEY * 64;
static_assert(E_END * 2 <= 108 * MiB, "QKV map");
constexpr int CW_TMO = 0, CW_CODE = 1, CW_BAR = 4096;

constexpr int RING_OFF = 0, RING_BYTES = 131072;
constexpr int LDSCTL_OFF = RING_BYTES, MISC_OFF = LDSCTL_OFF + 320;
constexpr int EX_OFF = RING_BYTES + 1024;
constexpr int LDS_BYTES = 147456;
static_assert(EX_OFF + 8192 <= LDS_BYTES, "LDS map");
constexpr int NWAVES = 8;

typedef float f32x2v __attribute__((ext_vector_type(2)));
typedef unsigned u32x2v __attribute__((ext_vector_type(2)));

__device__ __forceinline__ float bf2f(unsigned short v) { return __uint_as_float((unsigned)v << 16); }
__device__ __forceinline__ float bflo(unsigned w) { return __uint_as_float(w << 16); }
__device__ __forceinline__ float bfhi(unsigned w) { return __uint_as_float(w & 0xffff0000u); }
__device__ __forceinline__ float wave_sum(float v) {
#pragma unroll
    for (int o = 1; o < 64; o <<= 1) v += __shfl_xor(v, o);
    return v;
}
__device__ __forceinline__ float silu_f(float x) { return x / (1.f + __expf(-x)); }

__device__ __forceinline__ size_t q_off(int H, int DK, int b, int h, int q) { return ((size_t)(b * H + h) * NKEY + q) * DK; }
__device__ __forceinline__ size_t k_off(int H, int DK, int b, int h, int key, int d) { return ((((size_t)(b * H + h) * NKT + (key >> 6)) * (DK >> 3) + (d >> 3)) * 64 + (key & 63)) * 8 + (d & 7); }
__device__ __forceinline__ size_t v_off(int H, int b, int h, int key, int dv) {
    const int kk = key & 63, s = kk >> 4, i = kk & 15, hh = (i >> 2) & 1, j = (i & 3) + 4 * (i >> 3);
    return ((((size_t)(b * H + h) * NKT + (key >> 6)) * 8 + (s * 2 + hh)) * 64 + dv) * 8 + j;
}

constexpr int PT_OFF = LDSCTL_OFF + 512;
struct Ctx {
    LAS unsigned char* lds;
    int tid, lane, wave, G, gw, NGW;
};
extern __shared__ __attribute__((aligned(16))) unsigned char lds_raw[];
__device__ __forceinline__ Ctx make_ctx(const int wv) {
    unsigned zl = 0; asm volatile("" : "+s"(zl));
    Ctx C; C.lds = (LAS unsigned char*)lds_raw + zl;
    const int t = otid(wv);
    C.tid = t; C.lane = t & 63; C.wave = wv;
    C.G = gridDim.x; { const int bx = blockIdx.x; const int vcu = (C.G % 8 == 0) ? (bx % 8) * (C.G / 8) + bx / 8 : bx; C.gw = vcu * NWAVES + C.wave; } C.NGW = C.G * NWAVES;
    return C;
}
__device__ __forceinline__ unsigned long long ptab(const Ctx& C, int i) {
    const unsigned long long p = ((const LAS unsigned long long*)(C.lds + PT_OFF))[i];
    const unsigned lo = __builtin_amdgcn_readfirstlane((unsigned)p), hi = __builtin_amdgcn_readfirstlane((unsigned)(p >> 32));
    return ((unsigned long long)hi << 32) | lo;
}
__device__ __forceinline__ const float* inp(const Ctx& C, int i) { return (const float*)ptab(C, i); }
__device__ __forceinline__ float* outp(const Ctx& C) { return (float*)ptab(C, 32); }
__device__ __forceinline__ unsigned char* wsp(const Ctx& C) { return (unsigned char*)ptab(C, 33); }
__device__ __forceinline__ bf16* wptr(const Ctx& C, int l, size_t off) { return (bf16*)(wsp(C) + WS_W + (size_t)l * W_LAYER + off); }
__device__ __forceinline__ float lambda_init(int l) { return l == 0 ? 0.2f : l == 1 ? (float)(0.8 - 0.6 * 0.7408182206817179) : l == 2 ? (float)(0.8 - 0.6 * 0.5488116360940264) : (float)(0.8 - 0.6 * 0.4065696597405991); }

namespace pg8 {
struct EpiResGate {
    static constexpr bool PERM = false, AFTER_DRAIN = false;
    const float* base_lat; const float* base_ctx; float* out_lat; float* out_ctx; const float* gate;
    __device__ __forceinline__ void operator()(const f32x4 (&acc)[2][2][4][2], const Unit& u, int wr, int wc, int fr, int fq) const {
        const bool lat = u.pm < 64; const int bidx = lat ? (u.pm >> 3) : 8;
        const size_t rowt = lat ? (size_t)u.pm * BM : (size_t)(u.pm - 64) * BM;
        const float* base = (lat ? base_lat : base_ctx) + rowt * DM; float* out = (lat ? out_lat : out_ctx) + rowt * DM;
        const int row0 = wr * 64 + fr, col0 = u.pn * BM + wc * 32 + 4 * fq;
        f32x4 gv[2][2];
#pragma unroll
        for (int bj = 0; bj < 2; ++bj)
#pragma unroll
            for (int n = 0; n < 2; ++n) gv[bj][n] = *(const f32x4*)(gate + (size_t)bidx * 6144 + col0 + bj * HALF + n * 16);
#pragma unroll
        for (int ai = 0; ai < 2; ++ai)
#pragma unroll
            for (int m = 0; m < 4; ++m) { const size_t off = (size_t)(row0 + ai * HALF + m * 16) * DM + col0;
#pragma unroll
                for (int bj = 0; bj < 2; ++bj)
#pragma unroll
                    for (int n = 0; n < 2; ++n) { const f32x4 bs = *(const f32x4*)(base + off + bj * HALF + n * 16); *(f32x4*)(out + off + bj * HALF + n * 16) = bs + gv[bj][n] * acc[ai][bj][m][n]; }
                if (m & 1) asm volatile("" ::: "memory"); }
    }
};
__device__ __forceinline__ f32x4 shf4(const f32x4 v, int src) { f32x4 r; r[0] = __shfl(v[0], src); r[1] = __shfl(v[1], src); r[2] = __shfl(v[2], src); r[3] = __shfl(v[3], src); return r; }
__device__ __forceinline__ f32x4 sel4(bool c, const f32x4 a, const f32x4 b) { f32x4 r; r[0] = c ? a[0] : b[0]; r[1] = c ? a[1] : b[1]; r[2] = c ? a[2] : b[2]; r[3] = c ? a[3] : b[3]; return r; }
__device__ __forceinline__ float silu1(float x) { return x * __builtin_amdgcn_rcpf(1.f + __expf(-x)); }
struct EpiConvGate {
    static constexpr bool PERM = true, AFTER_DRAIN = false;
    bf16_t* ACT; float* HALO; const float* cw; const float* cb; PG8_LAS float* EX;
    __device__ __forceinline__ void operator()(const f32x4 (&acc)[2][2][4][2], const Unit& u, int wr, int wc, int fr, int fq) const {
        const int lane = fq * 16 + fr;
        const int jc = u.pn * 128 + wc * 32 + 8 * fq;
        if (fr == 0) {
#pragma unroll
            for (int ai = 0; ai < 2; ++ai)
#pragma unroll
                for (int bj = 0; bj < 2; ++bj)
#pragma unroll
                    for (int n = 0; n < 2; ++n) *(PG8_LAS f32x4*)(EX + ((((wr * 4 + wc) * 2 + ai) * 2 + 0) * 64 + bj * 32 + 8 * fq + 4 * n)) = acc[ai][bj][0][n];
        }
        if (fr == 15) {
#pragma unroll
            for (int ai = 0; ai < 2; ++ai)
#pragma unroll
                for (int bj = 0; bj < 2; ++bj)
#pragma unroll
                    for (int n = 0; n < 2; ++n) *(PG8_LAS f32x4*)(EX + ((((wr * 4 + wc) * 2 + ai) * 2 + 1) * 64 + bj * 32 + 8 * fq + 4 * n)) = acc[ai][bj][3][n];
        }
        asm volatile("s_waitcnt lgkmcnt(0)" ::: "memory"); __builtin_amdgcn_s_barrier(); asm volatile("" ::: "memory");
        if (u.pm < 64) {
            float* hb = HALO + (size_t)u.pm * 4 * NUP;
            if (wr == 0 && fr < 2) {
#pragma unroll
                for (int bj = 0; bj < 2; ++bj)
#pragma unroll
                    for (int n = 0; n < 2; ++n) *(f32x4*)(hb + (size_t)fr * NUP + bj * DFF + jc + 4 * n) = acc[0][bj][0][n];
            }
            if (wr == 1 && fr >= 14) {
#pragma unroll
                for (int bj = 0; bj < 2; ++bj)
#pragma unroll
                    for (int n = 0; n < 2; ++n) *(f32x4*)(hb + (size_t)(fr - 12) * NUP + bj * DFF + jc + 4 * n) = acc[1][bj][3][n];
            }
        }
        const int srcR = (lane & 48) | ((lane - 1) & 15), srcL = (lane & 48) | ((lane + 1) & 15);
        const bool f0 = fr == 0, f15 = fr == 15;
#pragma unroll
        for (int ai = 0; ai < 2; ++ai) {
            const int g = 2 * ai + wr;
            const int gp = g - 1, gn = g + 1;
            unsigned pk[4][4];
#pragma unroll
            for (int n = 0; n < 2; ++n)
#pragma unroll
                for (int ep = 0; ep < 2; ++ep) {
                    float cv[2][2][4];
#pragma unroll
                    for (int bj = 0; bj < 2; ++bj) {
                        const int c = bj * DFF + jc + 4 * n + 2 * ep;
                        const f32x2v w0 = *(const f32x2v*)(cw + c), w1 = *(const f32x2v*)(cw + NUP + c), w2 = *(const f32x2v*)(cw + 2 * NUP + c), bb = *(const f32x2v*)(cb + c);
                        f32x2v bprev = {0.f, 0.f}, bnext = {0.f, 0.f};
                        if (gp >= 0) bprev = *(const PG8_LAS f32x2v*)(EX + (((((gp & 1) * 4 + wc) * 2 + (gp >> 1)) * 2 + 1) * 64 + bj * 32 + 8 * fq + 4 * n + 2 * ep));
                        if (gn <= 3) bnext = *(const PG8_LAS f32x2v*)(EX + (((((gn & 1) * 4 + wc) * 2 + (gn >> 1)) * 2 + 0) * 64 + bj * 32 + 8 * fq + 4 * n + 2 * ep));
#pragma unroll
                        for (int e2 = 0; e2 < 2; ++e2) {
                            const int e = 2 * ep + e2;
                            float r[4], l[4];
#pragma unroll
                            for (int m = 0; m < 4; ++m) { r[m] = __shfl(acc[ai][bj][m][n][e], srcR); l[m] = __shfl(acc[ai][bj][m][n][e], srcL); }
#pragma unroll
                            for (int m = 0; m < 4; ++m) {
                                const float pv = f0 ? (m > 0 ? r[m > 0 ? m - 1 : 0] : bprev[e2]) : r[m];
                                const float nx = f15 ? (m < 3 ? l[m < 3 ? m + 1 : 3] : bnext[e2]) : l[m];
                                cv[bj][e2][m] = w0[e2] * pv + w1[e2] * acc[ai][bj][m][n][e] + w2[e2] * nx + bb[e2];
                            }
                        }
                    }
#pragma unroll
                    for (int m = 0; m < 4; ++m) pk[m][n * 2 + ep] = cvt_pk_bf16(silu1(cv[1][0][m]) * cv[0][0][m], silu1(cv[1][1][m]) * cv[0][1][m]);
                    __builtin_amdgcn_sched_barrier(0);
                }
#pragma unroll
            for (int m = 0; m < 4; ++m) {
                const size_t row = (size_t)u.pm * BM + ai * HALF + wr * 64 + m * 16 + fr;
                u32x4 w; w.x = pk[m][0]; w.y = pk[m][1]; w.z = pk[m][2]; w.w = pk[m][3];
                *(u32x4*)(ACT + row * DFF + jc) = w;
            }
            __builtin_amdgcn_sched_barrier(0);
        }
    }
};
}

__device__ __forceinline__ void transpose_item(const float* W, int N, int k0, int n0, bf16* WT, int ldt, int kcol0, int orow0, LAS float* scr, int lane) {
#pragma unroll 8
    for (int i = 0; i < 32; ++i) { const int kk = 2 * i + (lane >> 5); scr[kk * 33 + (lane & 31)] = W[(size_t)(k0 + kk) * N + n0 + (lane & 31)]; }
    LDS_WAIT(); asm volatile("" ::: "memory");
    const int c = lane & 7;
#pragma unroll
    for (int j = 0; j < 4; ++j) { const int n = (lane >> 3) + 8 * j; const LAS float* s = scr + (8 * c) * 33 + n;
        v4u o; o.x = pk2(s[0 * 33], s[1 * 33]); o.y = pk2(s[2 * 33], s[3 * 33]); o.z = pk2(s[4 * 33], s[5 * 33]); o.w = pk2(s[6 * 33], s[7 * 33]);
        *(GAS v4u*)(WT + (size_t)(orow0 + n) * ldt + kcol0 + k0 + 8 * c) = o; }
    LDS_WAIT(); asm volatile("" ::: "memory");
}
__device__ __forceinline__ void phase_prologue(const int wv) {
    const Ctx C = make_ctx(wv);
    {
        LAS float* S = (LAS float*)(C.lds);
        LAS float* red = (LAS float*)(C.lds + 40960);
        const float* cin = inp(C, 1); const float* cctx = inp(C, 3); const float* wmod = inp(C, 4); const float* bmod = inp(C, 5);
        for (int i = C.tid; i < 9 * 1024; i += 512) { const int r = i >> 10, k = i & 1023; const float v = (r < 8) ? cin[r * 1024 + k] : cctx[k]; S[i] = v / (1.f + expf(-v)); }
        __syncthreads();
        for (int it = blockIdx.x; it < NL * 192; it += C.G) {
            const int l = it / 192, col0 = (it % 192) * 32;
            const float* W = wmod + (size_t)l * 1024 * 6144 + col0 + (C.lane & 31);
            float acc[9];
#pragma unroll
            for (int r = 0; r < 9; ++r) acc[r] = 0.f;
            const int kb = C.wave * 128 + (C.lane >> 5);
#pragma unroll 4
            for (int i = 0; i < 64; ++i) { const int k = kb + 2 * i; const float w = W[(size_t)k * 6144];
#pragma unroll
                for (int r = 0; r < 9; ++r) acc[r] += S[r * 1024 + k] * w; }
#pragma unroll
            for (int r = 0; r < 9; ++r) acc[r] += __shfl_xor(acc[r], 32);
            if (C.lane < 32) {
#pragma unroll
                for (int r = 0; r < 9; ++r) red[(C.wave * 9 + r) * 32 + C.lane] = acc[r];
            }
            __syncthreads();
            if (C.tid < 288) { const int r = C.tid >> 5, cc = C.tid & 31; float s = 0.f;
#pragma unroll
                for (int w = 0; w < 8; ++w) s += red[(w * 9 + r) * 32 + cc];
                ((float*)(wsp(C) + WS_MODS))[(size_t)(l * 9 + r) * 6144 + col0 + cc] = s + bmod[l * 6144 + col0 + cc]; }
            __syncthreads();
        }
    }
    {
        LAS float* scr = (LAS float*)(C.lds + 49152 + C.wave * 9216);
        constexpr int I_IN = 16 * 77, I_OUT = 16 * 32, I_UP = 16 * 176, I_DN = 44 * 32, I_UQ = 4 * 12, I_UKV = 2 * 16, I_L = I_IN + I_OUT + I_UP + I_DN + I_UQ + I_UKV;
        for (int it = C.gw; it < NL * I_L; it += C.NGW) {
            const int l = it / I_L; int r = it % I_L;
            if (r < I_IN) { const int kb = r / 77, nb = r % 77, n0 = nb * 32; transpose_item(inp(C, 7) + (size_t)l * DM * NIN, NIN, kb * 64, n0, wptr(C, l, W_IN), DM, 0, n0 < 416 ? n0 : n0 + 96, scr, C.lane); continue; } r -= I_IN;
            if (r < I_OUT) { const int kb = r / 32, nb = r % 32; transpose_item(inp(C, 8) + (size_t)l * DM * DM, DM, kb * 64, nb * 32, wptr(C, l, W_OUT), DM, 0, nb * 32, scr, C.lane); continue; } r -= I_OUT;
            if (r < I_UP) { const int kb = r / 176, nb = r % 176, n0 = nb * 32, bj = n0 >= DFF ? 1 : 0, j0 = n0 - bj * DFF;
                transpose_item(inp(C, 28) + (size_t)l * DM * NUP, NUP, kb * 64, n0, wptr(C, l, W_UP), DM, 0, 256 * (j0 >> 7) + 128 * bj + (j0 & 127), scr, C.lane); continue; } r -= I_UP;
            if (r < I_DN) { const int kb = r / 32, nb = r % 32; transpose_item(inp(C, 31) + (size_t)l * DFF * DM, DM, kb * 64, nb * 32, wptr(C, l, W_DOWN), DFF, 0, nb * 32, scr, C.lane); continue; } r -= I_DN;
            if (r < I_UQ) { const int kb = r / 12, nb = r % 12; transpose_item(inp(C, 10) + (size_t)l * 256 * 384, 384, kb * 64, nb * 32, wptr(C, l, W_MLA), KMLA, 0, nb * 32, scr, C.lane); continue; } r -= I_UQ;
            { const int kb = r / 16, nb = r % 16; transpose_item(inp(C, 12) + (size_t)l * 128 * 512, 512, kb * 64, nb * 32, wptr(C, l, W_MLA), KMLA, 256, 512 + nb * 32, scr, C.lane); }
        }
        const int gt = C.gw * 64 + C.lane, NGT = C.NGW * 64;
        const v4u z = {0u, 0u, 0u, 0u};
        for (int i = gt; i < NL * 96 * 128; i += NGT) { const int l = i / (96 * 128), r = i % (96 * 128); *(GAS v4u*)(wptr(C, l, W_IN) + (size_t)(416 + r / 128) * DM + (r % 128) * 8) = z; }
        for (int i = gt; i < NL * 1024 * 48; i += NGT) { const int l = i / (1024 * 48), r = (i / 48) % 1024, k = (i % 48) * 8;
            const bool zero = (r < 384) ? (k >= 256) : (r < 512) ? true : (k < 256);
            if (zero) *(GAS v4u*)(wptr(C, l, W_MLA) + (size_t)r * KMLA + k) = z; }
        float* r32 = (float*)(wsp(C) + WS_ROPE32); float* r64 = (float*)(wsp(C) + WS_ROPE64);
        for (int i = gt; i < 2048 * 48; i += NGT) {
            const int pos = i / 48, e = i % 48; const float row = (float)(pos >> 6), col = (float)(pos & 63);
            if (e < 16) { const int f = e & 7; const float inv = powf(10000.f, -(float)f / 8.f); const float a = (e < 8 ? row : col) * inv; r32[(pos * 16 + e) * 2] = cosf(a); r32[(pos * 16 + e) * 2 + 1] = sinf(a); }
            else { const int e2 = e - 16, f = e2 & 15; const float inv = powf(10000.f, -(float)f / 16.f); const float a = (e2 < 16 ? row : col) * inv; r64[(pos * 32 + e2) * 2] = cosf(a); r64[(pos * 32 + e2) * 2 + 1] = sinf(a); }
        }
    }
}

__device__ __forceinline__ void phase_norm(const int wv, int l, int which, int nrows) {
    const Ctx C = make_ctx(wv);
    const bool first = (l == 0 && which == 1);
    const float* xl = first ? inp(C, 0) : outp(C); const float* xc = first ? inp(C, 2) : ((float*)(wsp(C) + WS_XC));
    const float* gv = (which == 1 ? inp(C, 6) : inp(C, 27)) + l * DM;
    f32x4 g4[4];
#pragma unroll
    for (int j = 0; j < 4; ++j) g4[j] = *(const f32x4*)(gv + 4 * C.lane + 256 * j);
    for (int R = C.gw; R < nrows; R += C.NGW) {
        const float* src = R < ML ? xl + (size_t)R * DM : xc + (size_t)(R - ML) * DM;
        const int bidx = R < ML ? (R >> 11) : 8;
        const float* md = ((float*)(wsp(C) + WS_MODS)) + (size_t)(l * 9 + bidx) * 6144 + (which == 1 ? 0 : 3072);
        f32x4 v[4]; float ss = 0.f;
#pragma unroll
        for (int j = 0; j < 4; ++j) { v[j] = *(const f32x4*)(src + 4 * C.lane + 256 * j); ss += (v[j][0] * v[j][0] + v[j][1] * v[j][1]) + (v[j][2] * v[j][2] + v[j][3] * v[j][3]); }
        const float rs = 1.f / sqrtf(wave_sum(ss) * (1.f / DM) + EPS);
#pragma unroll
        for (int j = 0; j < 4; ++j) {
            const f32x4 sh = *(const f32x4*)(md + 4 * C.lane + 256 * j), sc = *(const f32x4*)(md + 1024 + 4 * C.lane + 256 * j);
            const f32x4 y = (v[j] * rs) * g4[j] * (sc + 1.f) + sh;
            u32x2v w; w.x = pk2(y[0], y[1]); w.y = pk2(y[2], y[3]);
            *(u32x2v*)(((bf16*)(wsp(C) + WS_XN)) + (size_t)R * DM + 4 * C.lane + 256 * j) = w;
        }
    }
}

__device__ __forceinline__ void row_info(int R, int& b, int& qi, int& pos) {
    if (R < ML) { b = R >> 11; qi = R & 2047; pos = qi; } else { const int r = R - ML; b = r >> 8; qi = 2048 + (r & 255); pos = -1; }
}
__device__ __forceinline__ float red_xor(float v, int maxo) { for (int o = 1; o <= maxo; o <<= 1) v += __shfl_xor(v, o); return v; }

__device__ __forceinline__ void phase_prep1(const int wv, int l) {
    const Ctx C = make_ctx(wv);
    LAS unsigned short* st = (LAS unsigned short*)(C.lds + C.wave * 8192);
    bf16* Q = ((bf16*)(wsp(C) + WS_QKV));
    const float* rope32 = (const float*)(wsp(C) + WS_ROPE32); const float* rope64 = (const float*)(wsp(C) + WS_ROPE64);
    const float C32 = 0.17677669529663687f * LOG2E, C64 = 0.125f * LOG2E;
    for (int R = C.gw; R < MT; R += C.NGW) {
        int b, qi, pos; row_info(R, b, qi, pos);
        {   const GAS v4u* src = (const GAS v4u*)(((bf16*)(wsp(C) + WS_P)) + (size_t)R * NINP);
#pragma unroll
            for (int i = 0; i < 5; ++i) ((LAS v4u*)st)[C.lane + 64 * i] = src[C.lane + 64 * i];
            LDS_WAIT(); asm volatile("" ::: "memory"); }
        const int lane = C.lane;
        float v[4];
        {   float ss = 0.f;
#pragma unroll
            for (int e = 0; e < 4; ++e) { v[e] = bf2f(st[PC_CQ + 4 * lane + e]); ss += v[e] * v[e]; }
            const float rs = 1.f / sqrtf(wave_sum(ss) * (1.f / 256.f) + EPS); const float* g = inp(C, 9) + l * 256 + 4 * lane;
            u32x2v w; w.x = pk2(v[0] * rs * g[0], v[1] * rs * g[1]); w.y = pk2(v[2] * rs * g[2], v[3] * rs * g[3]);
            *(u32x2v*)(((bf16*)(wsp(C) + WS_CQKV)) + (size_t)R * KMLA + 4 * lane) = w; }
        {   float ss = 0.f;
#pragma unroll
            for (int e = 0; e < 2; ++e) { v[e] = bf2f(st[PC_CKV + 2 * lane + e]); ss += v[e] * v[e]; }
            const float rs = 1.f / sqrtf(wave_sum(ss) * (1.f / 128.f) + EPS); const float* g = inp(C, 11) + l * 128 + 2 * lane;
            *(unsigned*)(((bf16*)(wsp(C) + WS_CQKV)) + (size_t)R * KMLA + 256 + 2 * lane) = pk2(v[0] * rs * g[0], v[1] * rs * g[1]); }
#pragma unroll
        for (int qk = 0; qk < 2; ++qk) {
            float ss = 0.f;
#pragma unroll
            for (int e = 0; e < 4; ++e) { v[e] = bf2f(st[(qk ? PC_DK : PC_DQ) + 4 * lane + e]); ss += v[e] * v[e]; }
            ss = red_xor(ss, 4);
            const float rs = 1.f / sqrtf(ss * (1.f / 32.f) + EPS);
            const int gi = lane >> 3, lg = lane & 7, d0 = 4 * lg; const float* g = inp(C, qk ? 16 : 15) + l * 32 + d0;
            float y[4];
#pragma unroll
            for (int e = 0; e < 4; ++e) y[e] = v[e] * rs * g[e];
#pragma unroll
            for (int e = 0; e < 4; ++e) { const float pr = __shfl_xor(y[e], 2);
                if (pos >= 0) { const int ti = ((lg & 4) ? 8 : 0) + 4 * (lg & 1) + e; const float cs = rope32[(pos * 16 + ti) * 2], sn = rope32[(pos * 16 + ti) * 2 + 1];
                    v[e] = (lg & 2) ? y[e] * cs + pr * sn : y[e] * cs - pr * sn; } else v[e] = y[e]; }
            if (qk == 0) { u32x2v w; w.x = pk2(v[0] * C32, v[1] * C32); w.y = pk2(v[2] * C32, v[3] * C32); *(u32x2v*)(Q + E_QD + q_off(8, 32, b, gi, qi) + d0) = w; }
            else { u32x2v w; w.x = pk2(v[0], v[1]); w.y = pk2(v[2], v[3]); *(u32x2v*)(Q + E_KD + k_off(8, 32, b, gi, qi, d0)) = w; }
        }
#pragma unroll
        for (int t = 0; t < 2; ++t) {
            const int h = lane >> 4, dv0 = 4 * (lane & 15);
#pragma unroll
            for (int e = 0; e < 4; ++e) (Q + (t ? E_VN : E_VD))[v_off(4, b, h, qi, dv0 + e)] = st[(t ? PC_NV : PC_DV) + 4 * lane + e];
        }
#pragma unroll
        for (int qk = 0; qk < 2; ++qk) {
            float ss = 0.f;
#pragma unroll
            for (int e = 0; e < 4; ++e) { v[e] = bf2f(st[(qk ? PC_NK : PC_NQ) + 4 * lane + e]); ss += v[e] * v[e]; }
            ss = red_xor(ss, 8);
            const float rs = 1.f / sqrtf(ss * (1.f / 64.f) + EPS);
            const int h = lane >> 4, d0 = 4 * (lane & 15); const float* g = inp(C, qk ? 23 : 22) + l * 64 + d0;
#pragma unroll
            for (int e = 0; e < 4; ++e) v[e] = v[e] * rs * g[e];
            if (qk == 0) { u32x2v w; w.x = pk2(v[0] * C64, v[1] * C64); w.y = pk2(v[2] * C64, v[3] * C64); *(u32x2v*)(Q + E_QN + q_off(4, 64, b, h, qi) + d0) = w; }
            else { u32x2v w; w.x = pk2(v[0], v[1]); w.y = pk2(v[2], v[3]); *(u32x2v*)(Q + E_KN + k_off(4, 64, b, h, qi, d0)) = w; }
        }
        {   float ss = 0.f;
#pragma unroll
            for (int e = 0; e < 4; ++e) { v[e] = bf2f(st[PC_GQ + 4 * lane + e]); ss += v[e] * v[e]; }
            ss = red_xor(ss, 8);
            const float rs = 1.f / sqrtf(ss * (1.f / 64.f) + EPS);
            const int h = lane >> 4, lh = lane & 15, d0 = 4 * lh; const float* g = inp(C, 25) + l * 64 + d0;
            float y[4];
#pragma unroll
            for (int e = 0; e < 4; ++e) y[e] = v[e] * rs * g[e];
#pragma unroll
            for (int e = 0; e < 4; ++e) { const float pr = __shfl_xor(y[e], 4);
                if (pos >= 0) { const int ti = ((lh & 8) ? 16 : 0) + 4 * (lh & 3) + e; const float cs = rope64[(pos * 32 + ti) * 2], sn = rope64[(pos * 32 + ti) * 2 + 1];
                    v[e] = (lh & 4) ? y[e] * cs + pr * sn : y[e] * cs - pr * sn; } else v[e] = y[e]; }
            u32x2v w; w.x = pk2(v[0] * C64, v[1] * C64); w.y = pk2(v[2] * C64, v[3] * C64); *(u32x2v*)(Q + E_QG + q_off(4, 64, b, h, qi) + d0) = w; }
        {   float ss = 0.f;
#pragma unroll
            for (int e = 0; e < 2; ++e) { v[e] = bf2f(st[PC_GK + 2 * lane + e]); ss += v[e] * v[e]; }
            ss = red_xor(ss, 16);
            const float rs = 1.f / sqrtf(ss * (1.f / 64.f) + EPS);
            const int h = lane >> 5, ll = lane & 31, d0 = 2 * ll; const float* g = inp(C, 26) + l * 64 + d0;
            float y[2];
#pragma unroll
            for (int e = 0; e < 2; ++e) y[e] = v[e] * rs * g[e];
#pragma unroll
            for (int e = 0; e < 2; ++e) { const float pr = __shfl_xor(y[e], 8);
                if (pos >= 0) { const int ti = ((ll & 16) ? 16 : 0) + 2 * (ll & 7) + e; const float cs = rope64[(pos * 32 + ti) * 2], sn = rope64[(pos * 32 + ti) * 2 + 1];
                    v[e] = (ll & 8) ? y[e] * cs + pr * sn : y[e] * cs - pr * sn; } else v[e] = y[e]; }
            *(unsigned*)(Q + E_KG + k_off(2, 64, b, h, qi, d0)) = pk2(v[0], v[1]); }
        {   const int h = lane >> 5, dv0 = 2 * (lane & 31);
#pragma unroll
            for (int e = 0; e < 2; ++e) (Q + E_VG)[v_off(2, b, h, qi, dv0 + e)] = st[PC_GV + 2 * lane + e]; }
        LDS_WAIT(); asm volatile("" ::: "memory");
    }
}

__device__ __forceinline__ void phase_prep2(const int wv, int l) {
    const Ctx C = make_ctx(wv);
    LAS unsigned short* st = (LAS unsigned short*)(C.lds + C.wave * 8192);
    bf16* Q = ((bf16*)(wsp(C) + WS_QKV));
    const float* rope32 = (const float*)(wsp(C) + WS_ROPE32);
    const float C96 = 0.10206207261596575f * LOG2E;
    for (int R = C.gw; R < MT; R += C.NGW) {
        int b, qi, pos; row_info(R, b, qi, pos);
        {   const GAS v4u* src = (const GAS v4u*)(((bf16*)(wsp(C) + WS_MLAP)) + (size_t)R * NMLA);
            ((LAS v4u*)st)[C.lane] = src[C.lane]; ((LAS v4u*)st)[C.lane + 64] = src[C.lane + 64];
            if (C.lane < 4) ((LAS v4u*)st)[128 + C.lane] = ((const GAS v4u*)(((bf16*)(wsp(C) + WS_P)) + (size_t)R * NINP + PC_KR))[C.lane];
            LDS_WAIT(); asm volatile("" ::: "memory"); }
        const int lane = C.lane, h = lane >> 4, li = lane & 15;
#pragma unroll
        for (int qk = 0; qk < 2; ++qk) {
            float v[6]; float ss = 0.f;
#pragma unroll
            for (int e = 0; e < 6; ++e) { v[e] = qk == 0 ? bf2f(st[h * 96 + li + 16 * e]) : (e < 4 ? bf2f(st[512 + h * 128 + li + 16 * e]) : bf2f(st[1024 + li + 16 * (e - 4)])); ss += v[e] * v[e]; }
            ss = red_xor(ss, 8);
            const float rs = 1.f / sqrtf(ss * (1.f / 96.f) + EPS); const float* g = inp(C, qk ? 14 : 13) + l * 96 + li;
#pragma unroll
            for (int e = 0; e < 6; ++e) v[e] = v[e] * rs * g[16 * e];
#pragma unroll
            for (int e = 4; e < 6; ++e) { const float pr = __shfl_xor(v[e], 8);
                if (pos >= 0) { const int ti = (e == 5 ? 8 : 0) + (li & 7); const float cs = rope32[(pos * 16 + ti) * 2], sn = rope32[(pos * 16 + ti) * 2 + 1];
                    v[e] = (li & 8) ? v[e] * cs + pr * sn : v[e] * cs - pr * sn; } }
            if (qk == 0) {
#pragma unroll
                for (int e = 0; e < 6; ++e) (Q + E_QA)[q_off(4, 96, b, h, qi) + li + 16 * e] = (bf16)f2bf(v[e] * C96);
            } else {
#pragma unroll
                for (int e = 0; e < 6; ++e) (Q + E_KA)[k_off(4, 96, b, h, qi, li + 16 * e)] = (bf16)f2bf(v[e]);
            }
        }
#pragma unroll
        for (int e = 0; e < 4; ++e) (Q + E_VA)[v_off(4, b, h, qi, li + 16 * e)] = st[512 + h * 128 + 64 + li + 16 * e];
        LDS_WAIT(); asm volatile("" ::: "memory");
    }
}

template <int DK, int HQ, int HK, int HV, bool NA>
__device__ __forceinline__ void naive_attn_one(const bf16* Qb, const bf16* Kb, const bf16* Vb, const float* rpb, int b, int hq, int hk, int hv, int qi, float (&o)[64]) {
    float q[DK];
    { const bf16* qp = Qb + q_off(HQ, DK, b, hq, qi);
#pragma unroll
      for (int c = 0; c < DK / 8; ++c) { const v4u w = *(const v4u*)(qp + 8 * c); q[8 * c] = bflo(w.x); q[8 * c + 1] = bfhi(w.x); q[8 * c + 2] = bflo(w.y); q[8 * c + 3] = bfhi(w.y); q[8 * c + 4] = bflo(w.z); q[8 * c + 5] = bfhi(w.z); q[8 * c + 6] = bflo(w.w); q[8 * c + 7] = bfhi(w.w); } }
    float m = -1e30f, ls = 0.f;
#pragma unroll
    for (int d = 0; d < 64; ++d) o[d] = 0.f;
    const bool isctx = qi >= SEQ;
    const int r = qi >> 6, qc = qi & 63;
    const int rs0 = min(max(r - 4, 0), 24), ws0 = min(max(qc - 8, 0), 48);
    const int nloc = isctx ? 0 : (NA ? 128 : SEQ);
    const int ntot = nloc + CTXL;
    for (int it = 0; it < ntot; ++it) {
        int key; float bias = 0.f;
        if (it < nloc) {
            if (NA) { const int kr = rs0 + (it >> 4), kc = ws0 + (it & 15); key = kr * 64 + kc; bias = rpb[(kr - r + 7) * 31 + min(max(kc - qc + 15, 0), 30)] * LOG2E; }
            else key = it;
        } else key = SEQ + (it - nloc);
        float s = bias;
#pragma unroll
        for (int c = 0; c < DK / 8; ++c) { const v4u w = *(const v4u*)(Kb + k_off(HK, DK, b, hk, key, 8 * c));
            s += q[8 * c] * bflo(w.x) + q[8 * c + 1] * bfhi(w.x) + q[8 * c + 2] * bflo(w.y) + q[8 * c + 3] * bfhi(w.y) + q[8 * c + 4] * bflo(w.z) + q[8 * c + 5] * bfhi(w.z) + q[8 * c + 6] * bflo(w.w) + q[8 * c + 7] * bfhi(w.w); }
        if (s > m) { const float a = exp2f(m - s); ls *= a;
#pragma unroll
            for (int d = 0; d < 64; ++d) o[d] *= a;
            m = s; }
        const float p = exp2f(s - m); ls += p;
        const bf16* vp = Vb + v_off(HV, b, hv, key, 0);
#pragma unroll
        for (int d = 0; d < 64; ++d) { o[d] += p * bf2f(vp[8 * d]); if ((d & 15) == 15) asm volatile("" ::: "memory"); }
    }
    const float inv = 1.f / ls;
#pragma unroll
    for (int d = 0; d < 64; ++d) o[d] *= inv;
}
__device__ __forceinline__ void store_mix(const Ctx& C, int b, int qi, int col0, const float (&o)[64]) {
    const size_t R = qi < SEQ ? (size_t)b * SEQ + qi : (size_t)ML + b * CTXL + (qi - SEQ);
    bf16* dst = ((bf16*)(wsp(C) + WS_MIX)) + R * DM + col0;
#pragma unroll
    for (int d = 0; d < 64; d += 8) { v4u w; w.x = pk2(o[d], o[d + 1]); w.y = pk2(o[d + 2], o[d + 3]); w.z = pk2(o[d + 4], o[d + 5]); w.w = pk2(o[d + 6], o[d + 7]); *(v4u*)(dst + d) = w; }
}
__device__ __forceinline__ void phase_attn_naive(const int wv, int l) {
    const Ctx C = make_ctx(wv);
    const bf16* Q = ((bf16*)(wsp(C) + WS_QKV));
    const int gt = C.gw * 64 + C.lane, NGT = C.NGW * 64;
    constexpr int PER = NB * 4 * NKEY;
    for (int idx = gt; idx < 5 * PER; idx += NGT) {
        const int mixer = idx < 3 * PER ? idx / PER : 3;
        const int r0 = mixer < 3 ? idx % PER : (idx - 3 * PER) >> 1, pair = idx & 1;
        const int b = r0 / (4 * NKEY), h = (r0 / NKEY) % 4, qi = r0 % NKEY;
        if (l == NL - 1 && qi >= SEQ) continue;
        float o[64];
        if (mixer == 0) { naive_attn_one<96, 4, 4, 4, false>(Q + E_QA, Q + E_KA, Q + E_VA, nullptr, b, h, h, h, qi, o); store_mix(C, b, qi, h * 64, o); }
        else if (mixer == 1) { naive_attn_one<64, 4, 4, 4, true>(Q + E_QN, Q + E_KN, Q + E_VN, inp(C, 24) + (size_t)(l * 4 + h) * 15 * 31, b, h, h, h, qi, o); store_mix(C, b, qi, 512 + h * 64, o); }
        else if (mixer == 2) { naive_attn_one<64, 4, 2, 2, false>(Q + E_QG, Q + E_KG, Q + E_VG, nullptr, b, h, h >> 1, h >> 1, qi, o); store_mix(C, b, qi, 768 + h * 64, o); }
        else {
            naive_attn_one<32, 8, 8, 4, false>(Q + E_QD, Q + E_KD, Q + E_VD, nullptr, b, 2 * h + pair, 2 * h + pair, h, qi, o);
            float s1 = 0.f, s2 = 0.f;
            for (int d = 0; d < 32; ++d) { s1 += inp(C, 17)[l * 32 + d] * inp(C, 18)[l * 32 + d]; s2 += inp(C, 19)[l * 32 + d] * inp(C, 20)[l * 32 + d]; }
            const float li = lambda_init(l), lam = expf(s1) - expf(s2) + li;
            float ss = 0.f;
#pragma unroll
            for (int d = 0; d < 64; ++d) { const float other = __shfl_xor(o[d], 1); o[d] = o[d] - lam * other; ss += o[d] * o[d]; }
            const float rs = 1.f / sqrtf(ss * (1.f / 64.f) + EPS);
#pragma unroll
            for (int d = 0; d < 64; ++d) o[d] = o[d] * rs * inp(C, 21)[l * 64 + d] * (1.f - li);
            if (pair == 0) store_mix(C, b, qi, 256 + h * 64, o);
        }
    }
}

__device__ __forceinline__ void phase_fixup(const int wv, int l) {
    const Ctx C = make_ctx(wv);
    const int gt = C.gw * 64 + C.lane, NGT = C.NGW * 64;
    const float* cw = inp(C, 29) + (size_t)l * 3 * NUP; const float* cb = inp(C, 30) + (size_t)l * NUP;
    for (int idx = gt; idx < 56 * 2 * DFF; idx += NGT) {
        const int j = idx % DFF, w = (idx / DFF) & 1, bi = idx / (2 * DFF), pm = (bi / 7) * 8 + (bi % 7);
        const float* h0 = ((float*)(wsp(C) + WS_HALO)) + (size_t)pm * 4 * NUP; const float* h1 = h0 + 4 * NUP;
        float cva[2];
#pragma unroll
        for (int t = 0; t < 2; ++t) { const int c = t * DFF + j;
            const float up = w == 0 ? h0[2 * NUP + c] : h0[3 * NUP + c], uc = w == 0 ? h0[3 * NUP + c] : h1[c], un = w == 0 ? h1[c] : h1[NUP + c];
            cva[t] = cw[c] * up + cw[NUP + c] * uc + cw[2 * NUP + c] * un + cb[c]; }
        const size_t row = (size_t)pm * 256 + 255 + w;
        ((bf16*)(wsp(C) + WS_ACT))[row * DFF + j] = (bf16)f2bf(pg8::silu1(cva[1]) * cva[0]);
    }
}

#ifndef MK_PER_PHASE
#define MK_PER_PHASE 0
#endif
constexpr int PH_PRO = 0, PH_NORM0 = 1, PH_L0 = 2, PH_PER_LAYER = 11;
constexpr int N_PHASES = PH_L0 + NL * PH_PER_LAYER - 1;
struct Args { const float* in[32]; float* out; unsigned char* ws; int ph_lo, ph_hi; };

__global__ void __launch_bounds__(NWAVES * 64, 2) fwd_kernel(Args args) {
    const int wv = __builtin_amdgcn_readfirstlane((int)threadIdx.x >> 6);
    const Ctx C = make_ctx(wv);
    for (int u = C.tid; u < 1024 / 4; u += NWAVES * 64) ((LAS unsigned*)(C.lds + LDSCTL_OFF))[u] = 0u;
    __syncthreads();
    if (C.tid < 34) ((LAS unsigned long long*)(C.lds + PT_OFF))[C.tid] = ((const __attribute__((address_space(4))) unsigned long long*)__builtin_amdgcn_kernarg_segment_ptr())[C.tid];
    volatile LAS unsigned* MISC = (volatile LAS unsigned*)(C.lds + MISC_OFF);
    __syncthreads();
    gu32* ctl = (gu32*)(wsp(C) + WS_CTL);
    XcdBarrier bar; bar.bar = (unsigned*)(ctl + CW_BAR); bar.x = 0; bar.st = nullptr; bar.wv = wv;
    const bool multi = (args.ph_hi - args.ph_lo) > 1;
    if (multi) { bar = xcd_barrier_post((unsigned*)(ctl + CW_BAR), MISC + 8); bar.wv = wv; }

    for (int ph = args.ph_lo; ph < args.ph_hi; ++ph) {
        if (ph == PH_PRO) phase_prologue(wv);
        else if (ph == PH_NORM0) phase_norm(wv, 0, 1, MT);
        else {
            const int l = (ph - PH_L0) / PH_PER_LAYER, s = (ph - PH_L0) % PH_PER_LAYER;
            const int Mrows = (l == NL - 1) ? ML : MT;
            if (s == 0 || s == 2) {
                const bool mla = s == 2;
                pg8::Gemm g{mla ? (bf16*)(wsp(C) + WS_CQKV) : (bf16*)(wsp(C) + WS_XN), wptr(C, l, mla ? W_MLA : W_IN), MT, mla ? NMLA : NINP, mla ? KMLA : DM}; pg8::StaticOrder S; S.init(MT, mla ? NMLA : NINP, C.G, (int)blockIdx.x);
                pg8::EpiBf16<0> E{mla ? (bf16*)(wsp(C) + WS_MLAP) : (bf16*)(wsp(C) + WS_P), mla ? NMLA : NINP, nullptr, 0, 0, 1.f};
                pg8::gemm_phase<pg8::EpiBf16<0>, pg8::StaticOrder, true, true>(C.lds + RING_OFF, g, S, E, wv);
            } else if (s == 1) phase_prep1(wv, l);
            else if (s == 3) phase_prep2(wv, l);
            else if (s == 4) phase_attn_naive(wv, l);
            else if (s == 5 || s == 9) {
                const bool dn = s == 9;
                pg8::Gemm g{dn ? (bf16*)(wsp(C) + WS_ACT) : (bf16*)(wsp(C) + WS_MIX), wptr(C, l, dn ? W_DOWN : W_OUT), Mrows, DM, dn ? DFF : DM}; pg8::StaticOrder S; S.init(Mrows, DM, C.G, (int)blockIdx.x);
                const bool first = (l == 0 && !dn);
                pg8::EpiResGate E{first ? inp(C, 0) : outp(C), first ? inp(C, 2) : (float*)(wsp(C) + WS_XC), outp(C), (float*)(wsp(C) + WS_XC), (float*)(wsp(C) + WS_MODS) + (size_t)l * 9 * 6144 + (dn ? 5120 : 2048)};
                pg8::gemm_phase<pg8::EpiResGate, pg8::StaticOrder, true, true>(C.lds + RING_OFF, g, S, E, wv);
            } else if (s == 6) phase_norm(wv, l, 2, Mrows);
            else if (s == 7) {
                pg8::Gemm g{(bf16*)(wsp(C) + WS_XN), wptr(C, l, W_UP), Mrows, NUP, DM}; pg8::StaticOrder S; S.init(Mrows, NUP, C.G, (int)blockIdx.x);
                pg8::EpiConvGate E{(bf16*)(wsp(C) + WS_ACT), (float*)(wsp(C) + WS_HALO), inp(C, 29) + (size_t)l * 3 * NUP, inp(C, 30) + (size_t)l * NUP, (PG8_LAS float*)(C.lds + EX_OFF)};
                pg8::gemm_phase<pg8::EpiConvGate, pg8::StaticOrder, true, true>(C.lds + RING_OFF, g, S, E, wv);
            } else if (s == 8) phase_fixup(wv, l);
            else phase_norm(wv, l + 1, 1, MT);
        }
        if (ph + 1 < args.ph_hi) { XcdBarrier bb = bar; asm volatile("" : "+s"(bb.bar), "+s"(bb.x)); xcd_barrier(bb); }
    }
}

extern "C" void kernel_launch(void* const* d_in, const int* in_sizes, int n_in, void* d_out, int out_size, void* d_ws, size_t ws_size, hipStream_t stream) {
    static int grid = 0;
    if (grid == 0) {
        if (n_in != 32 || out_size != ML * DM || ws_size < WS_END) { fprintf(stderr, "kernel_launch: unexpected shapes (n_in %d out %d ws %zu)\n", n_in, out_size, ws_size); grid = -1; return; }
        int dev = 0, cus = 0;
        if (hipGetDevice(&dev) != hipSuccess || hipDeviceGetAttribute(&cus, hipDeviceAttributeMultiprocessorCount, dev) != hipSuccess) { grid = -1; return; }
        if (hipFuncSetAttribute((const void*)fwd_kernel, hipFuncAttributeMaxDynamicSharedMemorySize, LDS_BYTES) != hipSuccess) { fprintf(stderr, "kernel_launch: hipFuncSetAttribute failed\n"); grid = -1; return; }
        (void)hipGetLastError();
        grid = cus;
    }
    if (grid < 0) return;
    (void)hipMemsetAsync((char*)d_ws + WS_CTL, 0, CTL_ZERO_BYTES, stream);
    Args a{};
    for (int i = 0; i < 32; ++i) a.in[i] = (const float*)d_in[i];
    a.out = (float*)d_out; a.ws = (unsigned char*)d_ws;
#if MK_PER_PHASE
    for (int ph = 0; ph < N_PHASES; ++ph) { a.ph_lo = ph; a.ph_hi = ph + 1; hipLaunchKernelGGL(fwd_kernel, dim3(grid), dim3(NWAVES * 64), LDS_BYTES, stream, a); }
#else
    a.ph_lo = 0; a.ph_hi = N_PHASES; hipLaunchKernelGGL(fwd_kernel, dim3(grid), dim3(NWAVES * 64), LDS_BYTES, stream, a);
#endif
}
```

```cpp
#include <hip/hip_runtime.h>
#include <cstdio>
#include <cstdint>
__device__ __forceinline__ int otid(int wv) { int l; asm volatile("v_mbcnt_lo_u32_b32 %0, -1, 0\n\tv_mbcnt_hi_u32_b32 %0, -1, %0" : "=v"(l)); return wv * 64 + l; }
namespace pg8 {
#define PG8_LAS __attribute__((address_space(3)))
typedef unsigned short bf16_t;
typedef short bf16x8 __attribute__((ext_vector_type(8)));
typedef float f32x4 __attribute__((ext_vector_type(4)));
typedef unsigned u32x4 __attribute__((ext_vector_type(4)));
constexpr int BM = 256, BK = 64, HALF = 128, HTB = HALF * BK * 2  , STAGE_BYTES = 8 * HTB, NXCD = 8, WGM = 8;

__host__ __device__ __forceinline__ int lds_byte(int r, int c) { const int st = (r >> 4) * 2 + (c >> 5), rr = r & 15, cc = c & 31, ob = rr * 64 + cc * 2; return st * 1024 + (ob ^ (((ob >> 9) & 1) << 5)); }
__host__ __device__ __forceinline__ void stage_rc(int b, int& R, int& C) { const int st = b / 1024, sb = b % 1024, swz = sb ^ (((sb >> 9) & 1) << 5); R = (st >> 1) * 16 + swz / 64; C = (st & 1) * 32 + (swz % 64) / 2; }
__host__ __device__ __forceinline__ int perm32(int rho) { const int n = rho >> 4, i = rho & 15; return 8 * (i >> 2) + 4 * n + (i & 3); }

struct Unit { int pm, pn; };
struct Gemm { const bf16_t* A; const bf16_t* Bt; int M, N, K; };

struct StaticOrder {
    int nM, nN, nwg, G, c;
    __host__ __device__ void init(int M, int N, int G_, int c_) { nM = M / BM; nN = N / BM; nwg = nM * nN; G = G_; c = c_; }
    __host__ __device__ bool next(int i, Unit& u) const {
        const long L = (long)i * G + c; if (L >= nwg) return false;
        int wgid = (int)L; { const int q = nwg / NXCD, r = nwg % NXCD, xcd = wgid % NXCD, off = wgid / NXCD; wgid = (xcd < r ? xcd * (q + 1) : r * (q + 1) + (xcd - r) * q) + off; }
        const int nig = WGM * nN, gid = wgid / nig, fm = gid * WGM, gsz = (nM - fm) < WGM ? (nM - fm) : WGM;
        u.pm = fm + ((wgid % nig) % gsz); u.pn = (wgid % nig) / gsz; return true;
    }
    __device__ __forceinline__ void a_ready(const Unit&) const {}
    __device__ __forceinline__ void done(const Unit&) const {}
};

__device__ __forceinline__ unsigned cvt_pk_bf16(float lo, float hi) { unsigned r; asm volatile("v_cvt_pk_bf16_f32 %0, %1, %2" : "=v"(r) : "v"(lo), "v"(hi)); return r; }
typedef float f32x2 __attribute__((ext_vector_type(2)));
__device__ __forceinline__ f32x2 gelu_pk(f32x2 v) {
    const f32x2 av = __builtin_elementwise_abs(v), d = av * 0.2316418882f + 1.0f;
    f32x2 t; t.x = __builtin_amdgcn_rcpf(d.x); t.y = __builtin_amdgcn_rcpf(d.y);
    f32x2 q = t * 0.5307027145f + (-0.7265760135f); q = q * t + 0.7107068705f; q = q * t + (-0.142248368f); q = q * t + 0.127414796f; q = q * t;
    const f32x2 s = (v * v) * (-0.72134752044f);
    f32x2 e; e.x = __builtin_amdgcn_exp2f(s.x); e.y = __builtin_amdgcn_exp2f(s.y);
    const f32x2 m = v * (q * e), r = v - m;
    f32x2 o; o.x = v.x < 0.f ? m.x : r.x; o.y = v.y < 0.f ? m.y : r.y; return o;
}

template <int ACT  > struct EpiBf16 {
    static constexpr bool PERM = true, AFTER_DRAIN = false; static_assert(ACT == 0 || ACT == 1, "EpiBf16: ACT is 0 (none) or 1 (gelu_pk)");
    bf16_t* O; int ldc; const float* bias; int split_cols; size_t split_stride; float scale0;
    __device__ __forceinline__ void operator()(const f32x4 (&acc)[2][2][4][2], const Unit& u, int wr, int wc, int fr, int fq) const {
        const int row0 = u.pm * BM + wr * 64 + fr; int colt = u.pn * BM; bf16_t* base = O;
        float sc = 1.f; if (split_cols) { const int t = colt / split_cols; base += (size_t)t * split_stride; colt -= t * split_cols; if (t == 0) sc = scale0; }
        const int col0 = colt + wc * 32 + 8 * fq, bcol0 = u.pn * BM + wc * 32 + 8 * fq;
        f32x4 bv[2][2];
#pragma unroll
        for (int bj = 0; bj < 2; ++bj)
#pragma unroll
            for (int n = 0; n < 2; ++n) bv[bj][n] = bias ? *(const f32x4*)(bias + bcol0 + bj * HALF + 4 * n) : (f32x4){0.f, 0.f, 0.f, 0.f};
#pragma unroll
        for (int ai = 0; ai < 2; ++ai)
#pragma unroll
            for (int m = 0; m < 4; ++m) { bf16_t* rowp = base + (size_t)(row0 + ai * HALF + m * 16) * ldc + col0;
#pragma unroll
                for (int bj = 0; bj < 2; ++bj) { f32x4 v0 = acc[ai][bj][m][0] + bv[bj][0], v1 = acc[ai][bj][m][1] + bv[bj][1];
                    if (ACT == 1) { f32x2 a = gelu_pk((f32x2){v0[0], v0[1]}), b = gelu_pk((f32x2){v0[2], v0[3]}), c = gelu_pk((f32x2){v1[0], v1[1]}), d = gelu_pk((f32x2){v1[2], v1[3]});
                        v0 = (f32x4){a.x, a.y, b.x, b.y}; v1 = (f32x4){c.x, c.y, d.x, d.y}; }
                    v0 = v0 * sc; v1 = v1 * sc; u32x4 w; w.x = cvt_pk_bf16(v0[0], v0[1]); w.y = cvt_pk_bf16(v0[2], v0[3]); w.z = cvt_pk_bf16(v1[0], v1[1]); w.w = cvt_pk_bf16(v1[2], v1[3]);
                    *(u32x4*)(rowp + bj * HALF) = w; } }
    }
};

struct PanelStats {
    unsigned* xbuf;
    unsigned* cnt;
    unsigned* tmo;
    int ntn; float eps;
    unsigned code;
    __device__ __forceinline__ bool run(const f32x4 (&v)[2][2][4][2], const Unit& u, int wr, int wc, int fr, int fq, PG8_LAS unsigned char* lds, int wid, int lane) const {
        typedef float f32x2v __attribute__((ext_vector_type(2)));
        PG8_LAS f32x2v* P = (PG8_LAS f32x2v*)lds;
        PG8_LAS f32x2v* S = (PG8_LAS f32x2v*)(lds + 8192);
        PG8_LAS unsigned* flag = (PG8_LAS unsigned*)(lds + 8192 + 2048);
#pragma unroll
        for (int ai = 0; ai < 2; ++ai)
#pragma unroll
            for (int m = 0; m < 4; ++m) {
                float s = 0.f;
#pragma unroll
                for (int bj = 0; bj < 2; ++bj)
#pragma unroll
                    for (int n = 0; n < 2; ++n) { const f32x4 x = v[ai][bj][m][n]; s += (x[0] + x[1]) + (x[2] + x[3]); }
                s += __shfl_xor(s, 16); s += __shfl_xor(s, 32);
                const float mw = s * (1.0f / 64.0f); float q = 0.f;
#pragma unroll
                for (int bj = 0; bj < 2; ++bj)
#pragma unroll
                    for (int n = 0; n < 2; ++n) { const f32x4 d = v[ai][bj][m][n] - mw; q += (d[0] * d[0] + d[1] * d[1]) + (d[2] * d[2] + d[3] * d[3]); }
                q += __shfl_xor(q, 16); q += __shfl_xor(q, 32);
                if (fq == 0) P[(ai * HALF + wr * 64 + m * 16 + fr) * 4 + wc] = (f32x2v){mw, q};
            }
        asm volatile("s_waitcnt lgkmcnt(0)" ::: "memory"); __builtin_amdgcn_s_barrier(); asm volatile("" ::: "memory");
#if defined(BROKEN_EXCHANGE_NO_WAIT)
#warning BROKEN CONTROL BUILD: the row-statistics exchange does not wait; results are wrong by design
        if (blockIdx.x >= 64) { const long long t0_ = clock64(); while (clock64() - t0_ < 60000) __builtin_amdgcn_s_sleep(8); }
#endif
        const int row = wid * 32 + (lane & 31);
        if (lane < 32) {
            const f32x2v a = P[row * 4 + 0], b = P[row * 4 + 1], c = P[row * 4 + 2], d = P[row * 4 + 3];
            const float mt = (a.x + b.x + c.x + d.x) * 0.25f;
            const float da = a.x - mt, db = b.x - mt, dc = c.x - mt, dd = d.x - mt;
            const float m2 = (a.y + b.y) + (c.y + d.y) + 64.0f * ((da * da + db * db) + (dc * dc + dd * dd));
            unsigned long long* slot = (unsigned long long*)xbuf + ((size_t)(u.pm * BM + row) * 4 + u.pn);
            __hip_atomic_store(slot, ((unsigned long long)__float_as_uint(m2) << 32) | __float_as_uint(mt), __ATOMIC_RELAXED, __HIP_MEMORY_SCOPE_AGENT);
        }
        asm volatile("s_waitcnt vmcnt(0)" ::: "memory");
        if (lane == 0) __hip_atomic_fetch_add(cnt + 64 * u.pm, 1u, __ATOMIC_RELAXED, __HIP_MEMORY_SCOPE_AGENT);
        if (wid == 0) {
            bool dead = false; const unsigned long long t0 = __builtin_amdgcn_s_memrealtime(); const unsigned want = 8u * (unsigned)ntn;
            for (;;) {
#if defined(BROKEN_EXCHANGE_NO_WAIT)
                break;
#endif
                if ((unsigned)__builtin_amdgcn_readfirstlane(__hip_atomic_load(cnt + 64 * u.pm, __ATOMIC_RELAXED, __HIP_MEMORY_SCOPE_AGENT)) >= want) break;
                if (__builtin_amdgcn_s_memrealtime() - t0 > 2000000ull) {
                    if (lane == 0) { unsigned expect = 0u; __hip_atomic_compare_exchange_strong(tmo + 1, &expect, code | (unsigned)(u.pm & 0xff), __ATOMIC_RELAXED, __ATOMIC_RELAXED, __HIP_MEMORY_SCOPE_AGENT);
                                     __hip_atomic_store(tmo, 1u, __ATOMIC_RELAXED, __HIP_MEMORY_SCOPE_AGENT); }
                    dead = true; break; }
                __builtin_amdgcn_s_sleep(2);
            }
            __builtin_amdgcn_fence(__ATOMIC_ACQUIRE, "agent");
            if (lane == 0) flag[0] = dead ? 1u : 0u;
        }
        asm volatile("s_waitcnt vmcnt(0) lgkmcnt(0)" ::: "memory"); __builtin_amdgcn_s_barrier(); asm volatile("" ::: "memory");
        const bool bad = flag[0] != 0u;
        if (lane < 32) {
            const unsigned long long* slot = (const unsigned long long*)xbuf + (size_t)(u.pm * BM + row) * 4; float mt[4], m2[4]; float ms = 0.f;
#pragma unroll
            for (int t = 0; t < 4; ++t) { if (t < ntn) { const unsigned long long w = __hip_atomic_load(slot + t, __ATOMIC_RELAXED, __HIP_MEMORY_SCOPE_AGENT); mt[t] = __uint_as_float((unsigned)w); m2[t] = __uint_as_float((unsigned)(w >> 32)); } else { mt[t] = 0.f; m2[t] = 0.f; } ms += mt[t]; }
            const float mean = ms / (float)ntn; float q = 0.f;
#pragma unroll
            for (int t = 0; t < 4; ++t) if (t < ntn) { const float dm = mt[t] - mean; q += m2[t] + 256.0f * dm * dm; }
            S[row] = (f32x2v){mean, 1.0f / sqrtf(q / (256.0f * (float)ntn) + eps)};
        }
        asm volatile("s_waitcnt lgkmcnt(0)" ::: "memory"); __builtin_amdgcn_s_barrier(); asm volatile("" ::: "memory");
        return bad;
    }
};
struct EpiLnRes {
    static constexpr bool PERM = false, AFTER_DRAIN = true;
    const float* base; float* out; int ldc; const float* bias; PanelStats st; unsigned poison;
    __device__ __forceinline__ void fused(f32x4 (&acc)[2][2][4][2], const Unit& u, int wr, int wc, int fr, int fq, PG8_LAS unsigned char* lds, int wid, int lane) const {
        typedef float f32x2v __attribute__((ext_vector_type(2)));
        const PG8_LAS f32x2v* S = (const PG8_LAS f32x2v*)(lds + 8192);
        const int col0 = u.pn * BM + wc * 32 + 4 * fq;
#pragma unroll
        for (int bj = 0; bj < 2; ++bj)
#pragma unroll
            for (int n = 0; n < 2; ++n) { const f32x4 bv = bias ? *(const f32x4*)(bias + col0 + bj * HALF + n * 16) : (f32x4){0.f, 0.f, 0.f, 0.f};
#pragma unroll
                for (int ai = 0; ai < 2; ++ai)
#pragma unroll
                    for (int m = 0; m < 4; ++m) acc[ai][bj][m][n] += bv; }
        f32x4 pre[4][2][2];
#pragma unroll
        for (int m = 0; m < 4; ++m) { const size_t off = (size_t)(u.pm * BM + wr * 64 + m * 16 + fr) * ldc + col0;
#pragma unroll
            for (int bj = 0; bj < 2; ++bj)
#pragma unroll
                for (int n = 0; n < 2; ++n) pre[m][bj][n] = *(const f32x4*)(base + off + bj * HALF + n * 16); }
        const bool bad = st.run(acc, u, wr, wc, fr, fq, lds, wid, lane) || poison != 0u;
        const float qnan = __builtin_nanf("");
#pragma unroll
        for (int ai = 0; ai < 2; ++ai)
#pragma unroll
            for (int m = 0; m < 4; ++m) { const int r = ai * HALF + wr * 64 + m * 16 + fr; const f32x2v sr = S[r]; const size_t off = (size_t)(u.pm * BM + r) * ldc + col0;
#pragma unroll
                for (int bj = 0; bj < 2; ++bj)
#pragma unroll
                    for (int n = 0; n < 2; ++n) { const f32x4 bs = ai == 0 ? pre[m][bj][n] : *(const f32x4*)(base + off + bj * HALF + n * 16); f32x4 o = bs + (acc[ai][bj][m][n] - sr.x) * sr.y;
                        if (bad) o = (f32x4){qnan, qnan, qnan, qnan}; *(f32x4*)(out + off + bj * HALF + n * 16) = o; }
                if (m & 1) asm volatile("" ::: "memory"); }
    }
};
struct EpiLnResLn {
    static constexpr bool PERM = false, AFTER_DRAIN = true;
    const float* base; float* out; bf16_t* xn; int ldc; const float* bias; PanelStats st1, st2; unsigned poison;
    __device__ __forceinline__ void fused(f32x4 (&acc)[2][2][4][2], const Unit& u, int wr, int wc, int fr, int fq, PG8_LAS unsigned char* lds, int wid, int lane) const {
        typedef float f32x2v __attribute__((ext_vector_type(2))); typedef unsigned u32x2v __attribute__((ext_vector_type(2)));
        const PG8_LAS f32x2v* S = (const PG8_LAS f32x2v*)(lds + 8192);
        const int col0 = u.pn * BM + wc * 32 + 4 * fq;
#pragma unroll
        for (int bj = 0; bj < 2; ++bj)
#pragma unroll
            for (int n = 0; n < 2; ++n) { const f32x4 bv = bias ? *(const f32x4*)(bias + col0 + bj * HALF + n * 16) : (f32x4){0.f, 0.f, 0.f, 0.f};
#pragma unroll
                for (int ai = 0; ai < 2; ++ai)
#pragma unroll
                    for (int m = 0; m < 4; ++m) acc[ai][bj][m][n] += bv; }
        bool bad = st1.run(acc, u, wr, wc, fr, fq, lds, wid, lane) || poison != 0u;
        const float qnan = __builtin_nanf("");
#pragma unroll
        for (int ai = 0; ai < 2; ++ai)
#pragma unroll
            for (int m = 0; m < 4; ++m) { const int r = ai * HALF + wr * 64 + m * 16 + fr; const f32x2v sr = S[r]; const size_t off = (size_t)(u.pm * BM + r) * ldc + col0;
#pragma unroll
                for (int bj = 0; bj < 2; ++bj)
#pragma unroll
                    for (int n = 0; n < 2; ++n) { const f32x4 bs = *(const f32x4*)(base + off + bj * HALF + n * 16); acc[ai][bj][m][n] = bs + (acc[ai][bj][m][n] - sr.x) * sr.y; }
                asm volatile("" : "+v"(acc[ai][0][m][0]), "+v"(acc[ai][0][m][1]), "+v"(acc[ai][1][m][0]), "+v"(acc[ai][1][m][1]));
                if (m & 1) asm volatile("" ::: "memory"); }
        const bool bad1 = bad;
        bad = st2.run(acc, u, wr, wc, fr, fq, lds, wid, lane) || bad;
#pragma unroll
        for (int ai = 0; ai < 2; ++ai)
#pragma unroll
            for (int m = 0; m < 4; ++m) { const int r = ai * HALF + wr * 64 + m * 16 + fr; const f32x2v sr = S[r]; const size_t off = (size_t)(u.pm * BM + r) * ldc + col0;
#pragma unroll
                for (int bj = 0; bj < 2; ++bj)
#pragma unroll
                    for (int n = 0; n < 2; ++n) { const f32x4 x1 = acc[ai][bj][m][n]; *(f32x4*)(out + off + bj * HALF + n * 16) = bad1 ? (f32x4){qnan, qnan, qnan, qnan} : x1;
                        const f32x4 o = (x1 - sr.x) * sr.y; u32x2v w; w.x = cvt_pk_bf16(o[0], o[1]); w.y = cvt_pk_bf16(o[2], o[3]);
                        if (bad) { w.x = 0x7fc07fc0u; w.y = 0x7fc07fc0u; } *(u32x2v*)(xn + off + bj * HALF + n * 16) = w; }
                asm volatile("" ::: "memory"); }
    }
};

template <class Epi, class Sched, bool ALIGN_EPI = false, bool SP2 = false>
__device__ __forceinline__ void gemm_phase(PG8_LAS unsigned char* lds, const Gemm g, const Sched& S, const Epi& E, const int wv) {
    const int tid = otid(wv), wid = __builtin_amdgcn_readfirstlane(tid >> 6), lane = tid & 63, wr = wid >> 2, wc = wid & 3, fr = lane & 15, fq = lane >> 4;
    const int K = g.K, nt = K / BK;
    unsigned voffA[2], voffB[2];
#pragma unroll
    for (int i = 0; i < 2; ++i) { int R, C; stage_rc(tid * 16 + i * 8192, R, C); const int Rb = Epi::PERM ? ((R & ~31) + perm32(R & 31)) : R;
        voffA[i] = (unsigned)(R * K + C) * 2u; voffB[i] = (unsigned)(Rb * K + C) * 2u; }
    const size_t kstep = (size_t)(BK * 2);
    const size_t hstep = (size_t)HALF * K * 2;
    const size_t tstep = 2 * hstep;
    const unsigned ldsw = (unsigned)wid * 1024u;
    const int aoff = lds_byte(wr * 64 + fr, fq * 8), boff = lds_byte(wc * 32 + fr, fq * 8);
#define PG8_SA(b, h) (((b) * 2 + (h)) * HTB)
#define PG8_SB(b, h) ((4 + (b) * 2 + (h)) * HTB)
#define PG8_STAGE(bufoff, gbase, voff) do { _Pragma("unroll") for (int _i = 0; _i < 2; ++_i) \
        __builtin_amdgcn_global_load_lds((const unsigned*)((const char*)(gbase) + (voff)[_i]), (PG8_LAS unsigned*)(lds + (bufoff) + ldsw + _i * 8192), 16, 0, 0); } while (0)
#define PG8_LDA(dst, b, h) do { _Pragma("unroll") for (int m = 0; m < 4; ++m) _Pragma("unroll") for (int k = 0; k < 2; ++k) dst[m][k] = *(const PG8_LAS bf16x8*)(lds + PG8_SA(b, h) + aoff + m * 2048 + k * 1024); } while (0)
#define PG8_LDB(dst, b, h) do { _Pragma("unroll") for (int n = 0; n < 2; ++n) _Pragma("unroll") for (int k = 0; k < 2; ++k) dst[n][k] = *(const PG8_LAS bf16x8*)(lds + PG8_SB(b, h) + boff + n * 2048 + k * 1024); } while (0)
#define PG8_MMA(ai, bj, At, Bt) do { __builtin_amdgcn_s_setprio(1); _Pragma("unroll") for (int m = 0; m < 4; ++m) _Pragma("unroll") for (int n = 0; n < 2; ++n) _Pragma("unroll") for (int k = 0; k < 2; ++k) \
        acc[ai][bj][m][n] = __builtin_amdgcn_mfma_f32_16x16x32_bf16(Bt[n][k], At[m][k], acc[ai][bj][m][n], 0, 0, 0); __builtin_amdgcn_s_setprio(0); } while (0)
#define PG8_WAIT_V(n) asm volatile("s_waitcnt vmcnt(" #n ")" ::: "memory")
#define PG8_WAIT_L(n) asm volatile("s_waitcnt lgkmcnt(" #n ")" ::: "memory")
#define PG8_BAR __builtin_amdgcn_s_barrier()
#define PG8_SCHED __builtin_amdgcn_sched_barrier(0)
    Unit cur, nxt; int ui = 0;
    if (!S.next(0, cur)) return;
    f32x4 acc[2][2][4][2];
#pragma unroll
    for (int a = 0; a < 2; ++a)
#pragma unroll
        for (int b = 0; b < 2; ++b)
#pragma unroll
            for (int m = 0; m < 4; ++m)
#pragma unroll
                for (int n = 0; n < 2; ++n) acc[a][b][m][n] = (f32x4){0.f, 0.f, 0.f, 0.f};
    bf16x8 At[4][2], B0[2][2], B1[2][2];
    const char* cA = (const char*)g.A + (size_t)cur.pm * tstep; const char* cB = (const char*)g.Bt + (size_t)cur.pn * tstep;
    S.a_ready(cur);
    if constexpr (SP2) {
        PG8_STAGE(PG8_SB(0, 0), cB, voffB); PG8_STAGE(PG8_SB(0, 1), cB + hstep, voffB); PG8_STAGE(PG8_SA(0, 0), cA, voffA); PG8_STAGE(PG8_SA(0, 1), cA + hstep, voffA);
        if (wr == 1) PG8_BAR;
        PG8_WAIT_V(2); PG8_BAR;
        PG8_STAGE(PG8_SB(1, 0), cB + kstep, voffB); PG8_STAGE(PG8_SA(1, 0), cA + kstep, voffA); PG8_STAGE(PG8_SB(1, 1), cB + hstep + kstep, voffB);
        PG8_WAIT_V(6); PG8_BAR;
    } else {
        PG8_STAGE(PG8_SB(0, 0), cB, voffB); PG8_STAGE(PG8_SA(0, 0), cA, voffA); PG8_STAGE(PG8_SB(0, 1), cB + hstep, voffB); PG8_STAGE(PG8_SA(0, 1), cA + hstep, voffA);
        if (wr == 1) PG8_BAR;
        PG8_WAIT_V(4); PG8_BAR;
        PG8_STAGE(PG8_SB(1, 0), cB + kstep, voffB); PG8_STAGE(PG8_SA(1, 0), cA + kstep, voffA); PG8_STAGE(PG8_SB(1, 1), cB + hstep + kstep, voffB);
        PG8_WAIT_V(6); PG8_BAR;
    }
    for (;;) {
        const bool has_next = S.next(ui + 1, nxt);
        const char* nA = has_next ? (const char*)g.A + (size_t)nxt.pm * tstep : cA; const char* nB = has_next ? (const char*)g.Bt + (size_t)nxt.pn * tstep : cB;
        for (int t = 0; t < nt; t += 2) {
            const bool last = (t == nt - 2);
            const char* a1 = cA + (size_t)(t + 1) * kstep;
            const char* a2 = last ? nA : cA + (size_t)(t + 2) * kstep; const char* b2 = last ? nB : cB + (size_t)(t + 2) * kstep;
            const char* a3 = a2 + kstep; const char* b3 = b2 + kstep;
            if (last && has_next) S.a_ready(nxt);
            if constexpr (SP2) {
            PG8_LDB(B0, 0, 0); PG8_LDB(B1, 0, 1); PG8_SCHED; PG8_LDA(At, 0, 0); PG8_STAGE(PG8_SA(1, 1), a1 + hstep, voffA);
            PG8_WAIT_V(8); PG8_WAIT_L(0); PG8_BAR; PG8_MMA(0, 0, At, B0); PG8_MMA(0, 1, At, B1); PG8_BAR; PG8_SCHED;
            PG8_LDA(At, 0, 1); PG8_STAGE(PG8_SB(0, 0), b2, voffB); PG8_STAGE(PG8_SB(0, 1), b2 + hstep, voffB); PG8_STAGE(PG8_SA(0, 0), a2, voffA);
            PG8_WAIT_V(8); PG8_WAIT_L(0); PG8_BAR; PG8_MMA(1, 0, At, B0); PG8_MMA(1, 1, At, B1); PG8_BAR; PG8_SCHED;
            PG8_LDB(B0, 1, 0); PG8_LDB(B1, 1, 1); PG8_SCHED; PG8_LDA(At, 1, 0); PG8_STAGE(PG8_SA(0, 1), a2 + hstep, voffA);
            PG8_WAIT_V(8); PG8_WAIT_L(0); PG8_BAR; PG8_MMA(0, 0, At, B0); PG8_MMA(0, 1, At, B1); PG8_BAR; PG8_SCHED;
            PG8_LDA(At, 1, 1); PG8_STAGE(PG8_SB(1, 0), b3, voffB); PG8_STAGE(PG8_SB(1, 1), b3 + hstep, voffB); PG8_STAGE(PG8_SA(1, 0), a3, voffA);
            PG8_WAIT_V(8); PG8_WAIT_L(0); PG8_BAR; PG8_MMA(1, 0, At, B0); PG8_MMA(1, 1, At, B1); PG8_BAR; PG8_SCHED;
            } else {
            PG8_LDB(B0, 0, 0); PG8_SCHED; PG8_LDA(At, 0, 0); PG8_STAGE(PG8_SA(1, 1), a1 + hstep, voffA);
            PG8_WAIT_L(8); PG8_BAR; PG8_WAIT_L(0); PG8_MMA(0, 0, At, B0); PG8_BAR; PG8_SCHED;
            PG8_LDB(B1, 0, 1); PG8_STAGE(PG8_SB(0, 0), b2, voffB);
            PG8_BAR; PG8_WAIT_L(0); PG8_MMA(0, 1, At, B1); PG8_BAR;
            PG8_LDA(At, 0, 1); PG8_STAGE(PG8_SA(0, 0), a2, voffA);
            PG8_BAR; PG8_WAIT_L(0); PG8_MMA(1, 0, At, B0); PG8_BAR; PG8_SCHED;
            PG8_STAGE(PG8_SB(0, 1), b2 + hstep, voffB);
            PG8_WAIT_V(6); PG8_BAR; PG8_MMA(1, 1, At, B1); PG8_BAR;
            PG8_LDB(B0, 1, 0); PG8_SCHED; PG8_LDA(At, 1, 0); PG8_STAGE(PG8_SA(0, 1), a2 + hstep, voffA);
            PG8_WAIT_L(8); PG8_BAR; PG8_WAIT_L(0); PG8_MMA(0, 0, At, B0); PG8_BAR; PG8_SCHED;
            PG8_LDB(B1, 1, 1); PG8_STAGE(PG8_SB(1, 0), b3, voffB);
            PG8_BAR; PG8_WAIT_L(0); PG8_MMA(0, 1, At, B1); PG8_BAR;
            PG8_LDA(At, 1, 1); PG8_STAGE(PG8_SA(1, 0), a3, voffA);
            PG8_BAR; PG8_WAIT_L(0); PG8_MMA(1, 0, At, B0); PG8_BAR; PG8_SCHED;
            PG8_STAGE(PG8_SB(1, 1), b3 + hstep, voffB);
            PG8_WAIT_V(6); PG8_BAR; PG8_MMA(1, 1, At, B1); PG8_BAR;
            }
        }
        if constexpr (ALIGN_EPI) { if (wr == 0) PG8_BAR; }
        if constexpr (!Epi::AFTER_DRAIN) { E(acc, cur, wr, wc, fr, fq); S.done(cur); }
        if (!has_next) break;
#pragma unroll
        for (int a = 0; a < 2; ++a)
#pragma unroll
            for (int b = 0; b < 2; ++b)
#pragma unroll
                for (int m = 0; m < 4; ++m)
#pragma unroll
                    for (int n = 0; n < 2; ++n) acc[a][b][m][n] = (f32x4){0.f, 0.f, 0.f, 0.f};
        cur = nxt; cA = nA; cB = nB; ++ui;
        if constexpr (ALIGN_EPI) { if (wr == 1) PG8_BAR; }
    }
    PG8_WAIT_V(0);
    if constexpr (!ALIGN_EPI) { if (wr == 0) PG8_BAR; }
    PG8_BAR;
    if constexpr (Epi::AFTER_DRAIN) { E.fused(acc, cur, wr, wc, fr, fq, lds, wid, lane); S.done(cur); }
#undef PG8_SA
#undef PG8_SB
#undef PG8_STAGE
#undef PG8_LDA
#undef PG8_LDB
#undef PG8_MMA
#undef PG8_WAIT_V
#undef PG8_WAIT_L
#undef PG8_BAR
#undef PG8_SCHED
}
}

#ifndef PG8_SP2
#define PG8_SP2 true
#endif
#ifndef PG8_ALIGN
#define PG8_ALIGN true
#endif
#define GAS __attribute__((address_space(1)))
#define LAS __attribute__((address_space(3)))
typedef unsigned short bf16;
typedef unsigned v4u __attribute__((ext_vector_type(4)));
typedef float f32x4 __attribute__((ext_vector_type(4)));
typedef short bf16x8 __attribute__((ext_vector_type(8)));
typedef GAS unsigned gu32;
typedef GAS unsigned long long gu64;
#define RLX_AGENT __ATOMIC_RELAXED, __HIP_MEMORY_SCOPE_AGENT
#define LDS_WAIT() asm volatile("s_waitcnt lgkmcnt(0)" ::: "memory")
#define VM_WAIT() asm volatile("s_waitcnt vmcnt(0)" ::: "memory")
__device__ __forceinline__ unsigned long long rt() { return __builtin_amdgcn_s_memrealtime(); }
__device__ __forceinline__ unsigned f2bf(float f) { unsigned u = __builtin_bit_cast(unsigned, f); return (u + 0x7fffu + ((u >> 16) & 1u)) >> 16; }
__device__ __forceinline__ unsigned pk2(float lo, float hi) { return f2bf(lo) | (f2bf(hi) << 16); }

#define XB_TMO      128
#define XB_XCNT(j)  (256  + 64 * (j))
#define XB_XSUB(j)  (1280 + 64 * (j))
#define XB_XGEN(j)  (2304 + 64 * (j))
#define XB_TOP      3328
#define XB_TOPGEN   3392
#define XCD_BAR_WORDS 3456
#define XB_SPIN_CAP (1u << 18)

__device__ __forceinline__ unsigned xb_ld(unsigned* p)              { return __hip_atomic_load(p, __ATOMIC_RELAXED, __HIP_MEMORY_SCOPE_AGENT); }
__device__ __forceinline__ unsigned xb_add(unsigned* p, unsigned v) { return __hip_atomic_fetch_add(p, v, __ATOMIC_RELAXED, __HIP_MEMORY_SCOPE_AGENT); }
__device__ __forceinline__ unsigned xb_xcc_id() { return (unsigned)__builtin_amdgcn_s_getreg((3 << 11) | 20) & 0xFu; }
#define XB_SPIN(cond, bar) do { unsigned _sp = 0; while (cond) { __builtin_amdgcn_s_sleep(1); \
    if ((++_sp & 255u) == 0u) { if (xb_ld(&(bar)[XB_TMO])) break; if (_sp > XB_SPIN_CAP) { atomicAdd(&(bar)[XB_TMO], 1u); break; } } } } while (0)

struct XcdBarrier {
    unsigned* bar; unsigned x;
    volatile LAS unsigned* st;
    int wv;
};

__device__ __forceinline__ XcdBarrier xcd_barrier_post(unsigned* bar, volatile LAS unsigned* st) {
    XcdBarrier b; b.bar = bar; b.x = xb_xcc_id(); b.st = st;
    if (threadIdx.x == 0) (void)xb_add(&bar[XB_XCNT(b.x)], 1u);
    return b;
}
__device__ __forceinline__ void xcd_barrier_complete(unsigned* bar, unsigned x, unsigned& nloc, unsigned& nx) {
    const unsigned G = gridDim.x * gridDim.y * gridDim.z;
    unsigned sum, cnt, mine, sp = 0u;
    for (;;) {
        sum = 0u; cnt = 0u; mine = 0u;
#pragma unroll
        for (unsigned j = 0; j < 16; ++j) { const unsigned c = xb_ld(&bar[XB_XCNT(j)]); sum += c; cnt += (c > 0u) ? 1u : 0u; mine = (j == x) ? c : mine; }
        if (sum == G) break;
        __builtin_amdgcn_s_sleep(1);
        if ((++sp & 255u) == 0u) { if (xb_ld(&bar[XB_TMO])) break; if (sp > XB_SPIN_CAP) { atomicAdd(&bar[XB_TMO], 1u); break; } }
    }
    nloc = mine > 0u ? mine : 1u; nx = cnt > 0u ? cnt : 1u;
}

__device__ __forceinline__ void xcd_barrier(const XcdBarrier& b) {
    asm volatile("s_waitcnt vmcnt(0)" ::: "memory");
    __syncthreads();
    if (otid(b.wv) == 0) {
        unsigned* bar = b.bar;
        __builtin_amdgcn_s_waitcnt(0);
        unsigned nloc = b.st[0], nx = b.st[1];
        if (nloc == 0u) { xcd_barrier_complete(bar, b.x, nloc, nx); b.st[0] = nloc; b.st[1] = nx; }
        const unsigned old = xb_add(&bar[XB_XSUB(b.x)], 1u);
        const unsigned gen = old / nloc;
        if (old + 1u == (gen + 1u) * nloc) {
            __builtin_amdgcn_fence(__ATOMIC_RELEASE, "agent");
            asm volatile("s_waitcnt vmcnt(0)" ::: "memory");
            const unsigned og = xb_add(&bar[XB_TOP], 1u);
            const unsigned tg = og / nx;
            if (og + 1u == (tg + 1u) * nx) xb_add(&bar[XB_TOPGEN], 1u);
            else XB_SPIN(xb_ld(&bar[XB_TOPGEN]) == tg, bar);
            __builtin_amdgcn_fence(__ATOMIC_ACQUIRE, "agent");
            xb_add(&bar[XB_XGEN(b.x)], 1u);
            asm volatile("s_waitcnt vmcnt(0)" ::: "memory");
        } else {
            XB_SPIN(xb_ld(&bar[XB_XGEN(b.x)]) == gen, bar);
            __builtin_amdgcn_fence(__ATOMIC_ACQUIRE, "agent");
            asm volatile("s_waitcnt vmcnt(0)" ::: "memory");
        }
    }
    __syncthreads();
}


constexpr int NB = 8, SEQ = 2048, CTXL = 256, DM = 1024, NL = 4;
constexpr int ML = NB * SEQ, MC = NB * CTXL, MT = ML + MC;
constexpr int NIN = 2464, NINP = 2560, DFF = 2816, NUP = 5632, KMLA = 384, NMLA = 1024;
constexpr int NKEY = SEQ + CTXL, NKT = NKEY / 64;
constexpr float EPS = 1e-6f;
constexpr float LOG2E = 1.4426950408889634f;
constexpr int PC_CQ = 0, PC_CKV = 256, PC_KR = 384, PC_DQ = 512, PC_DK = 768, PC_DV = 1024, PC_NQ = 1280, PC_NK = 1536, PC_NV = 1792, PC_GQ = 2048, PC_GK = 2304, PC_GV = 2432;

constexpr size_t MiB = 1u << 20;
constexpr size_t WS_CTL = 0, CTL_ZERO_BYTES = 1 * MiB;
constexpr size_t WS_MODS = 1 * MiB;
constexpr size_t WS_ROPE32 = 2 * MiB;
constexpr size_t WS_ROPE64 = 2 * MiB + 262144;
constexpr size_t WS_W = 3 * MiB;
constexpr size_t W_IN = 0, W_OUT = W_IN + (size_t)NINP * DM * 2, W_UP = W_OUT + (size_t)DM * DM * 2, W_DOWN = W_UP + (size_t)NUP * DM * 2, W_MLA = W_DOWN + (size_t)DM * DFF * 2, W_LAYER = W_MLA + (size_t)NMLA * KMLA * 2;
static_assert(W_LAYER == 25427968, "weights per layer");
constexpr size_t WS_XC = 100 * MiB;
constexpr size_t WS_R2 = 108 * MiB;
constexpr size_t WS_XN = WS_R2, WS_MLAP = WS_R2, WS_CQKV = WS_R2 + 36 * MiB;
constexpr size_t WS_R1 = 158 * MiB;
constexpr size_t WS_P = WS_R1, WS_QKV = WS_R1 + 90 * MiB, WS_MIX = WS_R1, WS_ACT = WS_R1, WS_HALO = WS_R1 + 100 * MiB;
constexpr size_t WS_END = WS_R1 + 198 * MiB;
static_assert(WS_W + NL * W_LAYER <= WS_XC, "weights fit");
static_assert((size_t)MT * NINP * 2 <= 90 * MiB && (size_t)MT * DFF * 2 <= 100 * MiB && (size_t)72 * 4 * NUP * 4 <= 8 * MiB, "R1 map");
constexpr size_t E_QA = 0, E_KA = E_QA + (size_t)NB * 4 * NKEY * 96, E_VA = E_KA + (size_t)NB * 4 * NKEY * 96, E_QD = E_VA + (size_t)NB * 4 * NKEY * 64,
                 E_KD = E_QD + (size_t)NB * 8 * NKEY * 32, E_VD = E_KD + (size_t)NB * 8 * NKEY * 32, E_QN = E_VD + (size_t)NB * 4 * NKEY * 64, E_KN = E_QN + (size_t)NB * 4 * NKEY * 64,
                 E_VN = E_KN + (size_t)NB * 4 * NKEY * 64, E_QG = E_VN + (size_t)NB * 4 * NKEY * 64, E_KG = E_QG + (size_t)NB * 4 * NKEY * 64, E_VG = E_KG + (size_t)NB * 2 * NKEY * 64,
                 E_END = E_VG + (size_t)NB * 2 * NKEY * 64;
static_assert(E_END * 2 <= 108 * MiB, "QKV map");
constexpr int CW_TMO = 0, CW_CODE = 1, CW_BAR = 4096;

constexpr int RING_OFF = 0, RING_BYTES = 131072;
constexpr int LDSCTL_OFF = RING_BYTES, MISC_OFF = LDSCTL_OFF + 320;
constexpr int EX_OFF = RING_BYTES + 1024;
constexpr int LDS_BYTES = 147456;
static_assert(EX_OFF + 8192 <= LDS_BYTES, "LDS map");
constexpr int NWAVES = 8;

typedef float f32x2v __attribute__((ext_vector_type(2)));
typedef unsigned u32x2v __attribute__((ext_vector_type(2)));

__device__ __forceinline__ float bf2f(unsigned short v) { return __uint_as_float((unsigned)v << 16); }
__device__ __forceinline__ float bflo(unsigned w) { return __uint_as_float(w << 16); }
__device__ __forceinline__ float bfhi(unsigned w) { return __uint_as_float(w & 0xffff0000u); }
__device__ __forceinline__ float wave_sum(float v) {
#pragma unroll
    for (int o = 1; o < 64; o <<= 1) v += __shfl_xor(v, o);
    return v;
}
__device__ __forceinline__ float silu_f(float x) { return x / (1.f + __expf(-x)); }

__device__ __forceinline__ size_t q_off(int H, int DK, int b, int h, int q) { return ((size_t)(b * H + h) * NKEY + q) * DK; }
__device__ __forceinline__ size_t k_off(int H, int DK, int b, int h, int key, int d) { return ((((size_t)(b * H + h) * NKT + (key >> 6)) * (DK >> 3) + (d >> 3)) * 64 + (key & 63)) * 8 + (d & 7); }
__device__ __forceinline__ size_t v_off(int H, int b, int h, int key, int dv) {
    const int kk = key & 63, s = kk >> 4, i = kk & 15, hh = (i >> 2) & 1, j = (i & 3) + 4 * (i >> 3);
    return ((((size_t)(b * H + h) * NKT + (key >> 6)) * 8 + (s * 2 + hh)) * 64 + dv) * 8 + j;
}

constexpr int PT_OFF = LDSCTL_OFF + 512;
struct Ctx {
    LAS unsigned char* lds;
    int tid, lane, wave, G, gw, NGW;
};
extern __shared__ __attribute__((aligned(16))) unsigned char lds_raw[];
__device__ __forceinline__ Ctx make_ctx(const int wv) {
    unsigned zl = 0; asm volatile("" : "+s"(zl));
    Ctx C; C.lds = (LAS unsigned char*)lds_raw + zl;
    const int t = otid(wv);
    C.tid = t; C.lane = t & 63; C.wave = wv;
    C.G = gridDim.x; { const int bx = blockIdx.x; const int vcu = (C.G % 8 == 0) ? (bx % 8) * (C.G / 8) + bx / 8 : bx; C.gw = vcu * NWAVES + C.wave; } C.NGW = C.G * NWAVES;
    return C;
}
__device__ __forceinline__ unsigned long long ptab(const Ctx& C, int i) {
    const unsigned long long p = ((const LAS unsigned long long*)(C.lds + PT_OFF))[i];
    const unsigned lo = __builtin_amdgcn_readfirstlane((unsigned)p), hi = __builtin_amdgcn_readfirstlane((unsigned)(p >> 32));
    return ((unsigned long long)hi << 32) | lo;
}
__device__ __forceinline__ const float* inp(const Ctx& C, int i) { return (const float*)ptab(C, i); }
__device__ __forceinline__ float* outp(const Ctx& C) { return (float*)ptab(C, 32); }
__device__ __forceinline__ unsigned char* wsp(const Ctx& C) { return (unsigned char*)ptab(C, 33); }
__device__ __forceinline__ bf16* wptr(const Ctx& C, int l, size_t off) { return (bf16*)(wsp(C) + WS_W + (size_t)l * W_LAYER + off); }
__device__ __forceinline__ float lambda_init(int l) { return l == 0 ? 0.2f : l == 1 ? (float)(0.8 - 0.6 * 0.7408182206817179) : l == 2 ? (float)(0.8 - 0.6 * 0.5488116360940264) : (float)(0.8 - 0.6 * 0.4065696597405991); }

namespace pg8 {
struct EpiResGate {
    static constexpr bool PERM = false, AFTER_DRAIN = false;
    const float* base_lat; const float* base_ctx; float* out_lat; float* out_ctx; const float* gate;
    __device__ __forceinline__ void operator()(const f32x4 (&acc)[2][2][4][2], const Unit& u, int wr, int wc, int fr, int fq) const {
        const bool lat = u.pm < 64; const int bidx = lat ? (u.pm >> 3) : 8;
        const size_t rowt = lat ? (size_t)u.pm * BM : (size_t)(u.pm - 64) * BM;
        const float* base = (lat ? base_lat : base_ctx) + rowt * DM; float* out = (lat ? out_lat : out_ctx) + rowt * DM;
        const int row0 = wr * 64 + fr, col0 = u.pn * BM + wc * 32 + 4 * fq;
        f32x4 gv[2][2];
#pragma unroll
        for (int bj = 0; bj < 2; ++bj)
#pragma unroll
            for (int n = 0; n < 2; ++n) gv[bj][n] = *(const f32x4*)(gate + (size_t)bidx * 6144 + col0 + bj * HALF + n * 16);
#pragma unroll
        for (int ai = 0; ai < 2; ++ai)
#pragma unroll
            for (int m = 0; m < 4; ++m) { const size_t off = (size_t)(row0 + ai * HALF + m * 16) * DM + col0;
#pragma unroll
                for (int bj = 0; bj < 2; ++bj)
#pragma unroll
                    for (int n = 0; n < 2; ++n) { const f32x4 bs = *(const f32x4*)(base + off + bj * HALF + n * 16); *(f32x4*)(out + off + bj * HALF + n * 16) = bs + gv[bj][n] * acc[ai][bj][m][n]; }
                if (m & 1) asm volatile("" ::: "memory"); }
    }
};
__device__ __forceinline__ f32x4 shf4(const f32x4 v, int src) { f32x4 r; r[0] = __shfl(v[0], src); r[1] = __shfl(v[1], src); r[2] = __shfl(v[2], src); r[3] = __shfl(v[3], src); return r; }
__device__ __forceinline__ f32x4 sel4(bool c, const f32x4 a, const f32x4 b) { f32x4 r; r[0] = c ? a[0] : b[0]; r[1] = c ? a[1] : b[1]; r[2] = c ? a[2] : b[2]; r[3] = c ? a[3] : b[3]; return r; }
__device__ __forceinline__ float silu1(float x) { return x * __builtin_amdgcn_rcpf(1.f + __expf(-x)); }
struct EpiConvGate {
    static constexpr bool PERM = true, AFTER_DRAIN = false;
    bf16_t* ACT; float* HALO; const float* cw; const float* cb; PG8_LAS float* EX;
    __device__ __forceinline__ void operator()(const f32x4 (&acc)[2][2][4][2], const Unit& u, int wr, int wc, int fr, int fq) const {
        const int lane = fq * 16 + fr;
        const int jc = u.pn * 128 + wc * 32 + 8 * fq;
        if (fr == 0) {
#pragma unroll
            for (int ai = 0; ai < 2; ++ai)
#pragma unroll
                for (int bj = 0; bj < 2; ++bj)
#pragma unroll
                    for (int n = 0; n < 2; ++n) *(PG8_LAS f32x4*)(EX + ((((wr * 4 + wc) * 2 + ai) * 2 + 0) * 64 + bj * 32 + 8 * fq + 4 * n)) = acc[ai][bj][0][n];
        }
        if (fr == 15) {
#pragma unroll
            for (int ai = 0; ai < 2; ++ai)
#pragma unroll
                for (int bj = 0; bj < 2; ++bj)
#pragma unroll
                    for (int n = 0; n < 2; ++n) *(PG8_LAS f32x4*)(EX + ((((wr * 4 + wc) * 2 + ai) * 2 + 1) * 64 + bj * 32 + 8 * fq + 4 * n)) = acc[ai][bj][3][n];
        }
        asm volatile("s_waitcnt lgkmcnt(0)" ::: "memory"); __builtin_amdgcn_s_barrier(); asm volatile("" ::: "memory");
        if (u.pm < 64) {
            float* hb = HALO + (size_t)u.pm * 4 * NUP;
            if (wr == 0 && fr < 2) {
#pragma unroll
                for (int bj = 0; bj < 2; ++bj)
#pragma unroll
                    for (int n = 0; n < 2; ++n) *(f32x4*)(hb + (size_t)fr * NUP + bj * DFF + jc + 4 * n) = acc[0][bj][0][n];
            }
            if (wr == 1 && fr >= 14) {
#pragma unroll
                for (int bj = 0; bj < 2; ++bj)
#pragma unroll
                    for (int n = 0; n < 2; ++n) *(f32x4*)(hb + (size_t)(fr - 12) * NUP + bj * DFF + jc + 4 * n) = acc[1][bj][3][n];
            }
        }
        const int srcR = (lane & 48) | ((lane - 1) & 15), srcL = (lane & 48) | ((lane + 1) & 15);
        const bool f0 = fr == 0, f15 = fr == 15;
#pragma unroll
        for (int ai = 0; ai < 2; ++ai) {
            const int g = 2 * ai + wr;
            const int gp = g - 1, gn = g + 1;
            unsigned pk[4][4];
#pragma unroll
            for (int n = 0; n < 2; ++n)
#pragma unroll
                for (int ep = 0; ep < 2; ++ep) {
                    float cv[2][2][4];
#pragma unroll
                    for (int bj = 0; bj < 2; ++bj) {
                        const int c = bj * DFF + jc + 4 * n + 2 * ep;
                        const f32x2v w0 = *(const f32x2v*)(cw + c), w1 = *(const f32x2v*)(cw + NUP + c), w2 = *(const f32x2v*)(cw + 2 * NUP + c), bb = *(const f32x2v*)(cb + c);
                        f32x2v bprev = {0.f, 0.f}, bnext = {0.f, 0.f};
                        if (gp >= 0) bprev = *(const PG8_LAS f32x2v*)(EX + (((((gp & 1) * 4 + wc) * 2 + (gp >> 1)) * 2 + 1) * 64 + bj * 32 + 8 * fq + 4 * n + 2 * ep));
                        if (gn <= 3) bnext = *(const PG8_LAS f32x2v*)(EX + (((((gn & 1) * 4 + wc) * 2 + (gn >> 1)) * 2 + 0) * 64 + bj * 32 + 8 * fq + 4 * n + 2 * ep));
#pragma unroll
                        for (int e2 = 0; e2 < 2; ++e2) {
                            const int e = 2 * ep + e2;
                            float r[4], l[4];
#pragma unroll
                            for (int m = 0; m < 4; ++m) { r[m] = __shfl(acc[ai][bj][m][n][e], srcR); l[m] = __shfl(acc[ai][bj][m][n][e], srcL); }
#pragma unroll
                            for (int m = 0; m < 4; ++m) {
                                const float pv = f0 ? (m > 0 ? r[m > 0 ? m - 1 : 0] : bprev[e2]) : r[m];
                                const float nx = f15 ? (m < 3 ? l[m < 3 ? m + 1 : 3] : bnext[e2]) : l[m];
                                cv[bj][e2][m] = w0[e2] * pv + w1[e2] * acc[ai][bj][m][n][e] + w2[e2] * nx + bb[e2];
                            }
                        }
                    }
#pragma unroll
                    for (int m = 0; m < 4; ++m) pk[m][n * 2 + ep] = cvt_pk_bf16(silu1(cv[1][0][m]) * cv[0][0][m], silu1(cv[1][1][m]) * cv[0][1][m]);
                    __builtin_amdgcn_sched_barrier(0);
                }
#pragma unroll
            for (int m = 0; m < 4; ++m) {
                const size_t row = (size_t)u.pm * BM + ai * HALF + wr * 64 + m * 16 + fr;
                u32x4 w; w.x = pk[m][0]; w.y = pk[m][1]; w.z = pk[m][2]; w.w = pk[m][3];
                *(u32x4*)(ACT + row * DFF + jc) = w;
            }
            __builtin_amdgcn_sched_barrier(0);
        }
    }
};
}

__device__ __forceinline__ void transpose_item(const float* W, int N, int k0, int n0, bf16* WT, int ldt, int kcol0, int orow0, LAS float* scr, int lane) {
#pragma unroll 8
    for (int i = 0; i < 32; ++i) { const int kk = 2 * i + (lane >> 5); scr[kk * 33 + (lane & 31)] = W[(size_t)(k0 + kk) * N + n0 + (lane & 31)]; }
    LDS_WAIT(); asm volatile("" ::: "memory");
    const int c = lane & 7;
#pragma unroll
    for (int j = 0; j < 4; ++j) { const int n = (lane >> 3) + 8 * j; const LAS float* s = scr + (8 * c) * 33 + n;
        v4u o; o.x = pk2(s[0 * 33], s[1 * 33]); o.y = pk2(s[2 * 33], s[3 * 33]); o.z = pk2(s[4 * 33], s[5 * 33]); o.w = pk2(s[6 * 33], s[7 * 33]);
        *(GAS v4u*)(WT + (size_t)(orow0 + n) * ldt + kcol0 + k0 + 8 * c) = o; }
    LDS_WAIT(); asm volatile("" ::: "memory");
}
__device__ __forceinline__ void phase_prologue(const int wv) {
    const Ctx C = make_ctx(wv);
    {
        LAS float* S = (LAS float*)(C.lds);
        LAS float* red = (LAS float*)(C.lds + 40960);
        const float* cin = inp(C, 1); const float* cctx = inp(C, 3); const float* wmod = inp(C, 4); const float* bmod = inp(C, 5);
        for (int i = C.tid; i < 9 * 1024; i += 512) { const int r = i >> 10, k = i & 1023; const float v = (r < 8) ? cin[r * 1024 + k] : cctx[k]; S[i] = v / (1.f + expf(-v)); }
        __syncthreads();
        for (int it = blockIdx.x; it < NL * 192; it += C.G) {
            const int l = it / 192, col0 = (it % 192) * 32;
            const float* W = wmod + (size_t)l * 1024 * 6144 + col0 + (C.lane & 31);
            float acc[9];
#pragma unroll
            for (int r = 0; r < 9; ++r) acc[r] = 0.f;
            const int kb = C.wave * 128 + (C.lane >> 5);
#pragma unroll 4
            for (int i = 0; i < 64; ++i) { const int k = kb + 2 * i; const float w = W[(size_t)k * 6144];
#pragma unroll
                for (int r = 0; r < 9; ++r) acc[r] += S[r * 1024 + k] * w; }
#pragma unroll
            for (int r = 0; r < 9; ++r) acc[r] += __shfl_xor(acc[r], 32);
            if (C.lane < 32) {
#pragma unroll
                for (int r = 0; r < 9; ++r) red[(C.wave * 9 + r) * 32 + C.lane] = acc[r];
            }
            __syncthreads();
            if (C.tid < 288) { const int r = C.tid >> 5, cc = C.tid & 31; float s = 0.f;
#pragma unroll
                for (int w = 0; w < 8; ++w) s += red[(w * 9 + r) * 32 + cc];
                ((float*)(wsp(C) + WS_MODS))[(size_t)(l * 9 + r) * 6144 + col0 + cc] = s + bmod[l * 6144 + col0 + cc]; }
            __syncthreads();
        }
    }
    {
        LAS float* scr = (LAS float*)(C.lds + 49152 + C.wave * 9216);
        constexpr int I_IN = 16 * 77, I_OUT = 16 * 32, I_UP = 16 * 176, I_DN = 44 * 32, I_UQ = 4 * 12, I_UKV = 2 * 16, I_L = I_IN + I_OUT + I_UP + I_DN + I_UQ + I_UKV;
        for (int it = C.gw; it < NL * I_L; it += C.NGW) {
            const int l = it / I_L; int r = it % I_L;
            if (r < I_IN) { const int kb = r / 77, nb = r % 77, n0 = nb * 32; transpose_item(inp(C, 7) + (size_t)l * DM * NIN, NIN, kb * 64, n0, wptr(C, l, W_IN), DM, 0, n0 < 416 ? n0 : n0 + 96, scr, C.lane); continue; } r -= I_IN;
            if (r < I_OUT) { const int kb = r / 32, nb = r % 32; transpose_item(inp(C, 8) + (size_t)l * DM * DM, DM, kb * 64, nb * 32, wptr(C, l, W_OUT), DM, 0, nb * 32, scr, C.lane); continue; } r -= I_OUT;
            if (r < I_UP) { const int kb = r / 176, nb = r % 176, n0 = nb * 32, bj = n0 >= DFF ? 1 : 0, j0 = n0 - bj * DFF;
                transpose_item(inp(C, 28) + (size_t)l * DM * NUP, NUP, kb * 64, n0, wptr(C, l, W_UP), DM, 0, 256 * (j0 >> 7) + 128 * bj + (j0 & 127), scr, C.lane); continue; } r -= I_UP;
            if (r < I_DN) { const int kb = r / 32, nb = r % 32; transpose_item(inp(C, 31) + (size_t)l * DFF * DM, DM, kb * 64, nb * 32, wptr(C, l, W_DOWN), DFF, 0, nb * 32, scr, C.lane); continue; } r -= I_DN;
            if (r < I_UQ) { const int kb = r / 12, nb = r % 12; transpose_item(inp(C, 10) + (size_t)l * 256 * 384, 384, kb * 64, nb * 32, wptr(C, l, W_MLA), KMLA, 0, nb * 32, scr, C.lane); continue; } r -= I_UQ;
            { const int kb = r / 16, nb = r % 16; transpose_item(inp(C, 12) + (size_t)l * 128 * 512, 512, kb * 64, nb * 32, wptr(C, l, W_MLA), KMLA, 256, 512 + nb * 32, scr, C.lane); }
        }
        const int gt = C.gw * 64 + C.lane, NGT = C.NGW * 64;
        const v4u z = {0u, 0u, 0u, 0u};
        for (int i = gt; i < NL * 96 * 128; i += NGT) { const int l = i / (96 * 128), r = i % (96 * 128); *(GAS v4u*)(wptr(C, l, W_IN) + (size_t)(416 + r / 128) * DM + (r % 128) * 8) = z; }
        for (int i = gt; i < NL * 1024 * 48; i += NGT) { const int l = i / (1024 * 48), r = (i / 48) % 1024, k = (i % 48) * 8;
            const bool zero = (r < 384) ? (k >= 256) : (r < 512) ? true : (k < 256);
            if (zero) *(GAS v4u*)(wptr(C, l, W_MLA) + (size_t)r * KMLA + k) = z; }
        float* r32 = (float*)(wsp(C) + WS_ROPE32); float* r64 = (float*)(wsp(C) + WS_ROPE64);
        for (int i = gt; i < 2048 * 48; i += NGT) {
            const int pos = i / 48, e = i % 48; const float row = (float)(pos >> 6), col = (float)(pos & 63);
            if (e < 16) { const int f = e & 7; const float inv = powf(10000.f, -(float)f / 8.f); const float a = (e < 8 ? row : col) * inv; r32[(pos * 16 + e) * 2] = cosf(a); r32[(pos * 16 + e) * 2 + 1] = sinf(a); }
            else { const int e2 = e - 16, f = e2 & 15; const float inv = powf(10000.f, -(float)f / 16.f); const float a = (e2 < 16 ? row : col) * inv; r64[(pos * 32 + e2) * 2] = cosf(a); r64[(pos * 32 + e2) * 2 + 1] = sinf(a); }
        }
    }
}

__device__ __forceinline__ void phase_norm(const int wv, int l, int which, int nrows) {
    const Ctx C = make_ctx(wv);
    const bool first = (l == 0 && which == 1);
    const float* xl = first ? inp(C, 0) : outp(C); const float* xc = first ? inp(C, 2) : ((float*)(wsp(C) + WS_XC));
    const float* gv = (which == 1 ? inp(C, 6) : inp(C, 27)) + l * DM;
    f32x4 g4[4];
#pragma unroll
    for (int j = 0; j < 4; ++j) g4[j] = *(const f32x4*)(gv + 4 * C.lane + 256 * j);
    for (int R = C.gw; R < nrows; R += C.NGW) {
        const float* src = R < ML ? xl + (size_t)R * DM : xc + (size_t)(R - ML) * DM;
        const int bidx = R < ML ? (R >> 11) : 8;
        const float* md = ((float*)(wsp(C) + WS_MODS)) + (size_t)(l * 9 + bidx) * 6144 + (which == 1 ? 0 : 3072);
        f32x4 v[4]; float ss = 0.f;
#pragma unroll
        for (int j = 0; j < 4; ++j) { v[j] = *(const f32x4*)(src + 4 * C.lane + 256 * j); ss += (v[j][0] * v[j][0] + v[j][1] * v[j][1]) + (v[j][2] * v[j][2] + v[j][3] * v[j][3]); }
        const float rs = 1.f / sqrtf(wave_sum(ss) * (1.f / DM) + EPS);
#pragma unroll
        for (int j = 0; j < 4; ++j) {
            const f32x4 sh = *(const f32x4*)(md + 4 * C.lane + 256 * j), sc = *(const f32x4*)(md + 1024 + 4 * C.lane + 256 * j);
            const f32x4 y = (v[j] * rs) * g4[j] * (sc + 1.f) + sh;
            u32x2v w; w.x = pk2(y[0], y[1]); w.y = pk2(y[2], y[3]);
            *(u32x2v*)(((bf16*)(wsp(C) + WS_XN)) + (size_t)R * DM + 4 * C.lane + 256 * j) = w;
        }
    }
}

__device__ __forceinline__ void row_info(int R, int& b, int& qi, int& pos) {
    if (R < ML) { b = R >> 11; qi = R & 2047; pos = qi; } else { const int r = R - ML; b = r >> 8; qi = 2048 + (r & 255); pos = -1; }
}
__device__ __forceinline__ float red_xor(float v, int maxo) { for (int o = 1; o <= maxo; o <<= 1) v += __shfl_xor(v, o); return v; }

__device__ __forceinline__ void phase_prep1(const int wv, int l) {
    const Ctx C = make_ctx(wv);
    LAS unsigned short* st = (LAS unsigned short*)(C.lds + C.wave * 8192);
    bf16* Q = ((bf16*)(wsp(C) + WS_QKV));
    const float* rope32 = (const float*)(wsp(C) + WS_ROPE32); const float* rope64 = (const float*)(wsp(C) + WS_ROPE64);
    const float C32 = 0.17677669529663687f * LOG2E, C64 = 0.125f * LOG2E;
    for (int R = C.gw; R < MT; R += C.NGW) {
        int b, qi, pos; row_info(R, b, qi, pos);
        {   const GAS v4u* src = (const GAS v4u*)(((bf16*)(wsp(C) + WS_P)) + (size_t)R * NINP);
#pragma unroll
            for (int i = 0; i < 5; ++i) ((LAS v4u*)st)[C.lane + 64 * i] = src[C.lane + 64 * i];
            LDS_WAIT(); asm volatile("" ::: "memory"); }
        const int lane = C.lane;
        float v[4];
        {   float ss = 0.f;
#pragma unroll
            for (int e = 0; e < 4; ++e) { v[e] = bf2f(st[PC_CQ + 4 * lane + e]); ss += v[e] * v[e]; }
            const float rs = 1.f / sqrtf(wave_sum(ss) * (1.f / 256.f) + EPS); const float* g = inp(C, 9) + l * 256 + 4 * lane;
            u32x2v w; w.x = pk2(v[0] * rs * g[0], v[1] * rs * g[1]); w.y = pk2(v[2] * rs * g[2], v[3] * rs * g[3]);
            *(u32x2v*)(((bf16*)(wsp(C) + WS_CQKV)) + (size_t)R * KMLA + 4 * lane) = w; }
        {   float ss = 0.f;
#pragma unroll
            for (int e = 0; e < 2; ++e) { v[e] = bf2f(st[PC_CKV + 2 * lane + e]); ss += v[e] * v[e]; }
            const float rs = 1.f / sqrtf(wave_sum(ss) * (1.f / 128.f) + EPS); const float* g = inp(C, 11) + l * 128 + 2 * lane;
            *(unsigned*)(((bf16*)(wsp(C) + WS_CQKV)) + (size_t)R * KMLA + 256 + 2 * lane) = pk2(v[0] * rs * g[0], v[1] * rs * g[1]); }
#pragma unroll
        for (int qk = 0; qk < 2; ++qk) {
            float ss = 0.f;
#pragma unroll
            for (int e = 0; e < 4; ++e) { v[e] = bf2f(st[(qk ? PC_DK : PC_DQ) + 4 * lane + e]); ss += v[e] * v[e]; }
            ss = red_xor(ss, 4);
            const float rs = 1.f / sqrtf(ss * (1.f / 32.f) + EPS);
            const int gi = lane >> 3, lg = lane & 7, d0 = 4 * lg; const float* g = inp(C, qk ? 16 : 15) + l * 32 + d0;
            float y[4];
#pragma unroll
            for (int e = 0; e < 4; ++e) y[e] = v[e] * rs * g[e];
#pragma unroll
            for (int e = 0; e < 4; ++e) { const float pr = __shfl_xor(y[e], 2);
                if (pos >= 0) { const int ti = ((lg & 4) ? 8 : 0) + 4 * (lg & 1) + e; const float cs = rope32[(pos * 16 + ti) * 2], sn = rope32[(pos * 16 + ti) * 2 + 1];
                    v[e] = (lg & 2) ? y[e] * cs + pr * sn : y[e] * cs - pr * sn; } else v[e] = y[e]; }
            if (qk == 0) { u32x2v w; w.x = pk2(v[0] * C32, v[1] * C32); w.y = pk2(v[2] * C32, v[3] * C32); *(u32x2v*)(Q + E_QD + q_off(8, 32, b, gi, qi) + d0) = w; }
            else { u32x2v w; w.x = pk2(v[0], v[1]); w.y = pk2(v[2], v[3]); *(u32x2v*)(Q + E_KD + k_off(8, 32, b, gi, qi, d0)) = w; }
        }
#pragma unroll
        for (int t = 0; t < 2; ++t) {
            const int h = lane >> 4, dv0 = 4 * (lane & 15);
#pragma unroll
            for (int e = 0; e < 4; ++e) (Q + (t ? E_VN : E_VD))[v_off(4, b, h, qi, dv0 + e)] = st[(t ? PC_NV : PC_DV) + 4 * lane + e];
        }
#pragma unroll
        for (int qk = 0; qk < 2; ++qk) {
            float ss = 0.f;
#pragma unroll
            for (int e = 0; e < 4; ++e) { v[e] = bf2f(st[(qk ? PC_NK : PC_NQ) + 4 * lane + e]); ss += v[e] * v[e]; }
            ss = red_xor(ss, 8);
            const float rs = 1.f / sqrtf(ss * (1.f / 64.f) + EPS);
            const int h = lane >> 4, d0 = 4 * (lane & 15); const float* g = inp(C, qk ? 23 : 22) + l * 64 + d0;
#pragma unroll
            for (int e = 0; e < 4; ++e) v[e] = v[e] * rs * g[e];
            if (qk == 0) { u32x2v w; w.x = pk2(v[0] * C64, v[1] * C64); w.y = pk2(v[2] * C64, v[3] * C64); *(u32x2v*)(Q + E_QN + q_off(4, 64, b, h, qi) + d0) = w; }
            else { u32x2v w; w.x = pk2(v[0], v[1]); w.y = pk2(v[2], v[3]); *(u32x2v*)(Q + E_KN + k_off(4, 64, b, h, qi, d0)) = w; }
        }
        {   float ss = 0.f;
#pragma unroll
            for (int e = 0; e < 4; ++e) { v[e] = bf2f(st[PC_GQ + 4 * lane + e]); ss += v[e] * v[e]; }
            ss = red_xor(ss, 8);
            const float rs = 1.f / sqrtf(ss * (1.f / 64.f) + EPS);
            const int h = lane >> 4, lh = lane & 15, d0 = 4 * lh; const float* g = inp(C, 25) + l * 64 + d0;
            float y[4];
#pragma unroll
            for (int e = 0; e < 4; ++e) y[e] = v[e] * rs * g[e];
#pragma unroll
            for (int e = 0; e < 4; ++e) { const float pr = __shfl_xor(y[e], 4);
                if (pos >= 0) { const int ti = ((lh & 8) ? 16 : 0) + 4 * (lh & 3) + e; const float cs = rope64[(pos * 32 + ti) * 2], sn = rope64[(pos * 32 + ti) * 2 + 1];
                    v[e] = (lh & 4) ? y[e] * cs + pr * sn : y[e] * cs - pr * sn; } else v[e] = y[e]; }
            u32x2v w; w.x = pk2(v[0] * C64, v[1] * C64); w.y = pk2(v[2] * C64, v[3] * C64); *(u32x2v*)(Q + E_QG + q_off(4, 64, b, h, qi) + d0) = w; }
        {   float ss = 0.f;
#pragma unroll
            for (int e = 0; e < 2; ++e) { v[e] = bf2f(st[PC_GK + 2 * lane + e]); ss += v[e] * v[e]; }
            ss = red_xor(ss, 16);
            const float rs = 1.f / sqrtf(ss * (1.f / 64.f) + EPS);
            const int h = lane >> 5, ll = lane & 31, d0 = 2 * ll; const float* g = inp(C, 26) + l * 64 + d0;
            float y[2];
#pragma unroll
            for (int e = 0; e < 2; ++e) y[e] = v[e] * rs * g[e];
#pragma unroll
            for (int e = 0; e < 2; ++e) { const float pr = __shfl_xor(y[e], 8);
                if (pos >= 0) { const int ti = ((ll & 16) ? 16 : 0) + 2 * (ll & 7) + e; const float cs = rope64[(pos * 32 + ti) * 2], sn = rope64[(pos * 32 + ti) * 2 + 1];
                    v[e] = (ll & 8) ? y[e] * cs + pr * sn : y[e] * cs - pr * sn; } else v[e] = y[e]; }
            *(unsigned*)(Q + E_KG + k_off(2, 64, b, h, qi, d0)) = pk2(v[0], v[1]); }
        {   const int h = lane >> 5, dv0 = 2 * (lane & 31);
#pragma unroll
            for (int e = 0; e < 2; ++e) (Q + E_VG)[v_off(2, b, h, qi, dv0 + e)] = st[PC_GV + 2 * lane + e]; }
        LDS_WAIT(); asm volatile("" ::: "memory");
    }
}

__device__ __forceinline__ void phase_prep2(const int wv, int l) {
    const Ctx C = make_ctx(wv);
    LAS unsigned short* st = (LAS unsigned short*)(C.lds + C.wave * 8192);
    bf16* Q = ((bf16*)(wsp(C) + WS_QKV));
    const float* rope32 = (const float*)(wsp(C) + WS_ROPE32);
    const float C96 = 0.10206207261596575f * LOG2E;
    for (int R = C.gw; R < MT; R += C.NGW) {
        int b, qi, pos; row_info(R, b, qi, pos);
        {   const GAS v4u* src = (const GAS v4u*)(((bf16*)(wsp(C) + WS_MLAP)) + (size_t)R * NMLA);
            ((LAS v4u*)st)[C.lane] = src[C.lane]; ((LAS v4u*)st)[C.lane + 64] = src[C.lane + 64];
            if (C.lane < 4) ((LAS v4u*)st)[128 + C.lane] = ((const GAS v4u*)(((bf16*)(wsp(C) + WS_P)) + (size_t)R * NINP + PC_KR))[C.lane];
            LDS_WAIT(); asm volatile("" ::: "memory"); }
        const int lane = C.lane, h = lane >> 4, li = lane & 15;
#pragma unroll
        for (int qk = 0; qk < 2; ++qk) {
            float v[6]; float ss = 0.f;
#pragma unroll
            for (int e = 0; e < 6; ++e) { v[e] = qk == 0 ? bf2f(st[h * 96 + li + 16 * e]) : (e < 4 ? bf2f(st[512 + h * 128 + li + 16 * e]) : bf2f(st[1024 + li + 16 * (e - 4)])); ss += v[e] * v[e]; }
            ss = red_xor(ss, 8);
            const float rs = 1.f / sqrtf(ss * (1.f / 96.f) + EPS); const float* g = inp(C, qk ? 14 : 13) + l * 96 + li;
#pragma unroll
            for (int e = 0; e < 6; ++e) v[e] = v[e] * rs * g[16 * e];
#pragma unroll
            for (int e = 4; e < 6; ++e) { const float pr = __shfl_xor(v[e], 8);
                if (pos >= 0) { const int ti = (e == 5 ? 8 : 0) + (li & 7); const float cs = rope32[(pos * 16 + ti) * 2], sn = rope32[(pos * 16 + ti) * 2 + 1];
                    v[e] = (li & 8) ? v[e] * cs + pr * sn : v[e] * cs - pr * sn; } }
            if (qk == 0) {
#pragma unroll
                for (int e = 0; e < 6; ++e) (Q + E_QA)[q_off(4, 96, b, h, qi) + li + 16 * e] = (bf16)f2bf(v[e] * C96);
            } else {
#pragma unroll
                for (int e = 0; e < 6; ++e) (Q + E_KA)[k_off(4, 96, b, h, qi, li + 16 * e)] = (bf16)f2bf(v[e]);
            }
        }
#pragma unroll
        for (int e = 0; e < 4; ++e) (Q + E_VA)[v_off(4, b, h, qi, li + 16 * e)] = st[512 + h * 128 + 64 + li + 16 * e];
        LDS_WAIT(); asm volatile("" ::: "memory");
    }
}

template <int DK, int HQ, int HK, int HV, bool NA>
__device__ __forceinline__ void naive_attn_one(const bf16* Qb, const bf16* Kb, const bf16* Vb, const float* rpb, int b, int hq, int hk, int hv, int qi, float (&o)[64]) {
    float q[DK];
    { const bf16* qp = Qb + q_off(HQ, DK, b, hq, qi);
#pragma unroll
      for (int c = 0; c < DK / 8; ++c) { const v4u w = *(const v4u*)(qp + 8 * c); q[8 * c] = bflo(w.x); q[8 * c + 1] = bfhi(w.x); q[8 * c + 2] = bflo(w.y); q[8 * c + 3] = bfhi(w.y); q[8 * c + 4] = bflo(w.z); q[8 * c + 5] = bfhi(w.z); q[8 * c + 6] = bflo(w.w); q[8 * c + 7] = bfhi(w.w); } }
    float m = -1e30f, ls = 0.f;
#pragma unroll
    for (int d = 0; d < 64; ++d) o[d] = 0.f;
    const bool isctx = qi >= SEQ;
    const int r = qi >> 6, qc = qi & 63;
    const int rs0 = min(max(r - 4, 0), 24), ws0 = min(max(qc - 8, 0), 48);
    const int nloc = isctx ? 0 : (NA ? 128 : SEQ);
    const int ntot = nloc + CTXL;
    for (int it = 0; it < ntot; ++it) {
        int key; float bias = 0.f;
        if (it < nloc) {
            if (NA) { const int kr = rs0 + (it >> 4), kc = ws0 + (it & 15); key = kr * 64 + kc; bias = rpb[(kr - r + 7) * 31 + min(max(kc - qc + 15, 0), 30)] * LOG2E; }
            else key = it;
        } else key = SEQ + (it - nloc);
        float s = bias;
#pragma unroll
        for (int c = 0; c < DK / 8; ++c) { const v4u w = *(const v4u*)(Kb + k_off(HK, DK, b, hk, key, 8 * c));
            s += q[8 * c] * bflo(w.x) + q[8 * c + 1] * bfhi(w.x) + q[8 * c + 2] * bflo(w.y) + q[8 * c + 3] * bfhi(w.y) + q[8 * c + 4] * bflo(w.z) + q[8 * c + 5] * bfhi(w.z) + q[8 * c + 6] * bflo(w.w) + q[8 * c + 7] * bfhi(w.w); }
        if (s > m) { const float a = exp2f(m - s); ls *= a;
#pragma unroll
            for (int d = 0; d < 64; ++d) o[d] *= a;
            m = s; }
        const float p = exp2f(s - m); ls += p;
        const bf16* vp = Vb + v_off(HV, b, hv, key, 0);
#pragma unroll
        for (int d = 0; d < 64; ++d) { o[d] += p * bf2f(vp[8 * d]); if ((d & 15) == 15) asm volatile("" ::: "memory"); }
    }
    const float inv = 1.f / ls;
#pragma unroll
    for (int d = 0; d < 64; ++d) o[d] *= inv;
}
__device__ __forceinline__ void store_mix(const Ctx& C, int b, int qi, int col0, const float (&o)[64]) {
    const size_t R = qi < SEQ ? (size_t)b * SEQ + qi : (size_t)ML + b * CTXL + (qi - SEQ);
    bf16* dst = ((bf16*)(wsp(C) + WS_MIX)) + R * DM + col0;
#pragma unroll
    for (int d = 0; d < 64; d += 8) { v4u w; w.x = pk2(o[d], o[d + 1]); w.y = pk2(o[d + 2], o[d + 3]); w.z = pk2(o[d + 4], o[d + 5]); w.w = pk2(o[d + 6], o[d + 7]); *(v4u*)(dst + d) = w; }
}
__device__ __forceinline__ void phase_attn_naive(const int wv, int l) {
    const Ctx C = make_ctx(wv);
    const bf16* Q = ((bf16*)(wsp(C) + WS_QKV));
    const int gt = C.gw * 64 + C.lane, NGT = C.NGW * 64;
    constexpr int PER = NB * 4 * NKEY;
    for (int idx = gt; idx < 5 * PER; idx += NGT) {
        const int mixer = idx < 3 * PER ? idx / PER : 3;
        const int r0 = mixer < 3 ? idx % PER : (idx - 3 * PER) >> 1, pair = idx & 1;
        const int b = r0 / (4 * NKEY), h = (r0 / NKEY) % 4, qi = r0 % NKEY;
        if (l == NL - 1 && qi >= SEQ) continue;
        float o[64];
        if (mixer == 0) { naive_attn_one<96, 4, 4, 4, false>(Q + E_QA, Q + E_KA, Q + E_VA, nullptr, b, h, h, h, qi, o); store_mix(C, b, qi, h * 64, o); }
        else if (mixer == 1) { naive_attn_one<64, 4, 4, 4, true>(Q + E_QN, Q + E_KN, Q + E_VN, inp(C, 24) + (size_t)(l * 4 + h) * 15 * 31, b, h, h, h, qi, o); store_mix(C, b, qi, 512 + h * 64, o); }
        else if (mixer == 2) { naive_attn_one<64, 4, 2, 2, false>(Q + E_QG, Q + E_KG, Q + E_VG, nullptr, b, h, h >> 1, h >> 1, qi, o); store_mix(C, b, qi, 768 + h * 64, o); }
        else {
            naive_attn_one<32, 8, 8, 4, false>(Q + E_QD, Q + E_KD, Q + E_VD, nullptr, b, 2 * h + pair, 2 * h + pair, h, qi, o);
            float s1 = 0.f, s2 = 0.f;
            for (int d = 0; d < 32; ++d) { s1 += inp(C, 17)[l * 32 + d] * inp(C, 18)[l * 32 + d]; s2 += inp(C, 19)[l * 32 + d] * inp(C, 20)[l * 32 + d]; }
            const float li = lambda_init(l), lam = expf(s1) - expf(s2) + li;
            float ss = 0.f;
#pragma unroll
            for (int d = 0; d < 64; ++d) { const float other = __shfl_xor(o[d], 1); o[d] = o[d] - lam * other; ss += o[d] * o[d]; }
            const float rs = 1.f / sqrtf(ss * (1.f / 64.f) + EPS);
#pragma unroll
            for (int d = 0; d < 64; ++d) o[d] = o[d] * rs * inp(C, 21)[l * 64 + d] * (1.f - li);
            if (pair == 0) store_mix(C, b, qi, 256 + h * 64, o);
        }
    }
}

__device__ __forceinline__ void phase_fixup(const int wv, int l) {
    const Ctx C = make_ctx(wv);
    const int gt = C.gw * 64 + C.lane, NGT = C.NGW * 64;
    const float* cw = inp(C, 29) + (size_t)l * 3 * NUP; const float* cb = inp(C, 30) + (size_t)l * NUP;
    for (int idx = gt; idx < 56 * 2 * DFF; idx += NGT) {
        const int j = idx % DFF, w = (idx / DFF) & 1, bi = idx / (2 * DFF), pm = (bi / 7) * 8 + (bi % 7);
        const float* h0 = ((float*)(wsp(C) + WS_HALO)) + (size_t)pm * 4 * NUP; const float* h1 = h0 + 4 * NUP;
        float cva[2];
#pragma unroll
        for (int t = 0; t < 2; ++t) { const int c = t * DFF + j;
            const float up = w == 0 ? h0[2 * NUP + c] : h0[3 * NUP + c], uc = w == 0 ? h0[3 * NUP + c] : h1[c], un = w == 0 ? h1[c] : h1[NUP + c];
            cva[t] = cw[c] * up + cw[NUP + c] * uc + cw[2 * NUP + c] * un + cb[c]; }
        const size_t row = (size_t)pm * 256 + 255 + w;
        ((bf16*)(wsp(C) + WS_ACT))[row * DFF + j] = (bf16)f2bf(pg8::silu1(cva[1]) * cva[0]);
    }
}

namespace att {
typedef float f32x16 __attribute__((ext_vector_type(16)));
typedef __bf16 bf16x2_t __attribute__((ext_vector_type(2)));
__device__ __forceinline__ unsigned cvtpk(float lo, float hi) { f32x2v v = {lo, hi}; bf16x2_t b = __builtin_convertvector(v, bf16x2_t); return __builtin_bit_cast(unsigned, b); }
__device__ __forceinline__ int crow(int r, int hi) { return (r & 3) + 8 * (r >> 2) + 4 * hi; }
constexpr int BUF0 = 0, BUFSZ = 20480, WSC = 2 * BUFSZ  , WSCSZ = 4224, RPB = WSC + 8 * WSCSZ  , RPB_TAB = RPB + 512;
static_assert(RPB_TAB + 15 * 31 * 4 + 1024 <= RING_BYTES, "attention LDS map");

struct UnitDesc { int b, hq0, hk0, hv, q0, t_lo, n_loc, col0; };

template <int DK, int NP, bool NA>
__device__ __forceinline__ void attn_unit(const Ctx& C, const bf16* Qb, int HQ, const bf16* Kb, int HK, const bf16* Vb, int HV, const UnitDesc U, const float Mb,
                                          const float* rpb  , const float lam, const float* subg, const float osc, bf16* MIX) {
    constexpr int KS = DK / 16;
    constexpr int KP = NP * DK * 8;
    constexpr int NLD = (KP + 512 + 511) / 512;
    const int lane = C.lane, wave = C.wave, tid = C.tid, c31 = lane & 31, hi = lane >> 5;
    LAS unsigned char* L = C.lds;
    const int n_it = U.n_loc + 4;
    bf16x8 qf[NP][KS];
    const int qrow = U.q0 + wave * 32 + c31;
#pragma unroll
    for (int p = 0; p < NP; ++p) { const bf16* qp = Qb + q_off(HQ, DK, U.b, U.hq0 + p, qrow) + 8 * hi;
#pragma unroll
        for (int ks = 0; ks < KS; ++ks) qf[p][ks] = *(const bf16x8*)(qp + 16 * ks); }
    int my_lo = 0, my_r = 0;
    if (NA) {
        for (int i = tid; i < 15 * 31; i += 512) ((LAS float*)(L + RPB_TAB))[i] = rpb[i] * LOG2E;
        my_r = (U.q0 >> 6) + (wave >> 1); my_lo = min(max(my_r - 4, 0), 24);
    }
    f32x16 o[NP][2]; float lsum[NP];
#pragma unroll
    for (int p = 0; p < NP; ++p) { lsum[p] = 0.f;
#pragma unroll
        for (int d0 = 0; d0 < 2; ++d0)
#pragma unroll
            for (int r = 0; r < 16; ++r) o[p][d0][r] = 0.f; }
    const float shift = Mb > 40.f ? Mb - 40.f : 0.f;
    v4u stg[NLD];
    auto tile_of = [&](int it) { return it < U.n_loc ? U.t_lo + it : 32 + (it - U.n_loc); };
#define ATT_LOAD(tile) do { _Pragma("unroll") for (int i_ = 0; i_ < NLD; ++i_) { const int pi = tid + 512 * i_; \
        if (pi < KP + 512) { const bf16* src; \
            if (pi < KP) { const int ps = pi / (DK * 8), pr = pi % (DK * 8); src = Kb + ((size_t)((U.b * HK + U.hk0 + ps) * NKT + (tile))) * (DK * 64) + pr * 8; } \
            else src = Vb + ((size_t)((U.b * HV + U.hv) * NKT + (tile))) * 4096 + (pi - KP) * 8; \
            stg[i_] = *(const GAS v4u*)src; } } } while (0)
#define ATT_STORE(buf) do { _Pragma("unroll") for (int i_ = 0; i_ < NLD; ++i_) { const int pi = tid + 512 * i_; if (pi < KP + 512) *(LAS v4u*)(L + (buf) * BUFSZ + pi * 16) = stg[i_]; } } while (0)
    ATT_LOAD(tile_of(0)); ATT_STORE(0);
    __syncthreads();
    for (int it = 0; it < n_it; ++it) {
        const int tile = tile_of(it);
        if (it + 1 < n_it) ATT_LOAD(tile_of(it + 1));
        const bool local = NA && it < U.n_loc;
        const bool active = !local || (tile >= my_lo && tile < my_lo + 8);
        if (active) {
            const LAS unsigned char* kb = L + (it & 1) * BUFSZ;
            const LAS unsigned char* vb = kb + KP * 16;
#pragma unroll
            for (int p = 0; p < NP; ++p) {
                f32x16 p0, p1;
#pragma unroll
                for (int r = 0; r < 16; ++r) { p0[r] = 0.f; p1[r] = 0.f; }
#pragma unroll
                for (int ks = 0; ks < KS; ++ks) {
                    const bf16x8 k0 = *(const LAS bf16x8*)(kb + p * (DK * 128) + (2 * ks + hi) * 1024 + c31 * 16);
                    const bf16x8 k1 = *(const LAS bf16x8*)(kb + p * (DK * 128) + (2 * ks + hi) * 1024 + 512 + c31 * 16);
                    p0 = __builtin_amdgcn_mfma_f32_32x32x16_bf16(k0, qf[p][ks], p0, 0, 0, 0);
                    p1 = __builtin_amdgcn_mfma_f32_32x32x16_bf16(k1, qf[p][ks], p1, 0, 0, 0);
                }
                __builtin_amdgcn_sched_barrier(0);
                if (shift > 0.f) {
#pragma unroll
                    for (int r = 0; r < 16; ++r) { p0[r] -= shift; p1[r] -= shift; }
                }
                if (local) {
                    const int qc = (wave & 1) * 32 + c31, ws = min(max(qc - 8, 0), 48);
                    const LAS float* bt = (const LAS float*)(L + RPB_TAB) + (tile - my_r + 7) * 31 + 15 - qc + 4 * hi;
                    const int kb0 = 4 * hi - ws;
#pragma unroll
                    for (int r = 0; r < 16; ++r) { const int kc = (r & 3) + 8 * (r >> 2);
                        const float b0 = bt[kc], b1 = bt[kc + 32];
                        p0[r] = ((unsigned)(kc + kb0) < 16u) ? __builtin_amdgcn_exp2f(p0[r] + b0) : 0.f;
                        p1[r] = ((unsigned)(kc + 32 + kb0) < 16u) ? __builtin_amdgcn_exp2f(p1[r] + b1) : 0.f; }
                } else {
#pragma unroll
                    for (int r = 0; r < 16; ++r) { p0[r] = __builtin_amdgcn_exp2f(p0[r]); p1[r] = __builtin_amdgcn_exp2f(p1[r]); }
                }
                float sa = 0.f, sb = 0.f;
#pragma unroll
                for (int r = 0; r < 16; ++r) { sa += p0[r]; sb += p1[r]; }
                lsum[p] += sa + sb;
                v4u pa[4];
                pa[0].x = cvtpk(p0[0], p0[1]); pa[0].y = cvtpk(p0[2], p0[3]); pa[0].z = cvtpk(p0[4], p0[5]); pa[0].w = cvtpk(p0[6], p0[7]);
                pa[1].x = cvtpk(p0[8], p0[9]); pa[1].y = cvtpk(p0[10], p0[11]); pa[1].z = cvtpk(p0[12], p0[13]); pa[1].w = cvtpk(p0[14], p0[15]);
                pa[2].x = cvtpk(p1[0], p1[1]); pa[2].y = cvtpk(p1[2], p1[3]); pa[2].z = cvtpk(p1[4], p1[5]); pa[2].w = cvtpk(p1[6], p1[7]);
                pa[3].x = cvtpk(p1[8], p1[9]); pa[3].y = cvtpk(p1[10], p1[11]); pa[3].z = cvtpk(p1[12], p1[13]); pa[3].w = cvtpk(p1[14], p1[15]);
                __builtin_amdgcn_sched_barrier(0);
#pragma unroll
                for (int s = 0; s < 4; ++s)
#pragma unroll
                    for (int d0 = 0; d0 < 2; ++d0) {
                        const bf16x8 vf = *(const LAS bf16x8*)(vb + ((2 * s + hi) * 64 + 32 * d0 + c31) * 16);
                        o[p][d0] = __builtin_amdgcn_mfma_f32_32x32x16_bf16(__builtin_bit_cast(bf16x8, pa[s]), vf, o[p][d0], 0, 0, 0);
                    }
                __builtin_amdgcn_sched_barrier(0);
            }
        }
        if (it + 1 < n_it) ATT_STORE((it + 1) & 1);
        __syncthreads();
    }
#undef ATT_LOAD
#undef ATT_STORE
    LAS float* lsc = (LAS float*)(L + WSC + wave * WSCSZ);
    LAS unsigned short* ost = (LAS unsigned short*)(L + WSC + wave * WSCSZ + 128);
#pragma unroll
    for (int p = 0; p < NP; ++p) {
        const float lt = lsum[p] + __shfl_xor(lsum[p], 32);
        if (lane < 32) lsc[lane] = 1.f / lt;
        LDS_WAIT(); asm volatile("" ::: "memory");
#pragma unroll
        for (int r = 0; r < 16; ++r) { const float iv = lsc[crow(r, hi)]; o[p][0][r] *= iv; o[p][1][r] *= iv; }
        LDS_WAIT(); asm volatile("" ::: "memory");
        __builtin_amdgcn_sched_barrier(0);
    }
    f32x16 (&res)[2] = o[0];
    if (NP == 2) {
        const float g0 = subg[c31] * osc, g1 = subg[32 + c31] * osc;
#pragma unroll
        for (int r = 0; r < 16; ++r) { res[0][r] -= lam * o[NP - 1][0][r]; res[1][r] -= lam * o[NP - 1][1][r];
            float ss = res[0][r] * res[0][r] + res[1][r] * res[1][r];
            ss += __shfl_xor(ss, 1); ss += __shfl_xor(ss, 2); ss += __shfl_xor(ss, 4); ss += __shfl_xor(ss, 8); ss += __shfl_xor(ss, 16);
            const float rs = 1.f / sqrtf(ss * (1.f / 64.f) + EPS); res[0][r] *= rs * g0; res[1][r] *= rs * g1; }
    }
#pragma unroll
    for (int r = 0; r < 16; ++r)
#pragma unroll
        for (int d0 = 0; d0 < 2; ++d0) ost[crow(r, hi) * 64 + d0 * 32 + c31] = (unsigned short)f2bf(res[d0][r]);
    LDS_WAIT(); asm volatile("" ::: "memory");
    {
        const int qw = U.q0 + wave * 32;
        const size_t R0 = qw < SEQ ? (size_t)U.b * SEQ + qw : (size_t)ML + U.b * CTXL + (qw - SEQ);
#pragma unroll
        for (int i = 0; i < 4; ++i) { const int row = i * 8 + (lane >> 3), ch = lane & 7;
            const v4u v = *(const LAS v4u*)(ost + row * 64 + ch * 8);
            *(GAS v4u*)(MIX + (R0 + row) * DM + U.col0 + ch * 8) = v; }
    }
    LDS_WAIT(); asm volatile("" ::: "memory");
    __syncthreads();
}
}

__device__ __forceinline__ float maxabs_n(const float* g, int n, int lane) { float m = 0.f; for (int i = lane; i < n; i += 64) m = fmaxf(m, fabsf(g[i]));
    for (int o = 1; o < 64; o <<= 1) m = fmaxf(m, __shfl_xor(m, o)); return m; }

template <int TY>
__device__ __forceinline__ void phase_attn_ty(const int wv, int l) {
    const Ctx C = make_ctx(wv);
    const bf16* Q = ((const bf16*)(wsp(C) + WS_QKV)); bf16* MIX = (bf16*)(wsp(C) + WS_MIX);
    const int NUT = (l == NL - 1) ? 256 : 384;
    const int vcu = C.gw >> 3;
    float Mb, lam = 0.f, osc = 1.f; const float* subg = nullptr;
    if (TY == 0) { Mb = LOG2E * 5.656854249492381f * maxabs_n(inp(C, 15) + l * 32, 32, C.lane) * maxabs_n(inp(C, 16) + l * 32, 32, C.lane);
        float s1 = 0.f, s2 = 0.f;
        for (int d = 0; d < 32; ++d) { s1 += inp(C, 17)[l * 32 + d] * inp(C, 18)[l * 32 + d]; s2 += inp(C, 19)[l * 32 + d] * inp(C, 20)[l * 32 + d]; }
        const float li = lambda_init(l); lam = expf(s1) - expf(s2) + li; osc = 1.f - li; subg = inp(C, 21) + l * 64; }
    else if (TY == 1) Mb = LOG2E * 9.797958971132712f * maxabs_n(inp(C, 13) + l * 96, 96, C.lane) * maxabs_n(inp(C, 14) + l * 96, 96, C.lane);
    else if (TY == 2) Mb = LOG2E * 8.f * maxabs_n(inp(C, 25) + l * 64, 64, C.lane) * maxabs_n(inp(C, 26) + l * 64, 64, C.lane);
    else Mb = LOG2E * 8.f * maxabs_n(inp(C, 22) + l * 64, 64, C.lane) * maxabs_n(inp(C, 23) + l * 64, 64, C.lane) + LOG2E * maxabs_n(inp(C, 24) + (size_t)l * 4 * 15 * 31, 4 * 15 * 31, C.lane);
    for (int uu = vcu; uu < NUT; uu += C.G) {
        att::UnitDesc U; int h;
        if (uu < 256) { h = (uu >> 3) & 3; U.b = uu >> 5; U.q0 = (uu & 7) * 256; U.t_lo = 0; U.n_loc = 32; }
        else { const int i_ = uu - 256; if ((i_ >> 5) != TY) continue; h = i_ & 3; U.b = (i_ >> 2) & 7; U.q0 = SEQ; U.t_lo = 32; U.n_loc = 0; }
        if (TY == 0) { U.hq0 = 2 * h; U.hk0 = 2 * h; U.hv = h; U.col0 = 256 + 64 * h; att::attn_unit<32, 2, false>(C, Q + E_QD, 8, Q + E_KD, 8, Q + E_VD, 4, U, Mb, nullptr, lam, subg, osc, MIX); }
        else if (TY == 1) { U.hq0 = h; U.hk0 = h; U.hv = h; U.col0 = 64 * h; att::attn_unit<96, 1, false>(C, Q + E_QA, 4, Q + E_KA, 4, Q + E_VA, 4, U, Mb, nullptr, 0.f, nullptr, 1.f, MIX); }
        else if (TY == 2) { U.hq0 = h; U.hk0 = h >> 1; U.hv = h >> 1; U.col0 = 768 + 64 * h; att::attn_unit<64, 1, false>(C, Q + E_QG, 4, Q + E_KG, 2, Q + E_VG, 2, U, Mb, nullptr, 0.f, nullptr, 1.f, MIX); }
        else { if (uu < 256) { const int r0 = U.q0 >> 6; U.t_lo = min(max(r0 - 4, 0), 24); U.n_loc = min(max(r0 - 1, 0), 24) + 8 - U.t_lo; }
            U.hq0 = h; U.hk0 = h; U.hv = h; U.col0 = 512 + 64 * h; att::attn_unit<64, 1, true>(C, Q + E_QN, 4, Q + E_KN, 4, Q + E_VN, 4, U, Mb, inp(C, 24) + (size_t)(l * 4 + h) * 15 * 31, 0.f, nullptr, 1.f, MIX); }
    }
}
__device__ __forceinline__ void phase_attn(const int wv, int l) { phase_attn_ty<0>(wv, l); phase_attn_ty<1>(wv, l); phase_attn_ty<2>(wv, l); phase_attn_ty<3>(wv, l); }

#ifndef ATTN_NAIVE
#define ATTN_NAIVE 0
#endif
#ifndef MK_PER_PHASE
#define MK_PER_PHASE 0
#endif
constexpr int PH_PRO = 0, PH_NORM0 = 1, PH_L0 = 2, PH_PER_LAYER = 11;
constexpr int N_PHASES = PH_L0 + NL * PH_PER_LAYER - 1;
struct Args { const float* in[32]; float* out; unsigned char* ws; int ph_lo, ph_hi; };

__global__ void __launch_bounds__(NWAVES * 64, 2) fwd_kernel(Args args) {
    const int wv = __builtin_amdgcn_readfirstlane((int)threadIdx.x >> 6);
    const Ctx C = make_ctx(wv);
    for (int u = C.tid; u < 1024 / 4; u += NWAVES * 64) ((LAS unsigned*)(C.lds + LDSCTL_OFF))[u] = 0u;
    __syncthreads();
    if (C.tid < 34) ((LAS unsigned long long*)(C.lds + PT_OFF))[C.tid] = ((const __attribute__((address_space(4))) unsigned long long*)__builtin_amdgcn_kernarg_segment_ptr())[C.tid];
    volatile LAS unsigned* MISC = (volatile LAS unsigned*)(C.lds + MISC_OFF);
    __syncthreads();
    gu32* ctl = (gu32*)(wsp(C) + WS_CTL);
    XcdBarrier bar; bar.bar = (unsigned*)(ctl + CW_BAR); bar.x = 0; bar.st = nullptr; bar.wv = wv;
    const bool multi = (args.ph_hi - args.ph_lo) > 1;
    if (multi) { bar = xcd_barrier_post((unsigned*)(ctl + CW_BAR), MISC + 8); bar.wv = wv; }

    for (int ph = args.ph_lo; ph < args.ph_hi; ++ph) {
        if (ph == PH_PRO) phase_prologue(wv);
        else if (ph == PH_NORM0) phase_norm(wv, 0, 1, MT);
        else {
            const int l = (ph - PH_L0) / PH_PER_LAYER, s = (ph - PH_L0) % PH_PER_LAYER;
            const int Mrows = (l == NL - 1) ? ML : MT;
            if (s == 0 || s == 2) {
                const bool mla = s == 2;
                pg8::Gemm g{mla ? (bf16*)(wsp(C) + WS_CQKV) : (bf16*)(wsp(C) + WS_XN), wptr(C, l, mla ? W_MLA : W_IN), MT, mla ? NMLA : NINP, mla ? KMLA : DM}; pg8::StaticOrder S; S.init(MT, mla ? NMLA : NINP, C.G, (int)blockIdx.x);
                pg8::EpiBf16<0> E{mla ? (bf16*)(wsp(C) + WS_MLAP) : (bf16*)(wsp(C) + WS_P), mla ? NMLA : NINP, nullptr, 0, 0, 1.f};
                pg8::gemm_phase<pg8::EpiBf16<0>, pg8::StaticOrder, true, true>(C.lds + RING_OFF, g, S, E, wv);
            } else if (s == 1) phase_prep1(wv, l);
            else if (s == 3) phase_prep2(wv, l);
#if ATTN_NAIVE
            else if (s == 4) phase_attn_naive(wv, l);
#else
            else if (s == 4) phase_attn(wv, l);
#endif
            else if (s == 5 || s == 9) {
                const bool dn = s == 9;
                pg8::Gemm g{dn ? (bf16*)(wsp(C) + WS_ACT) : (bf16*)(wsp(C) + WS_MIX), wptr(C, l, dn ? W_DOWN : W_OUT), Mrows, DM, dn ? DFF : DM}; pg8::StaticOrder S; S.init(Mrows, DM, C.G, (int)blockIdx.x);
                const bool first = (l == 0 && !dn);
                pg8::EpiResGate E{first ? inp(C, 0) : outp(C), first ? inp(C, 2) : (float*)(wsp(C) + WS_XC), outp(C), (float*)(wsp(C) + WS_XC), (float*)(wsp(C) + WS_MODS) + (size_t)l * 9 * 6144 + (dn ? 5120 : 2048)};
                pg8::gemm_phase<pg8::EpiResGate, pg8::StaticOrder, true, true>(C.lds + RING_OFF, g, S, E, wv);
            } else if (s == 6) phase_norm(wv, l, 2, Mrows);
            else if (s == 7) {
                pg8::Gemm g{(bf16*)(wsp(C) + WS_XN), wptr(C, l, W_UP), Mrows, NUP, DM}; pg8::StaticOrder S; S.init(Mrows, NUP, C.G, (int)blockIdx.x);
                pg8::EpiConvGate E{(bf16*)(wsp(C) + WS_ACT), (float*)(wsp(C) + WS_HALO), inp(C, 29) + (size_t)l * 3 * NUP, inp(C, 30) + (size_t)l * NUP, (PG8_LAS float*)(C.lds + EX_OFF)};
                pg8::gemm_phase<pg8::EpiConvGate, pg8::StaticOrder, true, true>(C.lds + RING_OFF, g, S, E, wv);
            } else if (s == 8) phase_fixup(wv, l);
            else phase_norm(wv, l + 1, 1, MT);
        }
        if (ph + 1 < args.ph_hi) { XcdBarrier bb = bar; asm volatile("" : "+s"(bb.bar), "+s"(bb.x)); xcd_barrier(bb); }
    }
}

extern "C" void kernel_launch(void* const* d_in, const int* in_sizes, int n_in, void* d_out, int out_size, void* d_ws, size_t ws_size, hipStream_t stream) {
    static int grid = 0;
    if (grid == 0) {
        if (n_in != 32 || out_size != ML * DM || ws_size < WS_END) { fprintf(stderr, "kernel_launch: unexpected shapes (n_in %d out %d ws %zu)\n", n_in, out_size, ws_size); grid = -1; return; }
        int dev = 0, cus = 0;
        if (hipGetDevice(&dev) != hipSuccess || hipDeviceGetAttribute(&cus, hipDeviceAttributeMultiprocessorCount, dev) != hipSuccess) { grid = -1; return; }
        if (hipFuncSetAttribute((const void*)fwd_kernel, hipFuncAttributeMaxDynamicSharedMemorySize, LDS_BYTES) != hipSuccess) { fprintf(stderr, "kernel_launch: hipFuncSetAttribute failed\n"); grid = -1; return; }
        (void)hipGetLastError();
        grid = cus;
    }
    if (grid < 0) return;
    (void)hipMemsetAsync((char*)d_ws + WS_CTL, 0, CTL_ZERO_BYTES, stream);
    Args a{};
    for (int i = 0; i < 32; ++i) a.in[i] = (const float*)d_in[i];
    a.out = (float*)d_out; a.ws = (unsigned char*)d_ws;
#if MK_PER_PHASE
    for (int ph = 0; ph < N_PHASES; ++ph) { a.ph_lo = ph; a.ph_hi = ph + 1; hipLaunchKernelGGL(fwd_kernel, dim3(grid), dim3(NWAVES * 64), LDS_BYTES, stream, a); }
#else
    a.ph_lo = 0; a.ph_hi = N_PHASES; hipLaunchKernelGGL(fwd_kernel, dim3(grid), dim3(NWAVES * 64), LDS_BYTES, stream, a);
#endif
}
```

```cpp
#include <hip/hip_runtime.h>
#include <cstdio>
#include <cstdint>
__device__ __forceinline__ int otid(int wv) { int l; asm volatile("v_mbcnt_lo_u32_b32 %0, -1, 0\n\tv_mbcnt_hi_u32_b32 %0, -1, %0" : "=v"(l)); return wv * 64 + l; }
namespace pg8 {
#define PG8_LAS __attribute__((address_space(3)))
typedef unsigned short bf16_t;
typedef short bf16x8 __attribute__((ext_vector_type(8)));
typedef float f32x4 __attribute__((ext_vector_type(4)));
typedef unsigned u32x4 __attribute__((ext_vector_type(4)));
constexpr int BM = 256, BK = 64, HALF = 128, HTB = HALF * BK * 2  , STAGE_BYTES = 8 * HTB, NXCD = 8, WGM = 8;

__host__ __device__ __forceinline__ int lds_byte(int r, int c) { const int st = (r >> 4) * 2 + (c >> 5), rr = r & 15, cc = c & 31, ob = rr * 64 + cc * 2; return st * 1024 + (ob ^ (((ob >> 9) & 1) << 5)); }
__host__ __device__ __forceinline__ void stage_rc(int b, int& R, int& C) { const int st = b / 1024, sb = b % 1024, swz = sb ^ (((sb >> 9) & 1) << 5); R = (st >> 1) * 16 + swz / 64; C = (st & 1) * 32 + (swz % 64) / 2; }
__host__ __device__ __forceinline__ int perm32(int rho) { const int n = rho >> 4, i = rho & 15; return 8 * (i >> 2) + 4 * n + (i & 3); }

struct Unit { int pm, pn, kb, nt; };
struct Gemm { const bf16_t* A; const bf16_t* Bt; int M, N, K; };

struct StaticOrder {
    int nM, nN, nwg, G, c;
    __host__ __device__ void init(int M, int N, int G_, int c_) { nM = M / BM; nN = N / BM; nwg = nM * nN; G = G_; c = c_; }
    __host__ __device__ __forceinline__ bool next(int i, Unit& u) const {
        const long L = (long)i * G + c; if (L >= nwg) { u.pm = 0; u.pn = 0; u.kb = 0; u.nt = 0; return false; }
        int wgid = (int)L; { const int q = nwg / NXCD, r = nwg % NXCD, xcd = wgid % NXCD, off = wgid / NXCD; wgid = (xcd < r ? xcd * (q + 1) : r * (q + 1) + (xcd - r) * q) + off; }
        const int nig = WGM * nN, gid = wgid / nig, fm = gid * WGM, gsz = (nM - fm) < WGM ? (nM - fm) : WGM;
        u.pm = fm + ((wgid % nig) % gsz); u.pn = (wgid % nig) / gsz; u.kb = 0; u.nt = 0; return true;
    }
    __device__ __forceinline__ void a_ready(const Unit&) const {}
    __device__ __forceinline__ void done(const Unit&) const {}
};

__device__ __forceinline__ unsigned cvt_pk_bf16(float lo, float hi) { unsigned r; asm volatile("v_cvt_pk_bf16_f32 %0, %1, %2" : "=v"(r) : "v"(lo), "v"(hi)); return r; }
typedef float f32x2 __attribute__((ext_vector_type(2)));
__device__ __forceinline__ f32x2 gelu_pk(f32x2 v) {
    const f32x2 av = __builtin_elementwise_abs(v), d = av * 0.2316418882f + 1.0f;
    f32x2 t; t.x = __builtin_amdgcn_rcpf(d.x); t.y = __builtin_amdgcn_rcpf(d.y);
    f32x2 q = t * 0.5307027145f + (-0.7265760135f); q = q * t + 0.7107068705f; q = q * t + (-0.142248368f); q = q * t + 0.127414796f; q = q * t;
    const f32x2 s = (v * v) * (-0.72134752044f);
    f32x2 e; e.x = __builtin_amdgcn_exp2f(s.x); e.y = __builtin_amdgcn_exp2f(s.y);
    const f32x2 m = v * (q * e), r = v - m;
    f32x2 o; o.x = v.x < 0.f ? m.x : r.x; o.y = v.y < 0.f ? m.y : r.y; return o;
}

template <int ACT  > struct EpiBf16 {
    static constexpr bool PERM = true, AFTER_DRAIN = false; static_assert(ACT == 0 || ACT == 1, "EpiBf16: ACT is 0 (none) or 1 (gelu_pk)");
    bf16_t* O; int ldc; const float* bias; int split_cols; size_t split_stride; float scale0;
    __device__ __forceinline__ void operator()(const f32x4 (&acc)[2][2][4][2], const Unit& u, int wr, int wc, int fr, int fq) const {
        const int row0 = u.pm * BM + wr * 64 + fr; int colt = u.pn * BM; bf16_t* base = O;
        float sc = 1.f; if (split_cols) { const int t = colt / split_cols; base += (size_t)t * split_stride; colt -= t * split_cols; if (t == 0) sc = scale0; }
        const int col0 = colt + wc * 32 + 8 * fq, bcol0 = u.pn * BM + wc * 32 + 8 * fq;
        f32x4 bv[2][2];
#pragma unroll
        for (int bj = 0; bj < 2; ++bj)
#pragma unroll
            for (int n = 0; n < 2; ++n) bv[bj][n] = bias ? *(const f32x4*)(bias + bcol0 + bj * HALF + 4 * n) : (f32x4){0.f, 0.f, 0.f, 0.f};
#pragma unroll
        for (int ai = 0; ai < 2; ++ai)
#pragma unroll
            for (int m = 0; m < 4; ++m) { bf16_t* rowp = base + (size_t)(row0 + ai * HALF + m * 16) * ldc + col0;
#pragma unroll
                for (int bj = 0; bj < 2; ++bj) { f32x4 v0 = acc[ai][bj][m][0] + bv[bj][0], v1 = acc[ai][bj][m][1] + bv[bj][1];
                    if (ACT == 1) { f32x2 a = gelu_pk((f32x2){v0[0], v0[1]}), b = gelu_pk((f32x2){v0[2], v0[3]}), c = gelu_pk((f32x2){v1[0], v1[1]}), d = gelu_pk((f32x2){v1[2], v1[3]});
                        v0 = (f32x4){a.x, a.y, b.x, b.y}; v1 = (f32x4){c.x, c.y, d.x, d.y}; }
                    v0 = v0 * sc; v1 = v1 * sc; u32x4 w; w.x = cvt_pk_bf16(v0[0], v0[1]); w.y = cvt_pk_bf16(v0[2], v0[3]); w.z = cvt_pk_bf16(v1[0], v1[1]); w.w = cvt_pk_bf16(v1[2], v1[3]);
                    *(u32x4*)(rowp + bj * HALF) = w; } }
    }
};

struct PanelStats {
    unsigned* xbuf;
    unsigned* cnt;
    unsigned* tmo;
    int ntn; float eps;
    unsigned code;
    __device__ __forceinline__ bool run(const f32x4 (&v)[2][2][4][2], const Unit& u, int wr, int wc, int fr, int fq, PG8_LAS unsigned char* lds, int wid, int lane) const {
        typedef float f32x2v __attribute__((ext_vector_type(2)));
        PG8_LAS f32x2v* P = (PG8_LAS f32x2v*)lds;
        PG8_LAS f32x2v* S = (PG8_LAS f32x2v*)(lds + 8192);
        PG8_LAS unsigned* flag = (PG8_LAS unsigned*)(lds + 8192 + 2048);
#pragma unroll
        for (int ai = 0; ai < 2; ++ai)
#pragma unroll
            for (int m = 0; m < 4; ++m) {
                float s = 0.f;
#pragma unroll
                for (int bj = 0; bj < 2; ++bj)
#pragma unroll
                    for (int n = 0; n < 2; ++n) { const f32x4 x = v[ai][bj][m][n]; s += (x[0] + x[1]) + (x[2] + x[3]); }
                s += __shfl_xor(s, 16); s += __shfl_xor(s, 32);
                const float mw = s * (1.0f / 64.0f); float q = 0.f;
#pragma unroll
                for (int bj = 0; bj < 2; ++bj)
#pragma unroll
                    for (int n = 0; n < 2; ++n) { const f32x4 d = v[ai][bj][m][n] - mw; q += (d[0] * d[0] + d[1] * d[1]) + (d[2] * d[2] + d[3] * d[3]); }
                q += __shfl_xor(q, 16); q += __shfl_xor(q, 32);
                if (fq == 0) P[(ai * HALF + wr * 64 + m * 16 + fr) * 4 + wc] = (f32x2v){mw, q};
            }
        asm volatile("s_waitcnt lgkmcnt(0)" ::: "memory"); __builtin_amdgcn_s_barrier(); asm volatile("" ::: "memory");
#if defined(BROKEN_EXCHANGE_NO_WAIT)
#warning BROKEN CONTROL BUILD: the row-statistics exchange does not wait; results are wrong by design
        if (blockIdx.x >= 64) { const long long t0_ = clock64(); while (clock64() - t0_ < 60000) __builtin_amdgcn_s_sleep(8); }
#endif
        const int row = wid * 32 + (lane & 31);
        if (lane < 32) {
            const f32x2v a = P[row * 4 + 0], b = P[row * 4 + 1], c = P[row * 4 + 2], d = P[row * 4 + 3];
            const float mt = (a.x + b.x + c.x + d.x) * 0.25f;
            const float da = a.x - mt, db = b.x - mt, dc = c.x - mt, dd = d.x - mt;
            const float m2 = (a.y + b.y) + (c.y + d.y) + 64.0f * ((da * da + db * db) + (dc * dc + dd * dd));
            unsigned long long* slot = (unsigned long long*)xbuf + ((size_t)(u.pm * BM + row) * 4 + u.pn);
            __hip_atomic_store(slot, ((unsigned long long)__float_as_uint(m2) << 32) | __float_as_uint(mt), __ATOMIC_RELAXED, __HIP_MEMORY_SCOPE_AGENT);
        }
        asm volatile("s_waitcnt vmcnt(0)" ::: "memory");
        if (lane == 0) __hip_atomic_fetch_add(cnt + 64 * u.pm, 1u, __ATOMIC_RELAXED, __HIP_MEMORY_SCOPE_AGENT);
        if (wid == 0) {
            bool dead = false; const unsigned long long t0 = __builtin_amdgcn_s_memrealtime(); const unsigned want = 8u * (unsigned)ntn;
            for (;;) {
#if defined(BROKEN_EXCHANGE_NO_WAIT)
                break;
#endif
                if ((unsigned)__builtin_amdgcn_readfirstlane(__hip_atomic_load(cnt + 64 * u.pm, __ATOMIC_RELAXED, __HIP_MEMORY_SCOPE_AGENT)) >= want) break;
                if (__builtin_amdgcn_s_memrealtime() - t0 > 2000000ull) {
                    if (lane == 0) { unsigned expect = 0u; __hip_atomic_compare_exchange_strong(tmo + 1, &expect, code | (unsigned)(u.pm & 0xff), __ATOMIC_RELAXED, __ATOMIC_RELAXED, __HIP_MEMORY_SCOPE_AGENT);
                                     __hip_atomic_store(tmo, 1u, __ATOMIC_RELAXED, __HIP_MEMORY_SCOPE_AGENT); }
                    dead = true; break; }
                __builtin_amdgcn_s_sleep(2);
            }
            __builtin_amdgcn_fence(__ATOMIC_ACQUIRE, "agent");
            if (lane == 0) flag[0] = dead ? 1u : 0u;
        }
        asm volatile("s_waitcnt vmcnt(0) lgkmcnt(0)" ::: "memory"); __builtin_amdgcn_s_barrier(); asm volatile("" ::: "memory");
        const bool bad = flag[0] != 0u;
        if (lane < 32) {
            const unsigned long long* slot = (const unsigned long long*)xbuf + (size_t)(u.pm * BM + row) * 4; float mt[4], m2[4]; float ms = 0.f;
#pragma unroll
            for (int t = 0; t < 4; ++t) { if (t < ntn) { const unsigned long long w = __hip_atomic_load(slot + t, __ATOMIC_RELAXED, __HIP_MEMORY_SCOPE_AGENT); mt[t] = __uint_as_float((unsigned)w); m2[t] = __uint_as_float((unsigned)(w >> 32)); } else { mt[t] = 0.f; m2[t] = 0.f; } ms += mt[t]; }
            const float mean = ms / (float)ntn; float q = 0.f;
#pragma unroll
            for (int t = 0; t < 4; ++t) if (t < ntn) { const float dm = mt[t] - mean; q += m2[t] + 256.0f * dm * dm; }
            S[row] = (f32x2v){mean, 1.0f / sqrtf(q / (256.0f * (float)ntn) + eps)};
        }
        asm volatile("s_waitcnt lgkmcnt(0)" ::: "memory"); __builtin_amdgcn_s_barrier(); asm volatile("" ::: "memory");
        return bad;
    }
};
struct EpiLnRes {
    static constexpr bool PERM = false, AFTER_DRAIN = true;
    const float* base; float* out; int ldc; const float* bias; PanelStats st; unsigned poison;
    __device__ __forceinline__ void fused(f32x4 (&acc)[2][2][4][2], const Unit& u, int wr, int wc, int fr, int fq, PG8_LAS unsigned char* lds, int wid, int lane) const {
        typedef float f32x2v __attribute__((ext_vector_type(2)));
        const PG8_LAS f32x2v* S = (const PG8_LAS f32x2v*)(lds + 8192);
        const int col0 = u.pn * BM + wc * 32 + 4 * fq;
#pragma unroll
        for (int bj = 0; bj < 2; ++bj)
#pragma unroll
            for (int n = 0; n < 2; ++n) { const f32x4 bv = bias ? *(const f32x4*)(bias + col0 + bj * HALF + n * 16) : (f32x4){0.f, 0.f, 0.f, 0.f};
#pragma unroll
                for (int ai = 0; ai < 2; ++ai)
#pragma unroll
                    for (int m = 0; m < 4; ++m) acc[ai][bj][m][n] += bv; }
        f32x4 pre[4][2][2];
#pragma unroll
        for (int m = 0; m < 4; ++m) { const size_t off = (size_t)(u.pm * BM + wr * 64 + m * 16 + fr) * ldc + col0;
#pragma unroll
            for (int bj = 0; bj < 2; ++bj)
#pragma unroll
                for (int n = 0; n < 2; ++n) pre[m][bj][n] = *(const f32x4*)(base + off + bj * HALF + n * 16); }
        const bool bad = st.run(acc, u, wr, wc, fr, fq, lds, wid, lane) || poison != 0u;
        const float qnan = __builtin_nanf("");
#pragma unroll
        for (int ai = 0; ai < 2; ++ai)
#pragma unroll
            for (int m = 0; m < 4; ++m) { const int r = ai * HALF + wr * 64 + m * 16 + fr; const f32x2v sr = S[r]; const size_t off = (size_t)(u.pm * BM + r) * ldc + col0;
#pragma unroll
                for (int bj = 0; bj < 2; ++bj)
#pragma unroll
                    for (int n = 0; n < 2; ++n) { const f32x4 bs = ai == 0 ? pre[m][bj][n] : *(const f32x4*)(base + off + bj * HALF + n * 16); f32x4 o = bs + (acc[ai][bj][m][n] - sr.x) * sr.y;
                        if (bad) o = (f32x4){qnan, qnan, qnan, qnan}; *(f32x4*)(out + off + bj * HALF + n * 16) = o; }
                if (m & 1) asm volatile("" ::: "memory"); }
    }
};
struct EpiLnResLn {
    static constexpr bool PERM = false, AFTER_DRAIN = true;
    const float* base; float* out; bf16_t* xn; int ldc; const float* bias; PanelStats st1, st2; unsigned poison;
    __device__ __forceinline__ void fused(f32x4 (&acc)[2][2][4][2], const Unit& u, int wr, int wc, int fr, int fq, PG8_LAS unsigned char* lds, int wid, int lane) const {
        typedef float f32x2v __attribute__((ext_vector_type(2))); typedef unsigned u32x2v __attribute__((ext_vector_type(2)));
        const PG8_LAS f32x2v* S = (const PG8_LAS f32x2v*)(lds + 8192);
        const int col0 = u.pn * BM + wc * 32 + 4 * fq;
#pragma unroll
        for (int bj = 0; bj < 2; ++bj)
#pragma unroll
            for (int n = 0; n < 2; ++n) { const f32x4 bv = bias ? *(const f32x4*)(bias + col0 + bj * HALF + n * 16) : (f32x4){0.f, 0.f, 0.f, 0.f};
#pragma unroll
                for (int ai = 0; ai < 2; ++ai)
#pragma unroll
                    for (int m = 0; m < 4; ++m) acc[ai][bj][m][n] += bv; }
        bool bad = st1.run(acc, u, wr, wc, fr, fq, lds, wid, lane) || poison != 0u;
        const float qnan = __builtin_nanf("");
#pragma unroll
        for (int ai = 0; ai < 2; ++ai)
#pragma unroll
            for (int m = 0; m < 4; ++m) { const int r = ai * HALF + wr * 64 + m * 16 + fr; const f32x2v sr = S[r]; const size_t off = (size_t)(u.pm * BM + r) * ldc + col0;
#pragma unroll
                for (int bj = 0; bj < 2; ++bj)
#pragma unroll
                    for (int n = 0; n < 2; ++n) { const f32x4 bs = *(const f32x4*)(base + off + bj * HALF + n * 16); acc[ai][bj][m][n] = bs + (acc[ai][bj][m][n] - sr.x) * sr.y; }
                asm volatile("" : "+v"(acc[ai][0][m][0]), "+v"(acc[ai][0][m][1]), "+v"(acc[ai][1][m][0]), "+v"(acc[ai][1][m][1]));
                if (m & 1) asm volatile("" ::: "memory"); }
        const bool bad1 = bad;
        bad = st2.run(acc, u, wr, wc, fr, fq, lds, wid, lane) || bad;
#pragma unroll
        for (int ai = 0; ai < 2; ++ai)
#pragma unroll
            for (int m = 0; m < 4; ++m) { const int r = ai * HALF + wr * 64 + m * 16 + fr; const f32x2v sr = S[r]; const size_t off = (size_t)(u.pm * BM + r) * ldc + col0;
#pragma unroll
                for (int bj = 0; bj < 2; ++bj)
#pragma unroll
                    for (int n = 0; n < 2; ++n) { const f32x4 x1 = acc[ai][bj][m][n]; *(f32x4*)(out + off + bj * HALF + n * 16) = bad1 ? (f32x4){qnan, qnan, qnan, qnan} : x1;
                        const f32x4 o = (x1 - sr.x) * sr.y; u32x2v w; w.x = cvt_pk_bf16(o[0], o[1]); w.y = cvt_pk_bf16(o[2], o[3]);
                        if (bad) { w.x = 0x7fc07fc0u; w.y = 0x7fc07fc0u; } *(u32x2v*)(xn + off + bj * HALF + n * 16) = w; }
                asm volatile("" ::: "memory"); }
    }
};

template <class Epi, class Sched, bool ALIGN_EPI = false, bool SP2 = false>
__device__ __forceinline__ void gemm_phase(PG8_LAS unsigned char* lds, const Gemm g, const Sched& S, const Epi& E, const int wv) {
    const int tid = otid(wv), wid = __builtin_amdgcn_readfirstlane(tid >> 6), lane = tid & 63, wr = wid >> 2, wc = wid & 3, fr = lane & 15, fq = lane >> 4;
    const int K = g.K, nt = K / BK;
    unsigned voffA[2], voffB[2];
#pragma unroll
    for (int i = 0; i < 2; ++i) { int R, C; stage_rc(tid * 16 + i * 8192, R, C); const int Rb = Epi::PERM ? ((R & ~31) + perm32(R & 31)) : R;
        voffA[i] = (unsigned)(R * K + C) * 2u; voffB[i] = (unsigned)(Rb * K + C) * 2u; }
    const size_t kstep = (size_t)(BK * 2);
    const size_t hstep = (size_t)HALF * K * 2;
    const size_t tstep = 2 * hstep;
    const unsigned ldsw = (unsigned)wid * 1024u;
    const int aoff = lds_byte(wr * 64 + fr, fq * 8), boff = lds_byte(wc * 32 + fr, fq * 8);
#define PG8_SA(b, h) (((b) * 2 + (h)) * HTB)
#define PG8_SB(b, h) ((4 + (b) * 2 + (h)) * HTB)
#define PG8_STAGE(bufoff, gbase, voff) do { _Pragma("unroll") for (int _i = 0; _i < 2; ++_i) \
        __builtin_amdgcn_global_load_lds((const unsigned*)((const char*)(gbase) + (voff)[_i]), (PG8_LAS unsigned*)(lds + (bufoff) + ldsw + _i * 8192), 16, 0, 0); } while (0)
#define PG8_LDA(dst, b, h) do { _Pragma("unroll") for (int m = 0; m < 4; ++m) _Pragma("unroll") for (int k = 0; k < 2; ++k) dst[m][k] = *(const PG8_LAS bf16x8*)(lds + PG8_SA(b, h) + aoff + m * 2048 + k * 1024); } while (0)
#define PG8_LDB(dst, b, h) do { _Pragma("unroll") for (int n = 0; n < 2; ++n) _Pragma("unroll") for (int k = 0; k < 2; ++k) dst[n][k] = *(const PG8_LAS bf16x8*)(lds + PG8_SB(b, h) + boff + n * 2048 + k * 1024); } while (0)
#define PG8_MMA(ai, bj, At, Bt) do { __builtin_amdgcn_s_setprio(1); _Pragma("unroll") for (int m = 0; m < 4; ++m) _Pragma("unroll") for (int n = 0; n < 2; ++n) _Pragma("unroll") for (int k = 0; k < 2; ++k) \
        acc[ai][bj][m][n] = __builtin_amdgcn_mfma_f32_16x16x32_bf16(Bt[n][k], At[m][k], acc[ai][bj][m][n], 0, 0, 0); __builtin_amdgcn_s_setprio(0); } while (0)
#define PG8_WAIT_V(n) asm volatile("s_waitcnt vmcnt(" #n ")" ::: "memory")
#define PG8_WAIT_L(n) asm volatile("s_waitcnt lgkmcnt(" #n ")" ::: "memory")
#define PG8_BAR __builtin_amdgcn_s_barrier()
#define PG8_SCHED __builtin_amdgcn_sched_barrier(0)
    Unit cur, nxt; int ui = 0;
    if (!S.next(0, cur)) return;
    f32x4 acc[2][2][4][2];
#pragma unroll
    for (int a = 0; a < 2; ++a)
#pragma unroll
        for (int b = 0; b < 2; ++b)
#pragma unroll
            for (int m = 0; m < 4; ++m)
#pragma unroll
                for (int n = 0; n < 2; ++n) acc[a][b][m][n] = (f32x4){0.f, 0.f, 0.f, 0.f};
    bf16x8 At[4][2], B0[2][2], B1[2][2];
    const char* cA = (const char*)g.A + (size_t)cur.pm * tstep + (size_t)cur.kb * kstep; const char* cB = (const char*)g.Bt + (size_t)cur.pn * tstep + (size_t)cur.kb * kstep;
    S.a_ready(cur);
    if constexpr (SP2) {
        PG8_STAGE(PG8_SB(0, 0), cB, voffB); PG8_STAGE(PG8_SB(0, 1), cB + hstep, voffB); PG8_STAGE(PG8_SA(0, 0), cA, voffA); PG8_STAGE(PG8_SA(0, 1), cA + hstep, voffA);
        if (wr == 1) PG8_BAR;
        PG8_WAIT_V(2); PG8_BAR;
        PG8_STAGE(PG8_SB(1, 0), cB + kstep, voffB); PG8_STAGE(PG8_SA(1, 0), cA + kstep, voffA); PG8_STAGE(PG8_SB(1, 1), cB + hstep + kstep, voffB);
        PG8_WAIT_V(6); PG8_BAR;
    } else {
        PG8_STAGE(PG8_SB(0, 0), cB, voffB); PG8_STAGE(PG8_SA(0, 0), cA, voffA); PG8_STAGE(PG8_SB(0, 1), cB + hstep, voffB); PG8_STAGE(PG8_SA(0, 1), cA + hstep, voffA);
        if (wr == 1) PG8_BAR;
        PG8_WAIT_V(4); PG8_BAR;
        PG8_STAGE(PG8_SB(1, 0), cB + kstep, voffB); PG8_STAGE(PG8_SA(1, 0), cA + kstep, voffA); PG8_STAGE(PG8_SB(1, 1), cB + hstep + kstep, voffB);
        PG8_WAIT_V(6); PG8_BAR;
    }
    for (;;) {
        const bool has_next = S.next(ui + 1, nxt);
        const char* nA = has_next ? (const char*)g.A + (size_t)nxt.pm * tstep + (size_t)nxt.kb * kstep : cA; const char* nB = has_next ? (const char*)g.Bt + (size_t)nxt.pn * tstep + (size_t)nxt.kb * kstep : cB;
        const int cnt = cur.nt ? cur.nt : nt;
        for (int t = 0; t < cnt; t += 2) {
            const bool last = (t == cnt - 2);
            const char* a1 = cA + (size_t)(t + 1) * kstep;
            const char* a2 = last ? nA : cA + (size_t)(t + 2) * kstep; const char* b2 = last ? nB : cB + (size_t)(t + 2) * kstep;
            const char* a3 = a2 + kstep; const char* b3 = b2 + kstep;
            if (last && has_next) S.a_ready(nxt);
            if constexpr (SP2) {
            PG8_LDB(B0, 0, 0); PG8_LDB(B1, 0, 1); PG8_SCHED; PG8_LDA(At, 0, 0); PG8_STAGE(PG8_SA(1, 1), a1 + hstep, voffA);
            PG8_WAIT_V(8); PG8_WAIT_L(0); PG8_BAR; PG8_MMA(0, 0, At, B0); PG8_MMA(0, 1, At, B1); PG8_BAR; PG8_SCHED;
            PG8_LDA(At, 0, 1); PG8_STAGE(PG8_SB(0, 0), b2, voffB); PG8_STAGE(PG8_SB(0, 1), b2 + hstep, voffB); PG8_STAGE(PG8_SA(0, 0), a2, voffA);
            PG8_WAIT_V(8); PG8_WAIT_L(0); PG8_BAR; PG8_MMA(1, 0, At, B0); PG8_MMA(1, 1, At, B1); PG8_BAR; PG8_SCHED;
            PG8_LDB(B0, 1, 0); PG8_LDB(B1, 1, 1); PG8_SCHED; PG8_LDA(At, 1, 0); PG8_STAGE(PG8_SA(0, 1), a2 + hstep, voffA);
            PG8_WAIT_V(8); PG8_WAIT_L(0); PG8_BAR; PG8_MMA(0, 0, At, B0); PG8_MMA(0, 1, At, B1); PG8_BAR; PG8_SCHED;
            PG8_LDA(At, 1, 1); PG8_STAGE(PG8_SB(1, 0), b3, voffB); PG8_STAGE(PG8_SB(1, 1), b3 + hstep, voffB); PG8_STAGE(PG8_SA(1, 0), a3, voffA);
            PG8_WAIT_V(8); PG8_WAIT_L(0); PG8_BAR; PG8_MMA(1, 0, At, B0); PG8_MMA(1, 1, At, B1); PG8_BAR; PG8_SCHED;
            } else {
            PG8_LDB(B0, 0, 0); PG8_SCHED; PG8_LDA(At, 0, 0); PG8_STAGE(PG8_SA(1, 1), a1 + hstep, voffA);
            PG8_WAIT_L(8); PG8_BAR; PG8_WAIT_L(0); PG8_MMA(0, 0, At, B0); PG8_BAR; PG8_SCHED;
            PG8_LDB(B1, 0, 1); PG8_STAGE(PG8_SB(0, 0), b2, voffB);
            PG8_BAR; PG8_WAIT_L(0); PG8_MMA(0, 1, At, B1); PG8_BAR;
            PG8_LDA(At, 0, 1); PG8_STAGE(PG8_SA(0, 0), a2, voffA);
            PG8_BAR; PG8_WAIT_L(0); PG8_MMA(1, 0, At, B0); PG8_BAR; PG8_SCHED;
            PG8_STAGE(PG8_SB(0, 1), b2 + hstep, voffB);
            PG8_WAIT_V(6); PG8_BAR; PG8_MMA(1, 1, At, B1); PG8_BAR;
            PG8_LDB(B0, 1, 0); PG8_SCHED; PG8_LDA(At, 1, 0); PG8_STAGE(PG8_SA(0, 1), a2 + hstep, voffA);
            PG8_WAIT_L(8); PG8_BAR; PG8_WAIT_L(0); PG8_MMA(0, 0, At, B0); PG8_BAR; PG8_SCHED;
            PG8_LDB(B1, 1, 1); PG8_STAGE(PG8_SB(1, 0), b3, voffB);
            PG8_BAR; PG8_WAIT_L(0); PG8_MMA(0, 1, At, B1); PG8_BAR;
            PG8_LDA(At, 1, 1); PG8_STAGE(PG8_SA(1, 0), a3, voffA);
            PG8_BAR; PG8_WAIT_L(0); PG8_MMA(1, 0, At, B0); PG8_BAR; PG8_SCHED;
            PG8_STAGE(PG8_SB(1, 1), b3 + hstep, voffB);
            PG8_WAIT_V(6); PG8_BAR; PG8_MMA(1, 1, At, B1); PG8_BAR;
            }
        }
        if constexpr (ALIGN_EPI) { if (wr == 0) PG8_BAR; }
        if constexpr (!Epi::AFTER_DRAIN) { E(acc, cur, wr, wc, fr, fq); S.done(cur); }
        if (!has_next) break;
#pragma unroll
        for (int a = 0; a < 2; ++a)
#pragma unroll
            for (int b = 0; b < 2; ++b)
#pragma unroll
                for (int m = 0; m < 4; ++m)
#pragma unroll
                    for (int n = 0; n < 2; ++n) acc[a][b][m][n] = (f32x4){0.f, 0.f, 0.f, 0.f};
        cur = nxt; cA = nA; cB = nB; ++ui;
        if constexpr (ALIGN_EPI) { if (wr == 1) PG8_BAR; }
    }
    PG8_WAIT_V(0);
    if constexpr (!ALIGN_EPI) { if (wr == 0) PG8_BAR; }
    PG8_BAR;
    if constexpr (Epi::AFTER_DRAIN) { E.fused(acc, cur, wr, wc, fr, fq, lds, wid, lane); S.done(cur); }
#undef PG8_SA
#undef PG8_SB
#undef PG8_STAGE
#undef PG8_LDA
#undef PG8_LDB
#undef PG8_MMA
#undef PG8_WAIT_V
#undef PG8_WAIT_L
#undef PG8_BAR
#undef PG8_SCHED
}
}

#ifndef PG8_SP2
#define PG8_SP2 true
#endif
#ifndef PG8_ALIGN
#define PG8_ALIGN true
#endif
#define GAS __attribute__((address_space(1)))
#define LAS __attribute__((address_space(3)))
typedef unsigned short bf16;
typedef unsigned v4u __attribute__((ext_vector_type(4)));
typedef float f32x4 __attribute__((ext_vector_type(4)));
typedef short bf16x8 __attribute__((ext_vector_type(8)));
typedef GAS unsigned gu32;
typedef GAS unsigned long long gu64;
#define RLX_AGENT __ATOMIC_RELAXED, __HIP_MEMORY_SCOPE_AGENT
#define LDS_WAIT() asm volatile("s_waitcnt lgkmcnt(0)" ::: "memory")
#define VM_WAIT() asm volatile("s_waitcnt vmcnt(0)" ::: "memory")
__device__ __forceinline__ unsigned long long rt() { return __builtin_amdgcn_s_memrealtime(); }
__device__ __forceinline__ unsigned f2bf(float f) { unsigned u = __builtin_bit_cast(unsigned, f); return (u + 0x7fffu + ((u >> 16) & 1u)) >> 16; }
__device__ __forceinline__ unsigned pk2(float lo, float hi) { return f2bf(lo) | (f2bf(hi) << 16); }

#define XB_TMO      128
#define XB_XCNT(j)  (256  + 64 * (j))
#define XB_XSUB(j)  (1280 + 64 * (j))
#define XB_XGEN(j)  (2304 + 64 * (j))
#define XB_TOP      3328
#define XB_TOPGEN   3392
#define XCD_BAR_WORDS 3456
#define XB_SPIN_CAP (1u << 18)

__device__ __forceinline__ unsigned xb_ld(unsigned* p)              { return __hip_atomic_load(p, __ATOMIC_RELAXED, __HIP_MEMORY_SCOPE_AGENT); }
__device__ __forceinline__ unsigned xb_add(unsigned* p, unsigned v) { return __hip_atomic_fetch_add(p, v, __ATOMIC_RELAXED, __HIP_MEMORY_SCOPE_AGENT); }
__device__ __forceinline__ unsigned xb_xcc_id() { return (unsigned)__builtin_amdgcn_s_getreg((3 << 11) | 20) & 0xFu; }
#define XB_SPIN(cond, bar) do { unsigned _sp = 0; while (cond) { __builtin_amdgcn_s_sleep(1); \
    if ((++_sp & 255u) == 0u) { if (xb_ld(&(bar)[XB_TMO])) break; if (_sp > XB_SPIN_CAP) { atomicAdd(&(bar)[XB_TMO], 1u); break; } } } } while (0)

struct XcdBarrier {
    unsigned* bar; unsigned x;
    volatile LAS unsigned* st;
    int wv;
};

__device__ __forceinline__ XcdBarrier xcd_barrier_post(unsigned* bar, volatile LAS unsigned* st) {
    XcdBarrier b; b.bar = bar; b.x = xb_xcc_id(); b.st = st;
    if (threadIdx.x == 0) (void)xb_add(&bar[XB_XCNT(b.x)], 1u);
    return b;
}
__device__ __forceinline__ void xcd_barrier_complete(unsigned* bar, unsigned x, unsigned& nloc, unsigned& nx) {
    const unsigned G = gridDim.x * gridDim.y * gridDim.z;
    unsigned sum, cnt, mine, sp = 0u;
    for (;;) {
        sum = 0u; cnt = 0u; mine = 0u;
#pragma unroll
        for (unsigned j = 0; j < 16; ++j) { const unsigned c = xb_ld(&bar[XB_XCNT(j)]); sum += c; cnt += (c > 0u) ? 1u : 0u; mine = (j == x) ? c : mine; }
        if (sum == G) break;
        __builtin_amdgcn_s_sleep(1);
        if ((++sp & 255u) == 0u) { if (xb_ld(&bar[XB_TMO])) break; if (sp > XB_SPIN_CAP) { atomicAdd(&bar[XB_TMO], 1u); break; } }
    }
    nloc = mine > 0u ? mine : 1u; nx = cnt > 0u ? cnt : 1u;
}

__device__ __forceinline__ void xcd_barrier(const XcdBarrier& b) {
    asm volatile("s_waitcnt vmcnt(0)" ::: "memory");
    __syncthreads();
    if (otid(b.wv) == 0) {
        unsigned* bar = b.bar;
        __builtin_amdgcn_s_waitcnt(0);
        unsigned nloc = b.st[0], nx = b.st[1];
        if (nloc == 0u) { xcd_barrier_complete(bar, b.x, nloc, nx); b.st[0] = nloc; b.st[1] = nx; }
        const unsigned old = xb_add(&bar[XB_XSUB(b.x)], 1u);
        const unsigned gen = old / nloc;
        if (old + 1u == (gen + 1u) * nloc) {
            __builtin_amdgcn_fence(__ATOMIC_RELEASE, "agent");
            asm volatile("s_waitcnt vmcnt(0)" ::: "memory");
            const unsigned og = xb_add(&bar[XB_TOP], 1u);
            const unsigned tg = og / nx;
            if (og + 1u == (tg + 1u) * nx) xb_add(&bar[XB_TOPGEN], 1u);
            else XB_SPIN(xb_ld(&bar[XB_TOPGEN]) == tg, bar);
            __builtin_amdgcn_fence(__ATOMIC_ACQUIRE, "agent");
            xb_add(&bar[XB_XGEN(b.x)], 1u);
            asm volatile("s_waitcnt vmcnt(0)" ::: "memory");
        } else {
            XB_SPIN(xb_ld(&bar[XB_XGEN(b.x)]) == gen, bar);
            __builtin_amdgcn_fence(__ATOMIC_ACQUIRE, "agent");
            asm volatile("s_waitcnt vmcnt(0)" ::: "memory");
        }
    }
    __syncthreads();
}


constexpr int NB = 8, SEQ = 2048, CTXL = 256, DM = 1024, NL = 4;
constexpr int ML = NB * SEQ, MC = NB * CTXL, MT = ML + MC;
constexpr int NIN = 2464, NINP = 2560, DFF = 2816, NUP = 5632, KMLA = 384, NMLA = 1024;
constexpr int NKEY = SEQ + CTXL, NKT = NKEY / 64;
constexpr float EPS = 1e-6f;
constexpr float LOG2E = 1.4426950408889634f;
constexpr int PC_CQ = 0, PC_CKV = 256, PC_KR = 384, PC_DQ = 512, PC_DK = 768, PC_DV = 1024, PC_NQ = 1280, PC_NK = 1536, PC_NV = 1792, PC_GQ = 2048, PC_GK = 2304, PC_GV = 2432;

constexpr size_t MiB = 1u << 20;
constexpr size_t WS_CTL = 0, CTL_ZERO_BYTES = 1 * MiB;
constexpr size_t WS_MODS = 1 * MiB;
constexpr size_t WS_ROPE32 = 2 * MiB;
constexpr size_t WS_ROPE64 = 2 * MiB + 262144;
constexpr size_t WS_W = 3 * MiB;
constexpr size_t W_IN = 0, W_OUT = W_IN + (size_t)NINP * DM * 2, W_UP = W_OUT + (size_t)DM * DM * 2, W_DOWN = W_UP + (size_t)NUP * DM * 2, W_MLA = W_DOWN + (size_t)DM * DFF * 2, W_LAYER = W_MLA + (size_t)NMLA * KMLA * 2;
static_assert(W_LAYER == 25427968, "weights per layer");
constexpr size_t WS_XC = 100 * MiB;
constexpr size_t WS_R2 = 108 * MiB;
constexpr size_t WS_XN = WS_R2, WS_MLAP = WS_R2, WS_CQKV = WS_R2 + 36 * MiB;
constexpr size_t WS_R1 = 158 * MiB;
constexpr size_t WS_P = WS_R1, WS_QKV = WS_R1 + 90 * MiB, WS_MIX = WS_R1, WS_ACT = WS_R1, WS_HALO = WS_R1 + 100 * MiB;
constexpr size_t WS_END = WS_R1 + 198 * MiB;
static_assert(WS_W + NL * W_LAYER <= WS_XC, "weights fit");
static_assert((size_t)MT * NINP * 2 <= 90 * MiB && (size_t)MT * DFF * 2 <= 100 * MiB && (size_t)72 * 4 * NUP * 4 <= 8 * MiB, "R1 map");
constexpr size_t E_QA = 0, E_KA = E_QA + (size_t)NB * 4 * NKEY * 96, E_VA = E_KA + (size_t)NB * 4 * NKEY * 96, E_QD = E_VA + (size_t)NB * 4 * NKEY * 64,
                 E_KD = E_QD + (size_t)NB * 8 * NKEY * 32, E_VD = E_KD + (size_t)NB * 8 * NKEY * 32, E_QN = E_VD + (size_t)NB * 4 * NKEY * 64, E_KN = E_QN + (size_t)NB * 4 * NKEY * 64,
                 E_VN = E_KN + (size_t)NB * 4 * NKEY * 64, E_QG = E_VN + (size_t)NB * 4 * NKEY * 64, E_KG = E_QG + (size_t)NB * 4 * NKEY * 64, E_VG = E_KG + (size_t)NB * 2 * NKEY * 64,
                 E_END = E_VG + (size_t)NB * 2 * NKEY * 64;
static_assert(E_END * 2 <= 108 * MiB, "QKV map");
constexpr int CW_TMO = 0, CW_CODE = 1, CW_BAR = 4096;

constexpr int RING_OFF = 0, RING_BYTES = 131072;
constexpr int LDSCTL_OFF = RING_BYTES, MISC_OFF = LDSCTL_OFF + 320;
constexpr int EX_OFF = RING_BYTES + 1024;
constexpr int LDS_BYTES = 147456;
static_assert(EX_OFF + 8192 <= LDS_BYTES, "LDS map");
constexpr int NWAVES = 8;

typedef float f32x2v __attribute__((ext_vector_type(2)));
typedef unsigned u32x2v __attribute__((ext_vector_type(2)));

__device__ __forceinline__ float bf2f(unsigned short v) { return __uint_as_float((unsigned)v << 16); }
__device__ __forceinline__ float bflo(unsigned w) { return __uint_as_float(w << 16); }
__device__ __forceinline__ float bfhi(unsigned w) { return __uint_as_float(w & 0xffff0000u); }
template <int M> __device__ __forceinline__ float swz(float v) { static_assert(M >= 1 && M < 32, "xor mask within 32 lanes"); return __int_as_float(__builtin_amdgcn_ds_swizzle(__float_as_int(v), (M << 10) | 0x1f)); }
__device__ __forceinline__ float sum32(float v) { auto r = __builtin_amdgcn_permlane32_swap(__float_as_uint(v), __float_as_uint(v), false, false); return __uint_as_float(r[0]) + __uint_as_float(r[1]); }
__device__ __forceinline__ float max32(float v) { auto r = __builtin_amdgcn_permlane32_swap(__float_as_uint(v), __float_as_uint(v), false, false); return fmaxf(__uint_as_float(r[0]), __uint_as_float(r[1])); }
__device__ __forceinline__ float wave_sum(float v) { v += swz<1>(v); v += swz<2>(v); v += swz<4>(v); v += swz<8>(v); v += swz<16>(v); return sum32(v); }
template <int CTRL> __device__ __forceinline__ float dpp_mov(float v) { return __int_as_float(__builtin_amdgcn_update_dpp(0, __float_as_int(v), CTRL, 0xf, 0xf, false)); }
__device__ __forceinline__ float silu_f(float x) { return x / (1.f + __expf(-x)); }
__device__ __forceinline__ float rsq_f(float x) { return __builtin_amdgcn_rsqf(x); }
typedef __bf16 bf16x2h __attribute__((ext_vector_type(2)));
__device__ __forceinline__ unsigned pkc(float lo, float hi) { f32x2v v = {lo, hi}; bf16x2h b = __builtin_convertvector(v, bf16x2h); return __builtin_bit_cast(unsigned, b); }
__device__ __forceinline__ unsigned pkc1(float v) { return pkc(v, 0.f) & 0xffffu; }

__device__ __forceinline__ size_t q_off(int H, int DK, int b, int h, int q) { return ((size_t)(b * H + h) * NKEY + q) * DK; }
__device__ __forceinline__ size_t k_off(int H, int DK, int b, int h, int key, int d) { return ((((size_t)(b * H + h) * NKT + (key >> 6)) * (DK >> 3) + (d >> 3)) * 64 + (key & 63)) * 8 + (d & 7); }
__device__ __forceinline__ size_t v_off(int H, int b, int h, int key, int dv) {
    const int kk = key & 63, s = kk >> 4, i = kk & 15, hh = (i >> 2) & 1, j = (i & 3) + 4 * (i >> 3);
    return ((((size_t)(b * H + h) * NKT + (key >> 6)) * 8 + (s * 2 + hh)) * 64 + dv) * 8 + j;
}

constexpr int PT_OFF = LDSCTL_OFF + 512;
struct Ctx {
    LAS unsigned char* lds;
    int tid, lane, wave, G, gw, NGW;
};
extern __shared__ __attribute__((aligned(16))) unsigned char lds_raw[];
__device__ __forceinline__ Ctx make_ctx(const int wv) {
    unsigned zl = 0; asm volatile("" : "+s"(zl));
    Ctx C; C.lds = (LAS unsigned char*)lds_raw + zl;
    int w = wv; asm volatile("" : "+s"(w));
    const int t = otid(w);
    C.tid = t; C.lane = t & 63; C.wave = w;
    C.G = gridDim.x; { const int bx = blockIdx.x; const int vcu = (C.G % 8 == 0) ? (bx % 8) * (C.G / 8) + bx / 8 : bx; C.gw = vcu * NWAVES + C.wave; } C.NGW = C.G * NWAVES;
    return C;
}
__device__ __forceinline__ unsigned long long ptab(const Ctx& C, int i) {
    const unsigned long long p = ((const LAS unsigned long long*)(C.lds + PT_OFF))[i];
    const unsigned lo = __builtin_amdgcn_readfirstlane((unsigned)p), hi = __builtin_amdgcn_readfirstlane((unsigned)(p >> 32));
    return ((unsigned long long)hi << 32) | lo;
}
__device__ __forceinline__ const float* inp(const Ctx& C, int i) { return (const float*)ptab(C, i); }
__device__ __forceinline__ float* outp(const Ctx& C) { return (float*)ptab(C, 32); }
__device__ __forceinline__ unsigned char* wsp(const Ctx& C) { return (unsigned char*)ptab(C, 33); }
__device__ __forceinline__ bf16* wptr(const Ctx& C, int l, size_t off) { return (bf16*)(wsp(C) + WS_W + (size_t)l * W_LAYER + off); }
__device__ __forceinline__ float lambda_init(int l) { return l == 0 ? 0.2f : l == 1 ? (float)(0.8 - 0.6 * 0.7408182206817179) : l == 2 ? (float)(0.8 - 0.6 * 0.5488116360940264) : (float)(0.8 - 0.6 * 0.4065696597405991); }

namespace pg8 {
struct EpiResGate {
    static constexpr bool PERM = false, AFTER_DRAIN = false;
    const float* base_lat; const float* base_ctx; float* out_lat; float* out_ctx; const float* gate;
    __device__ __forceinline__ void operator()(const f32x4 (&acc)[2][2][4][2], const Unit& u, int wr, int wc, int fr, int fq) const {
        const bool lat = u.pm < 64; const int bidx = lat ? (u.pm >> 3) : 8;
        const size_t rowt = lat ? (size_t)u.pm * BM : (size_t)(u.pm - 64) * BM;
        const float* base = (lat ? base_lat : base_ctx) + rowt * DM; float* out = (lat ? out_lat : out_ctx) + rowt * DM;
        const int row0 = wr * 64 + fr, col0 = u.pn * BM + wc * 32 + 4 * fq;
        f32x4 gv[2][2];
#pragma unroll
        for (int bj = 0; bj < 2; ++bj)
#pragma unroll
            for (int n = 0; n < 2; ++n) gv[bj][n] = *(const f32x4*)(gate + (size_t)bidx * 6144 + col0 + bj * HALF + n * 16);
#pragma unroll
        for (int ai = 0; ai < 2; ++ai)
#pragma unroll
            for (int m = 0; m < 4; ++m) { const size_t off = (size_t)(row0 + ai * HALF + m * 16) * DM + col0;
#pragma unroll
                for (int bj = 0; bj < 2; ++bj)
#pragma unroll
                    for (int n = 0; n < 2; ++n) {
                        if (u.nt) { const f32x4 d = gv[bj][n] * acc[ai][bj][m][n]; float* o = out + off + bj * HALF + n * 16;
#pragma unroll
                            for (int e = 0; e < 4; ++e) (void)__hip_atomic_fetch_add(o + e, d[e], __ATOMIC_RELAXED, __HIP_MEMORY_SCOPE_AGENT); }
                        else { const f32x4 bs = *(const f32x4*)(base + off + bj * HALF + n * 16); *(f32x4*)(out + off + bj * HALF + n * 16) = bs + gv[bj][n] * acc[ai][bj][m][n]; } }
                if (m & 1) asm volatile("" ::: "memory"); }
    }
};
struct SplitOrder {
    StaticOrder lat; int G, c, nsub, NS, ntsub;
    __device__ __forceinline__ void init(int G_, int c_, bool with_ctx, int NS_, int ntsub_) { lat.init(ML, DM, G_, c_); G = G_; c = c_; NS = NS_; ntsub = ntsub_; nsub = with_ctx ? 32 * NS_ : 0; }
    __device__ __forceinline__ bool next(int i, Unit& u) const {
        const long L = (long)i * G + c;
        Unit a; const bool okl = lat.next(i, a);
        const int j = (int)(L - 256), cu = j / NS, sp = j - cu * NS; const bool sub = L >= 256;
        u.pm = sub ? 64 + (cu >> 2) : a.pm; u.pn = sub ? (cu & 3) : a.pn; u.kb = sub ? sp * ntsub : 0; u.nt = sub ? ntsub : 0;
        return sub ? (j < nsub) : okl;
    }
    __device__ __forceinline__ void a_ready(const Unit&) const {}
    __device__ __forceinline__ void done(const Unit&) const {}
};
__device__ __forceinline__ f32x4 sel4(bool c, const f32x4 a, const f32x4 b) { f32x4 r; r[0] = c ? a[0] : b[0]; r[1] = c ? a[1] : b[1]; r[2] = c ? a[2] : b[2]; r[3] = c ? a[3] : b[3]; return r; }
__device__ __forceinline__ float silu1(float x) { return x * __builtin_amdgcn_rcpf(1.f + __expf(-x)); }
struct EpiConvGate {
    static constexpr bool PERM = true, AFTER_DRAIN = false;
    bf16_t* ACT; float* HALO; const float* cw; const float* cb; PG8_LAS float* EX;
    __device__ __forceinline__ void operator()(const f32x4 (&acc)[2][2][4][2], const Unit& u, int wr, int wc, int fr, int fq) const {
        const int lane = fq * 16 + fr;
        const int jc = u.pn * 128 + wc * 32 + 8 * fq;
        if (fr == 0) {
#pragma unroll
            for (int ai = 0; ai < 2; ++ai)
#pragma unroll
                for (int bj = 0; bj < 2; ++bj)
#pragma unroll
                    for (int n = 0; n < 2; ++n) *(PG8_LAS f32x4*)(EX + ((((wr * 4 + wc) * 2 + ai) * 2 + 0) * 64 + bj * 32 + 8 * fq + 4 * n)) = acc[ai][bj][0][n];
        }
        if (fr == 15) {
#pragma unroll
            for (int ai = 0; ai < 2; ++ai)
#pragma unroll
                for (int bj = 0; bj < 2; ++bj)
#pragma unroll
                    for (int n = 0; n < 2; ++n) *(PG8_LAS f32x4*)(EX + ((((wr * 4 + wc) * 2 + ai) * 2 + 1) * 64 + bj * 32 + 8 * fq + 4 * n)) = acc[ai][bj][3][n];
        }
        asm volatile("s_waitcnt lgkmcnt(0)" ::: "memory"); __builtin_amdgcn_s_barrier(); asm volatile("" ::: "memory");
        if (u.pm < 64) {
            float* hb = HALO + (size_t)u.pm * 4 * NUP;
            if (wr == 0 && fr < 2) {
#pragma unroll
                for (int bj = 0; bj < 2; ++bj)
#pragma unroll
                    for (int n = 0; n < 2; ++n) *(f32x4*)(hb + (size_t)fr * NUP + bj * DFF + jc + 4 * n) = acc[0][bj][0][n];
            }
            if (wr == 1 && fr >= 14) {
#pragma unroll
                for (int bj = 0; bj < 2; ++bj)
#pragma unroll
                    for (int n = 0; n < 2; ++n) *(f32x4*)(hb + (size_t)(fr - 12) * NUP + bj * DFF + jc + 4 * n) = acc[1][bj][3][n];
            }
        }
        const bool f0 = fr == 0, f15 = fr == 15;
#pragma unroll
        for (int ai = 0; ai < 2; ++ai) {
            const int g = 2 * ai + wr;
            const int gp = g - 1, gn = g + 1;
            unsigned pk[4][4];
#pragma unroll
            for (int n = 0; n < 2; ++n)
#pragma unroll
                for (int ep = 0; ep < 2; ++ep) {
                    float cv[2][2][4];
#pragma unroll
                    for (int bj = 0; bj < 2; ++bj) {
                        const int c = bj * DFF + jc + 4 * n + 2 * ep;
                        const f32x2v w0 = *(const f32x2v*)(cw + c), w1 = *(const f32x2v*)(cw + NUP + c), w2 = *(const f32x2v*)(cw + 2 * NUP + c), bb = *(const f32x2v*)(cb + c);
                        f32x2v bprev = {0.f, 0.f}, bnext = {0.f, 0.f};
                        if (gp >= 0) bprev = *(const PG8_LAS f32x2v*)(EX + (((((gp & 1) * 4 + wc) * 2 + (gp >> 1)) * 2 + 1) * 64 + bj * 32 + 8 * fq + 4 * n + 2 * ep));
                        if (gn <= 3) bnext = *(const PG8_LAS f32x2v*)(EX + (((((gn & 1) * 4 + wc) * 2 + (gn >> 1)) * 2 + 0) * 64 + bj * 32 + 8 * fq + 4 * n + 2 * ep));
#pragma unroll
                        for (int e2 = 0; e2 < 2; ++e2) {
                            const int e = 2 * ep + e2;
                            float r[4], l[4];
#pragma unroll
                            for (int m = 0; m < 4; ++m) { r[m] = dpp_mov<0x121>(acc[ai][bj][m][n][e]); l[m] = dpp_mov<0x12f>(acc[ai][bj][m][n][e]); }
#pragma unroll
                            for (int m = 0; m < 4; ++m) {
                                const float pv = f0 ? (m > 0 ? r[m > 0 ? m - 1 : 0] : bprev[e2]) : r[m];
                                const float nx = f15 ? (m < 3 ? l[m < 3 ? m + 1 : 3] : bnext[e2]) : l[m];
                                cv[bj][e2][m] = w0[e2] * pv + w1[e2] * acc[ai][bj][m][n][e] + w2[e2] * nx + bb[e2];
                            }
                        }
                    }
#pragma unroll
                    for (int m = 0; m < 4; ++m) pk[m][n * 2 + ep] = cvt_pk_bf16(silu1(cv[1][0][m]) * cv[0][0][m], silu1(cv[1][1][m]) * cv[0][1][m]);
                    __builtin_amdgcn_sched_barrier(0);
                }
#pragma unroll
            for (int m = 0; m < 4; ++m) {
                const size_t row = (size_t)u.pm * BM + ai * HALF + wr * 64 + m * 16 + fr;
                u32x4 w; w.x = pk[m][0]; w.y = pk[m][1]; w.z = pk[m][2]; w.w = pk[m][3];
                *(u32x4*)(ACT + row * DFF + jc) = w;
            }
            __builtin_amdgcn_sched_barrier(0);
        }
    }
};
}

__device__ __forceinline__ void transpose_item(const float* W, int N, int k0, int n0, bf16* WT, int ldt, int kcol0, int orow0, LAS float* scr, int lane) {
#pragma unroll 8
    for (int i = 0; i < 32; ++i) { const int kk = 2 * i + (lane >> 5); scr[kk * 33 + (lane & 31)] = W[(size_t)(k0 + kk) * N + n0 + (lane & 31)]; }
    LDS_WAIT(); asm volatile("" ::: "memory");
    const int c = lane & 7;
#pragma unroll
    for (int j = 0; j < 4; ++j) { const int n = (lane >> 3) + 8 * j; const LAS float* s = scr + (8 * c) * 33 + n;
        v4u o; o.x = pkc(s[0 * 33], s[1 * 33]); o.y = pkc(s[2 * 33], s[3 * 33]); o.z = pkc(s[4 * 33], s[5 * 33]); o.w = pkc(s[6 * 33], s[7 * 33]);
        *(GAS v4u*)(WT + (size_t)(orow0 + n) * ldt + kcol0 + k0 + 8 * c) = o; }
    LDS_WAIT(); asm volatile("" ::: "memory");
}
__device__ __forceinline__ void phase_prologue(const int wv) {
    const Ctx C = make_ctx(wv);
    {
        LAS float* S = (LAS float*)(C.lds);
        LAS float* red = (LAS float*)(C.lds + 40960);
        const float* cin = inp(C, 1); const float* cctx = inp(C, 3); const float* wmod = inp(C, 4); const float* bmod = inp(C, 5);
        for (int i = C.tid; i < 9 * 1024; i += 512) { const int r = i >> 10, k = i & 1023; const float v = (r < 8) ? cin[r * 1024 + k] : cctx[k]; S[i] = v / (1.f + expf(-v)); }
        __syncthreads();
        for (int it = blockIdx.x; it < NL * 192; it += C.G) {
            const int l = it / 192, col0 = (it % 192) * 32;
            const float* W = wmod + (size_t)l * 1024 * 6144 + col0 + (C.lane & 31);
            float acc[9];
#pragma unroll
            for (int r = 0; r < 9; ++r) acc[r] = 0.f;
            const int kb = C.wave * 128 + (C.lane >> 5);
#pragma unroll 4
            for (int i = 0; i < 64; ++i) { const int k = kb + 2 * i; const float w = W[(size_t)k * 6144];
#pragma unroll
                for (int r = 0; r < 9; ++r) acc[r] += S[r * 1024 + k] * w; }
#pragma unroll
            for (int r = 0; r < 9; ++r) acc[r] = sum32(acc[r]);
            if (C.lane < 32) {
#pragma unroll
                for (int r = 0; r < 9; ++r) red[(C.wave * 9 + r) * 32 + C.lane] = acc[r];
            }
            __syncthreads();
            if (C.tid < 288) { const int r = C.tid >> 5, cc = C.tid & 31; float s = 0.f;
#pragma unroll
                for (int w = 0; w < 8; ++w) s += red[(w * 9 + r) * 32 + cc];
                ((float*)(wsp(C) + WS_MODS))[(size_t)(l * 9 + r) * 6144 + col0 + cc] = s + bmod[l * 6144 + col0 + cc]; }
            __syncthreads();
        }
    }
    {
        LAS float* scr = (LAS float*)(C.lds + 49152 + C.wave * 9216);
        constexpr int I_IN = 16 * 77, I_OUT = 16 * 32, I_UP = 16 * 176, I_DN = 44 * 32, I_UQ = 4 * 12, I_UKV = 2 * 16, I_L = I_IN + I_OUT + I_UP + I_DN + I_UQ + I_UKV;
        for (int it = C.gw; it < NL * I_L; it += C.NGW) {
            const int l = it / I_L; int r = it % I_L;
            if (r < I_IN) { const int kb = r / 77, nb = r % 77, n0 = nb * 32; transpose_item(inp(C, 7) + (size_t)l * DM * NIN, NIN, kb * 64, n0, wptr(C, l, W_IN), DM, 0, n0 < 416 ? n0 : n0 + 96, scr, C.lane); continue; } r -= I_IN;
            if (r < I_OUT) { const int kb = r / 32, nb = r % 32; transpose_item(inp(C, 8) + (size_t)l * DM * DM, DM, kb * 64, nb * 32, wptr(C, l, W_OUT), DM, 0, nb * 32, scr, C.lane); continue; } r -= I_OUT;
            if (r < I_UP) { const int kb = r / 176, nb = r % 176, n0 = nb * 32, bj = n0 >= DFF ? 1 : 0, j0 = n0 - bj * DFF;
                transpose_item(inp(C, 28) + (size_t)l * DM * NUP, NUP, kb * 64, n0, wptr(C, l, W_UP), DM, 0, 256 * (j0 >> 7) + 128 * bj + (j0 & 127), scr, C.lane); continue; } r -= I_UP;
            if (r < I_DN) { const int kb = r / 32, nb = r % 32; transpose_item(inp(C, 31) + (size_t)l * DFF * DM, DM, kb * 64, nb * 32, wptr(C, l, W_DOWN), DFF, 0, nb * 32, scr, C.lane); continue; } r -= I_DN;
            if (r < I_UQ) { const int kb = r / 12, nb = r % 12; transpose_item(inp(C, 10) + (size_t)l * 256 * 384, 384, kb * 64, nb * 32, wptr(C, l, W_MLA), KMLA, 0, nb * 32, scr, C.lane); continue; } r -= I_UQ;
            { const int kb = r / 16, nb = r % 16; transpose_item(inp(C, 12) + (size_t)l * 128 * 512, 512, kb * 64, nb * 32, wptr(C, l, W_MLA), KMLA, 256, 512 + nb * 32, scr, C.lane); }
        }
        const int gt = C.gw * 64 + C.lane, NGT = C.NGW * 64;
        const v4u z = {0u, 0u, 0u, 0u};
        for (int i = gt; i < NL * 96 * 128; i += NGT) { const int l = i / (96 * 128), r = i % (96 * 128); *(GAS v4u*)(wptr(C, l, W_IN) + (size_t)(416 + r / 128) * DM + (r % 128) * 8) = z; }
        for (int i = gt; i < NL * 1024 * 48; i += NGT) { const int l = i / (1024 * 48), r = (i / 48) % 1024, k = (i % 48) * 8;
            const bool zero = (r < 384) ? (k >= 256) : (r < 512) ? true : (k < 256);
            if (zero) *(GAS v4u*)(wptr(C, l, W_MLA) + (size_t)r * KMLA + k) = z; }
        float* r32 = (float*)(wsp(C) + WS_ROPE32); float* r64 = (float*)(wsp(C) + WS_ROPE64);
        for (int i = gt; i < 2048 * 48; i += NGT) {
            const int pos = i / 48, e = i % 48; const float row = (float)(pos >> 6), col = (float)(pos & 63);
            if (e < 16) { const int f = e & 7; const float inv = powf(10000.f, -(float)f / 8.f); const float a = (e < 8 ? row : col) * inv; r32[(pos * 16 + e) * 2] = cosf(a); r32[(pos * 16 + e) * 2 + 1] = sinf(a); }
            else { const int e2 = e - 16, f = e2 & 15; const float inv = powf(10000.f, -(float)f / 16.f); const float a = (e2 < 16 ? row : col) * inv; r64[(pos * 32 + e2) * 2] = cosf(a); r64[(pos * 32 + e2) * 2 + 1] = sinf(a); }
        }
    }
}

__device__ __forceinline__ void phase_norm(const int wv, int l, int which, int nrows) {
    const Ctx C = make_ctx(wv);
    const bool first = (l == 0 && which == 1);
    const float* xl = first ? inp(C, 0) : outp(C); const float* xc = first ? inp(C, 2) : ((float*)(wsp(C) + WS_XC));
    const float* gv = (which == 1 ? inp(C, 6) : inp(C, 27)) + l * DM;
    f32x4 g4[4];
#pragma unroll
    for (int j = 0; j < 4; ++j) g4[j] = *(const f32x4*)(gv + 4 * C.lane + 256 * j);
    bf16* XN = (bf16*)(wsp(C) + WS_XN); const float* mods = (const float*)(wsp(C) + WS_MODS);
    for (int R0 = C.gw; R0 < nrows; R0 += 3 * C.NGW) {
        f32x4 v[3][4]; float ss[3];
#pragma unroll
        for (int u = 0; u < 3; ++u) { const int R = R0 + u * C.NGW; ss[u] = 0.f;
            if (R < nrows) { const float* src = R < ML ? xl + (size_t)R * DM : xc + (size_t)(R - ML) * DM;
#pragma unroll
                for (int j = 0; j < 4; ++j) { v[u][j] = *(const f32x4*)(src + 4 * C.lane + 256 * j); ss[u] += (v[u][j][0] * v[u][j][0] + v[u][j][1] * v[u][j][1]) + (v[u][j][2] * v[u][j][2] + v[u][j][3] * v[u][j][3]); } } }
#pragma unroll
        for (int u = 0; u < 3; ++u) ss[u] = wave_sum(ss[u]);
#pragma unroll
        for (int u = 0; u < 3; ++u) { const int R = R0 + u * C.NGW;
            if (R < nrows) { const float rs = rsq_f(ss[u] * (1.f / DM) + EPS);
                const int bidx = R < ML ? (R >> 11) : 8; const float* md = mods + (size_t)(l * 9 + bidx) * 6144 + (which == 1 ? 0 : 3072);
#pragma unroll
                for (int j = 0; j < 4; ++j) {
                    const f32x4 sh = *(const f32x4*)(md + 4 * C.lane + 256 * j), sc = *(const f32x4*)(md + 1024 + 4 * C.lane + 256 * j);
                    const f32x4 y = (v[u][j] * rs) * g4[j] * (sc + 1.f) + sh;
                    u32x2v w; w.x = pkc(y[0], y[1]); w.y = pkc(y[2], y[3]);
                    *(u32x2v*)(XN + (size_t)R * DM + 4 * C.lane + 256 * j) = w; } } }
    }
}

__device__ __forceinline__ void row_info(int R, int& b, int& qi, int& pos) {
    if (R < ML) { b = R >> 11; qi = R & 2047; pos = qi; } else { const int r = R - ML; b = r >> 8; qi = 2048 + (r & 255); pos = -1; }
}
template <int MAXO> __device__ __forceinline__ float red_xor(float v) { v += swz<1>(v); v += swz<2>(v); v += swz<4>(v); if (MAXO >= 8) v += swz<8>(v); if (MAXO >= 16) v += swz<16>(v); return v; }

constexpr int TB = 8;
__device__ __forceinline__ void phase_prep1(const int wv, int l) {
    const Ctx C = make_ctx(wv);
    LAS unsigned char* img = C.lds + C.wave * 16384;
    bf16* Q = ((bf16*)(wsp(C) + WS_QKV));
    const bf16* P = (const bf16*)(wsp(C) + WS_P); bf16* CQKV = (bf16*)(wsp(C) + WS_CQKV);
    const float* rope32 = (const float*)(wsp(C) + WS_ROPE32); const float* rope64 = (const float*)(wsp(C) + WS_ROPE64);
    const float C32 = 0.17677669529663687f * LOG2E, C64 = 0.125f * LOG2E;
    const int lane = C.lane;
    for (int item = C.gw; item < 3 * (MT / 16); item += C.NGW) {
        const int part = item / (MT / 16), g = item % (MT / 16), R0 = 16 * g;
        int b, qi0, pos0; row_info(R0, b, qi0, pos0);
        const int tile = qi0 >> 6, sidx = (qi0 >> 4) & 3;
        if (part == 0) {
            const int gi = lane >> 3, lg = lane & 7, d0 = 4 * lg, ti0 = ((lg & 4) ? 8 : 0) + 4 * (lg & 1); const bool rot = pos0 >= 0;
            const float* gq = inp(C, 15) + l * 32 + d0; const float* gk = inp(C, 16) + l * 32 + d0;
            float gqv[4], gkv[4];
#pragma unroll
            for (int e = 0; e < 4; ++e) { gqv[e] = gq[e]; gkv[e] = gk[e]; }
            for (int t0 = 0; t0 < 16; t0 += TB) {
            u32x2v wq4[TB], wk4[TB], wv4[TB]; f32x4 rt4[TB][2];
#pragma unroll
            for (int tt = 0; tt < TB; ++tt) { const bf16* pr = P + (size_t)(R0 + t0 + tt) * NINP; wq4[tt] = *(const u32x2v*)(pr + PC_DQ + 4 * lane); wk4[tt] = *(const u32x2v*)(pr + PC_DK + 4 * lane); wv4[tt] = *(const u32x2v*)(pr + PC_DV + 4 * lane);
                const float* rp = rope32 + ((rot ? pos0 + t0 + tt : 0) * 16 + ti0) * 2; rt4[tt][0] = *(const f32x4*)rp; rt4[tt][1] = *(const f32x4*)(rp + 4); }
#pragma unroll
            for (int tt = 0; tt < TB; ++tt) {
                const int t = t0 + tt;
                const u32x2v wq = wq4[tt], wk = wk4[tt], wvv = wv4[tt];
#pragma unroll
                for (int qk = 0; qk < 2; ++qk) {
                    const u32x2v w = qk ? wk : wq; float v[4] = {bflo(w.x), bfhi(w.x), bflo(w.y), bfhi(w.y)};
                    float ss = (v[0] * v[0] + v[1] * v[1]) + (v[2] * v[2] + v[3] * v[3]); ss = red_xor<4>(ss);
                    const float rs = rsq_f(ss * (1.f / 32.f) + EPS);
                    float y[4];
#pragma unroll
                    for (int e = 0; e < 4; ++e) y[e] = v[e] * rs * (qk ? gkv[e] : gqv[e]);
#pragma unroll
                    for (int e = 0; e < 4; ++e) { const float pp = swz<2>(y[e]); const float cs = rot ? rt4[tt][e >> 1][2 * (e & 1)] : 1.f, sn = rot ? rt4[tt][e >> 1][2 * (e & 1) + 1] : 0.f;
                        v[e] = y[e] * cs + ((lg & 2) ? pp : -pp) * sn; }
                    if (qk == 0) { u32x2v o; o.x = pkc(v[0] * C32, v[1] * C32); o.y = pkc(v[2] * C32, v[3] * C32); *(u32x2v*)(Q + E_QD + q_off(8, 32, b, gi, qi0 + t) + d0) = o; }
                    else { u32x2v o; o.x = pkc(v[0], v[1]); o.y = pkc(v[2], v[3]); *(LAS u32x2v*)(img + ((gi * 4 + (d0 >> 3)) * 16 + t) * 16 + (d0 & 7) * 2) = o; }
                }
                {   const int h = lane >> 4, dv0 = 4 * (lane & 15), hh = (t >> 2) & 1, j = (t & 3) + 4 * (t >> 3);
                    LAS unsigned short* vp = (LAS unsigned short*)(img + 8192 + ((h * 2 + hh) * 64 + dv0) * 16 + j * 2);
                    vp[0] = (unsigned short)(wvv.x & 0xffff); vp[8] = (unsigned short)(wvv.x >> 16); vp[16] = (unsigned short)(wvv.y & 0xffff); vp[24] = (unsigned short)(wvv.y >> 16); }
            }
            }
            LDS_WAIT(); asm volatile("" ::: "memory");
#pragma unroll
            for (int i = 0; i < 8; ++i) { const int pc = lane + 64 * i; const int gi2 = pc >> 6, ch = (pc >> 4) & 3, t = pc & 15;
                *(GAS v4u*)(Q + E_KD + k_off(8, 32, b, gi2, qi0 + t, 8 * ch)) = *(const LAS v4u*)(img + pc * 16); }
#pragma unroll
            for (int i = 0; i < 8; ++i) { const int pc = lane + 64 * i; const int h = pc >> 7, hh = (pc >> 6) & 1, dv = pc & 63;
                *(GAS v4u*)(Q + E_VD + ((((size_t)(b * 4 + h) * NKT + tile) * 8 + (sidx * 2 + hh)) * 64 + dv) * 8) = *(const LAS v4u*)(img + 8192 + pc * 16); }
        } else if (part == 1) {
            const int h = lane >> 4, d0 = 4 * (lane & 15);
            const float* gq = inp(C, 22) + l * 64 + d0; const float* gk = inp(C, 23) + l * 64 + d0;
            float gqv[4], gkv[4];
#pragma unroll
            for (int e = 0; e < 4; ++e) { gqv[e] = gq[e]; gkv[e] = gk[e]; }
            for (int t0 = 0; t0 < 16; t0 += TB) {
            u32x2v wq4[TB], wk4[TB], wv4[TB];
#pragma unroll
            for (int tt = 0; tt < TB; ++tt) { const bf16* pr = P + (size_t)(R0 + t0 + tt) * NINP; wq4[tt] = *(const u32x2v*)(pr + PC_NQ + 4 * lane); wk4[tt] = *(const u32x2v*)(pr + PC_NK + 4 * lane); wv4[tt] = *(const u32x2v*)(pr + PC_NV + 4 * lane); }
#pragma unroll
            for (int tt = 0; tt < TB; ++tt) {
                const int t = t0 + tt;
                const u32x2v wq = wq4[tt], wk = wk4[tt], wvv = wv4[tt];
#pragma unroll
                for (int qk = 0; qk < 2; ++qk) {
                    const u32x2v w = qk ? wk : wq; float v[4] = {bflo(w.x), bfhi(w.x), bflo(w.y), bfhi(w.y)};
                    float ss = (v[0] * v[0] + v[1] * v[1]) + (v[2] * v[2] + v[3] * v[3]); ss = red_xor<8>(ss);
                    const float rs = rsq_f(ss * (1.f / 64.f) + EPS);
#pragma unroll
                    for (int e = 0; e < 4; ++e) v[e] = v[e] * rs * (qk ? gkv[e] : gqv[e]);
                    if (qk == 0) { u32x2v o; o.x = pkc(v[0] * C64, v[1] * C64); o.y = pkc(v[2] * C64, v[3] * C64); *(u32x2v*)(Q + E_QN + q_off(4, 64, b, h, qi0 + t) + d0) = o; }
                    else { u32x2v o; o.x = pkc(v[0], v[1]); o.y = pkc(v[2], v[3]); *(LAS u32x2v*)(img + ((h * 8 + (d0 >> 3)) * 16 + t) * 16 + (d0 & 7) * 2) = o; }
                }
                {   const int hh = (t >> 2) & 1, j = (t & 3) + 4 * (t >> 3);
                    LAS unsigned short* vp = (LAS unsigned short*)(img + 8192 + ((h * 2 + hh) * 64 + d0) * 16 + j * 2);
                    vp[0] = (unsigned short)(wvv.x & 0xffff); vp[8] = (unsigned short)(wvv.x >> 16); vp[16] = (unsigned short)(wvv.y & 0xffff); vp[24] = (unsigned short)(wvv.y >> 16); }
            }
            }
            LDS_WAIT(); asm volatile("" ::: "memory");
#pragma unroll
            for (int i = 0; i < 8; ++i) { const int pc = lane + 64 * i; const int h2 = pc >> 7, ch = (pc >> 4) & 7, t = pc & 15;
                *(GAS v4u*)(Q + E_KN + k_off(4, 64, b, h2, qi0 + t, 8 * ch)) = *(const LAS v4u*)(img + pc * 16); }
#pragma unroll
            for (int i = 0; i < 8; ++i) { const int pc = lane + 64 * i; const int h2 = pc >> 7, hh = (pc >> 6) & 1, dv = pc & 63;
                *(GAS v4u*)(Q + E_VN + ((((size_t)(b * 4 + h2) * NKT + tile) * 8 + (sidx * 2 + hh)) * 64 + dv) * 8) = *(const LAS v4u*)(img + 8192 + pc * 16); }
        } else {
            const int h = lane >> 4, lh = lane & 15, d0 = 4 * lh;
            const int hk = lane >> 5, ll = lane & 31, dk0 = 2 * ll;
            const int tiq = ((lh & 8) ? 16 : 0) + 4 * (lh & 3), tik = ((ll & 16) ? 16 : 0) + 2 * (ll & 7); const bool rot = pos0 >= 0;
            const float* gq = inp(C, 25) + l * 64 + d0; const float* gk = inp(C, 26) + l * 64 + dk0;
            const float* ga = inp(C, 9) + l * 256 + 4 * lane; const float* gb = inp(C, 11) + l * 128 + 2 * lane;
            float gqv[4], gav[4], gkv[2], gbv[2];
#pragma unroll
            for (int e = 0; e < 4; ++e) { gqv[e] = gq[e]; gav[e] = ga[e]; }
            gkv[0] = gk[0]; gkv[1] = gk[1]; gbv[0] = gb[0]; gbv[1] = gb[1];
            for (int t0 = 0; t0 < 16; t0 += TB) {
            u32x2v wa4[TB], wq4[TB]; unsigned wb4[TB], wk4[TB], wv4[TB]; f32x4 rq4[TB][2], rk4[TB];
#pragma unroll
            for (int tt = 0; tt < TB; ++tt) { const bf16* pr = P + (size_t)(R0 + t0 + tt) * NINP; wa4[tt] = *(const u32x2v*)(pr + PC_CQ + 4 * lane); wq4[tt] = *(const u32x2v*)(pr + PC_GQ + 4 * lane);
                wb4[tt] = *(const unsigned*)(pr + PC_CKV + 2 * lane); wk4[tt] = *(const unsigned*)(pr + PC_GK + 2 * lane); wv4[tt] = *(const unsigned*)(pr + PC_GV + 2 * lane);
                const float* rp = rope64 + (rot ? pos0 + t0 + tt : 0) * 64; rq4[tt][0] = *(const f32x4*)(rp + 2 * tiq); rq4[tt][1] = *(const f32x4*)(rp + 2 * tiq + 4); rk4[tt] = *(const f32x4*)(rp + 2 * tik); }
#pragma unroll
            for (int tt = 0; tt < TB; ++tt) {
                const int t = t0 + tt; const int R = R0 + t;
                const u32x2v wa = wa4[tt], wq = wq4[tt]; const unsigned wb = wb4[tt], wk = wk4[tt], wvv = wv4[tt];
                {   float v[4] = {bflo(wa.x), bfhi(wa.x), bflo(wa.y), bfhi(wa.y)};
                    const float rs = rsq_f(wave_sum((v[0] * v[0] + v[1] * v[1]) + (v[2] * v[2] + v[3] * v[3])) * (1.f / 256.f) + EPS);
                    u32x2v o; o.x = pkc(v[0] * rs * gav[0], v[1] * rs * gav[1]); o.y = pkc(v[2] * rs * gav[2], v[3] * rs * gav[3]);
                    *(u32x2v*)(CQKV + (size_t)R * KMLA + 4 * lane) = o; }
                {   const float v0 = bflo(wb), v1 = bfhi(wb);
                    const float rs = rsq_f(wave_sum(v0 * v0 + v1 * v1) * (1.f / 128.f) + EPS);
                    *(unsigned*)(CQKV + (size_t)R * KMLA + 256 + 2 * lane) = pkc(v0 * rs * gbv[0], v1 * rs * gbv[1]); }
                {   float v[4] = {bflo(wq.x), bfhi(wq.x), bflo(wq.y), bfhi(wq.y)};
                    float ss = (v[0] * v[0] + v[1] * v[1]) + (v[2] * v[2] + v[3] * v[3]); ss = red_xor<8>(ss);
                    const float rs = rsq_f(ss * (1.f / 64.f) + EPS);
                    float y[4];
#pragma unroll
                    for (int e = 0; e < 4; ++e) y[e] = v[e] * rs * gqv[e];
#pragma unroll
                    for (int e = 0; e < 4; ++e) { const float pp = swz<4>(y[e]); const float cs = rot ? rq4[tt][e >> 1][2 * (e & 1)] : 1.f, sn = rot ? rq4[tt][e >> 1][2 * (e & 1) + 1] : 0.f;
                        v[e] = y[e] * cs + ((lh & 4) ? pp : -pp) * sn; }
                    u32x2v o; o.x = pkc(v[0] * C64, v[1] * C64); o.y = pkc(v[2] * C64, v[3] * C64); *(u32x2v*)(Q + E_QG + q_off(4, 64, b, h, qi0 + t) + d0) = o; }
                {   float v[2] = {bflo(wk), bfhi(wk)};
                    float ss = v[0] * v[0] + v[1] * v[1]; ss = red_xor<16>(ss);
                    const float rs = rsq_f(ss * (1.f / 64.f) + EPS);
                    float y[2] = {v[0] * rs * gkv[0], v[1] * rs * gkv[1]};
#pragma unroll
                    for (int e = 0; e < 2; ++e) { const float pp = swz<8>(y[e]); const float cs = rot ? rk4[tt][2 * e] : 1.f, sn = rot ? rk4[tt][2 * e + 1] : 0.f;
                        v[e] = y[e] * cs + ((ll & 8) ? pp : -pp) * sn; }
                    *(LAS unsigned*)(img + ((hk * 8 + (dk0 >> 3)) * 16 + t) * 16 + (dk0 & 7) * 2) = pkc(v[0], v[1]); }
                {   const int hh = (t >> 2) & 1, j = (t & 3) + 4 * (t >> 3);
                    LAS unsigned short* vp = (LAS unsigned short*)(img + 8192 + ((hk * 2 + hh) * 64 + dk0) * 16 + j * 2);
                    vp[0] = (unsigned short)(wvv & 0xffff); vp[8] = (unsigned short)(wvv >> 16); }
            }
            }
            LDS_WAIT(); asm volatile("" ::: "memory");
#pragma unroll
            for (int i = 0; i < 4; ++i) { const int pc = lane + 64 * i; const int h2 = pc >> 7, ch = (pc >> 4) & 7, t = pc & 15;
                *(GAS v4u*)(Q + E_KG + k_off(2, 64, b, h2, qi0 + t, 8 * ch)) = *(const LAS v4u*)(img + pc * 16); }
#pragma unroll
            for (int i = 0; i < 4; ++i) { const int pc = lane + 64 * i; const int h2 = pc >> 7, hh = (pc >> 6) & 1, dv = pc & 63;
                *(GAS v4u*)(Q + E_VG + ((((size_t)(b * 2 + h2) * NKT + tile) * 8 + (sidx * 2 + hh)) * 64 + dv) * 8) = *(const LAS v4u*)(img + 8192 + pc * 16); }
        }
        LDS_WAIT(); asm volatile("" ::: "memory");
    }
}

__device__ __forceinline__ void phase_prep2(const int wv, int l) {
    const Ctx C = make_ctx(wv);
    LAS unsigned char* img = C.lds + C.wave * 16384;
    bf16* Q = ((bf16*)(wsp(C) + WS_QKV));
    const bf16* P = (const bf16*)(wsp(C) + WS_P); const bf16* MLAP = (const bf16*)(wsp(C) + WS_MLAP);
    const float* rope32 = (const float*)(wsp(C) + WS_ROPE32);
    const float C96 = 0.10206207261596575f * LOG2E;
    const int lane = C.lane, h = lane >> 4, c = lane & 15; const bool on = c < 12;
    constexpr int TB = 4;
    for (int item = C.gw; item < 3 * (MT / 16); item += C.NGW) {
        const int pass = item / (MT / 16), g = item % (MT / 16), R0 = 16 * g;
        int b, qi0, pos0; row_info(R0, b, qi0, pos0);
        const int tile = qi0 >> 6, sidx = (qi0 >> 4) & 3;
        if (l == NL - 1 && pass == 0 && pos0 < 0) continue;
        const bool rot = pos0 >= 0;
        if (pass < 2) {
            float gv[8];
            { const float* gp = inp(C, pass ? 14 : 13) + l * 96 + 8 * (on ? c : 0);
#pragma unroll
              for (int e = 0; e < 8; ++e) gv[e] = gp[e]; }
            for (int t0 = 0; t0 < 16; t0 += TB) {
                v4u w4[TB]; f32x4 rt[TB][4];
#pragma unroll
                for (int tt = 0; tt < TB; ++tt) { const size_t R = R0 + t0 + tt;
                    const bf16* src = pass == 0 ? MLAP + R * NMLA + h * 96 + 8 * c : (c < 8 ? MLAP + R * NMLA + 512 + h * 128 + 8 * c : P + R * NINP + PC_KR + 8 * (c - 8));
                    const v4u z = {0u, 0u, 0u, 0u}; w4[tt] = on ? *(const GAS v4u*)src : z;
                    const float* rp = rope32 + ((rot ? pos0 + t0 + tt : 0) * 16 + (c >= 10 ? 8 : 0)) * 2;
#pragma unroll
                    for (int k4 = 0; k4 < 4; ++k4) rt[tt][k4] = *(const f32x4*)(rp + 4 * k4); }
#pragma unroll
                for (int tt = 0; tt < TB; ++tt) {
                    const int t = t0 + tt;
                    float v[8] = {bflo(w4[tt].x), bfhi(w4[tt].x), bflo(w4[tt].y), bfhi(w4[tt].y), bflo(w4[tt].z), bfhi(w4[tt].z), bflo(w4[tt].w), bfhi(w4[tt].w)};
                    float ss = ((v[0] * v[0] + v[1] * v[1]) + (v[2] * v[2] + v[3] * v[3])) + ((v[4] * v[4] + v[5] * v[5]) + (v[6] * v[6] + v[7] * v[7]));
                    ss = red_xor<8>(ss);
                    const float rs = rsq_f(ss * (1.f / 96.f) + EPS);
#pragma unroll
                    for (int e = 0; e < 8; ++e) v[e] = v[e] * rs * gv[e];
#pragma unroll
                    for (int e = 0; e < 8; ++e) { const float pp = swz<1>(v[e]); const bool rr = rot && c >= 8; const float cs = rr ? rt[tt][e >> 1][2 * (e & 1)] : 1.f, sn = rr ? rt[tt][e >> 1][2 * (e & 1) + 1] : 0.f;
                        v[e] = v[e] * cs + ((c & 1) ? pp : -pp) * sn; }
                    if (pass == 0) { v4u o; o.x = pkc(v[0] * C96, v[1] * C96); o.y = pkc(v[2] * C96, v[3] * C96); o.z = pkc(v[4] * C96, v[5] * C96); o.w = pkc(v[6] * C96, v[7] * C96);
                        if (on) *(GAS v4u*)(Q + E_QA + q_off(4, 96, b, h, qi0 + t) + 8 * c) = o; }
                    else { v4u o; o.x = pkc(v[0], v[1]); o.y = pkc(v[2], v[3]); o.z = pkc(v[4], v[5]); o.w = pkc(v[6], v[7]);
                        if (on) *(LAS v4u*)(img + ((h * 12 + c) * 16 + t) * 16) = o; }
                }
            }
            if (pass == 1) {
                LDS_WAIT(); asm volatile("" ::: "memory");
#pragma unroll
                for (int i = 0; i < 12; ++i) { const int pc = lane + 64 * i; const int h2 = pc / 192, ch = (pc >> 4) % 12, t = pc & 15;
                    *(GAS v4u*)(Q + E_KA + k_off(4, 96, b, h2, qi0 + t, 8 * ch)) = *(const LAS v4u*)(img + pc * 16); }
            }
        } else {
            for (int t0 = 0; t0 < 16; t0 += TB) {
                v4u w4[TB];
#pragma unroll
                for (int tt = 0; tt < TB; ++tt) { const size_t R = R0 + t0 + tt; const v4u z = {0u, 0u, 0u, 0u}; w4[tt] = c < 8 ? *(const GAS v4u*)(MLAP + R * NMLA + 512 + h * 128 + 64 + 8 * c) : z; }
#pragma unroll
                for (int tt = 0; tt < TB; ++tt) { const int t = t0 + tt, hh = (t >> 2) & 1, j = (t & 3) + 4 * (t >> 3);
                    LAS unsigned short* vp = (LAS unsigned short*)(img + ((h * 2 + hh) * 64 + 8 * c) * 16 + j * 2);
                    if (c < 8) { vp[0] = (unsigned short)(w4[tt].x & 0xffff); vp[8] = (unsigned short)(w4[tt].x >> 16); vp[16] = (unsigned short)(w4[tt].y & 0xffff); vp[24] = (unsigned short)(w4[tt].y >> 16);
                        vp[32] = (unsigned short)(w4[tt].z & 0xffff); vp[40] = (unsigned short)(w4[tt].z >> 16); vp[48] = (unsigned short)(w4[tt].w & 0xffff); vp[56] = (unsigned short)(w4[tt].w >> 16); } }
            }
            LDS_WAIT(); asm volatile("" ::: "memory");
#pragma unroll
            for (int i = 0; i < 8; ++i) { const int pc = lane + 64 * i; const int h2 = pc >> 7, hh = (pc >> 6) & 1, dv = pc & 63;
                *(GAS v4u*)(Q + E_VA + ((((size_t)(b * 4 + h2) * NKT + tile) * 8 + (sidx * 2 + hh)) * 64 + dv) * 8) = *(const LAS v4u*)(img + pc * 16); }
        }
        LDS_WAIT(); asm volatile("" ::: "memory");
    }
}

template <int DK, int HQ, int HK, int HV, bool NA>
__device__ __forceinline__ void naive_attn_one(const bf16* Qb, const bf16* Kb, const bf16* Vb, const float* rpb, int b, int hq, int hk, int hv, int qi, float (&o)[64]) {
    float q[DK];
    { const bf16* qp = Qb + q_off(HQ, DK, b, hq, qi);
#pragma unroll
      for (int c = 0; c < DK / 8; ++c) { const v4u w = *(const v4u*)(qp + 8 * c); q[8 * c] = bflo(w.x); q[8 * c + 1] = bfhi(w.x); q[8 * c + 2] = bflo(w.y); q[8 * c + 3] = bfhi(w.y); q[8 * c + 4] = bflo(w.z); q[8 * c + 5] = bfhi(w.z); q[8 * c + 6] = bflo(w.w); q[8 * c + 7] = bfhi(w.w); } }
    float m = -1e30f, ls = 0.f;
#pragma unroll
    for (int d = 0; d < 64; ++d) o[d] = 0.f;
    const bool isctx = qi >= SEQ;
    const int r = qi >> 6, qc = qi & 63;
    const int rs0 = min(max(r - 4, 0), 24), ws0 = min(max(qc - 8, 0), 48);
    const int nloc = isctx ? 0 : (NA ? 128 : SEQ);
    const int ntot = nloc + CTXL;
    for (int it = 0; it < ntot; ++it) {
        int key; float bias = 0.f;
        if (it < nloc) {
            if (NA) { const int kr = rs0 + (it >> 4), kc = ws0 + (it & 15); key = kr * 64 + kc; bias = rpb[(kr - r + 7) * 31 + min(max(kc - qc + 15, 0), 30)] * LOG2E; }
            else key = it;
        } else key = SEQ + (it - nloc);
        float s = bias;
#pragma unroll
        for (int c = 0; c < DK / 8; ++c) { const v4u w = *(const v4u*)(Kb + k_off(HK, DK, b, hk, key, 8 * c));
            s += q[8 * c] * bflo(w.x) + q[8 * c + 1] * bfhi(w.x) + q[8 * c + 2] * bflo(w.y) + q[8 * c + 3] * bfhi(w.y) + q[8 * c + 4] * bflo(w.z) + q[8 * c + 5] * bfhi(w.z) + q[8 * c + 6] * bflo(w.w) + q[8 * c + 7] * bfhi(w.w); }
        if (s > m) { const float a = exp2f(m - s); ls *= a;
#pragma unroll
            for (int d = 0; d < 64; ++d) o[d] *= a;
            m = s; }
        const float p = exp2f(s - m); ls += p;
        const bf16* vp = Vb + v_off(HV, b, hv, key, 0);
#pragma unroll
        for (int d = 0; d < 64; ++d) { o[d] += p * bf2f(vp[8 * d]); if ((d & 15) == 15) asm volatile("" ::: "memory"); }
    }
    const float inv = 1.f / ls;
#pragma unroll
    for (int d = 0; d < 64; ++d) o[d] *= inv;
}
__device__ __forceinline__ void store_mix(const Ctx& C, int b, int qi, int col0, const float (&o)[64]) {
    const size_t R = qi < SEQ ? (size_t)b * SEQ + qi : (size_t)ML + b * CTXL + (qi - SEQ);
    bf16* dst = ((bf16*)(wsp(C) + WS_MIX)) + R * DM + col0;
#pragma unroll
    for (int d = 0; d < 64; d += 8) { v4u w; w.x = pkc(o[d], o[d + 1]); w.y = pkc(o[d + 2], o[d + 3]); w.z = pkc(o[d + 4], o[d + 5]); w.w = pkc(o[d + 6], o[d + 7]); *(v4u*)(dst + d) = w; }
}
__device__ __forceinline__ void phase_attn_naive(const int wv, int l) {
    const Ctx C = make_ctx(wv);
    const bf16* Q = ((bf16*)(wsp(C) + WS_QKV));
    const int gt = C.gw * 64 + C.lane, NGT = C.NGW * 64;
    constexpr int PER = NB * 4 * NKEY;
    for (int idx = gt; idx < 5 * PER; idx += NGT) {
        const int mixer = idx < 3 * PER ? idx / PER : 3;
        const int r0 = mixer < 3 ? idx % PER : (idx - 3 * PER) >> 1, pair = idx & 1;
        const int b = r0 / (4 * NKEY), h = (r0 / NKEY) % 4, qi = r0 % NKEY;
        if (l == NL - 1 && qi >= SEQ) continue;
        float o[64];
        if (mixer == 0) { naive_attn_one<96, 4, 4, 4, false>(Q + E_QA, Q + E_KA, Q + E_VA, nullptr, b, h, h, h, qi, o); store_mix(C, b, qi, h * 64, o); }
        else if (mixer == 1) { naive_attn_one<64, 4, 4, 4, true>(Q + E_QN, Q + E_KN, Q + E_VN, inp(C, 24) + (size_t)(l * 4 + h) * 15 * 31, b, h, h, h, qi, o); store_mix(C, b, qi, 512 + h * 64, o); }
        else if (mixer == 2) { naive_attn_one<64, 4, 2, 2, false>(Q + E_QG, Q + E_KG, Q + E_VG, nullptr, b, h, h >> 1, h >> 1, qi, o); store_mix(C, b, qi, 768 + h * 64, o); }
        else {
            naive_attn_one<32, 8, 8, 4, false>(Q + E_QD, Q + E_KD, Q + E_VD, nullptr, b, 2 * h + pair, 2 * h + pair, h, qi, o);
            float s1 = 0.f, s2 = 0.f;
            for (int d = 0; d < 32; ++d) { s1 += inp(C, 17)[l * 32 + d] * inp(C, 18)[l * 32 + d]; s2 += inp(C, 19)[l * 32 + d] * inp(C, 20)[l * 32 + d]; }
            const float li = lambda_init(l), lam = expf(s1) - expf(s2) + li;
            float ss = 0.f;
#pragma unroll
            for (int d = 0; d < 64; ++d) { const float other = swz<1>(o[d]); o[d] = o[d] - lam * other; ss += o[d] * o[d]; }
            const float rs = rsq_f(ss * (1.f / 64.f) + EPS);
#pragma unroll
            for (int d = 0; d < 64; ++d) o[d] = o[d] * rs * inp(C, 21)[l * 64 + d] * (1.f - li);
            if (pair == 0) store_mix(C, b, qi, 256 + h * 64, o);
        }
    }
}

__device__ __forceinline__ void phase_fixup(const int wv, int l) {
    const Ctx C = make_ctx(wv);
    const int gt = C.gw * 64 + C.lane, NGT = C.NGW * 64;
    const float* cw = inp(C, 29) + (size_t)l * 3 * NUP; const float* cb = inp(C, 30) + (size_t)l * NUP;
    for (int idx = gt; idx < 56 * 2 * DFF; idx += NGT) {
        const int j = idx % DFF, w = (idx / DFF) & 1, bi = idx / (2 * DFF), pm = (bi / 7) * 8 + (bi % 7);
        const float* h0 = ((float*)(wsp(C) + WS_HALO)) + (size_t)pm * 4 * NUP; const float* h1 = h0 + 4 * NUP;
        float cva[2];
#pragma unroll
        for (int t = 0; t < 2; ++t) { const int c = t * DFF + j;
            const float up = w == 0 ? h0[2 * NUP + c] : h0[3 * NUP + c], uc = w == 0 ? h0[3 * NUP + c] : h1[c], un = w == 0 ? h1[c] : h1[NUP + c];
            cva[t] = cw[c] * up + cw[NUP + c] * uc + cw[2 * NUP + c] * un + cb[c]; }
        const size_t row = (size_t)pm * 256 + 255 + w;
        ((bf16*)(wsp(C) + WS_ACT))[row * DFF + j] = (bf16)f2bf(pg8::silu1(cva[1]) * cva[0]);
    }
}

namespace att {
typedef float f32x16 __attribute__((ext_vector_type(16)));
typedef __bf16 bf16x2_t __attribute__((ext_vector_type(2)));
__device__ __forceinline__ unsigned cvtpk(float lo, float hi) { f32x2v v = {lo, hi}; bf16x2_t b = __builtin_convertvector(v, bf16x2_t); return __builtin_bit_cast(unsigned, b); }
__device__ __forceinline__ int crow(int r, int hi) { return (r & 3) + 8 * (r >> 2) + 4 * hi; }
constexpr int BUF0 = 0, BUFSZ = 20480, WSC = 4 * BUFSZ  , WSCSZ = 4224, RPB = WSC + 8 * WSCSZ  , RPB_TAB = RPB + 512;
static_assert(RPB_TAB + 15 * 31 * 4 + 1024 <= RING_BYTES, "attention LDS map");

struct UnitDesc { int b, hq0, hk0, hv, q0, t_lo, n_loc, col0; };

template <int DK, int NP, bool NA>
__device__ __forceinline__ void attn_unit(const Ctx& C, const bf16* Qb, int HQ, const bf16* Kb, int HK, const bf16* Vb, int HV, const UnitDesc U, const float Mb,
                                          const float* rpb  , const float lam, const float* subg, const float osc, bf16* MIX) {
    constexpr int KS = DK / 16;
    constexpr int KP = NP * DK * 8;
    constexpr int NLD = (KP + 512 + 511) / 512;
    const int lane = C.lane, wave = C.wave, tid = C.tid, c31 = lane & 31, hi = lane >> 5;
    LAS unsigned char* L = C.lds;
    const int n_it = U.n_loc + 4;
    bf16x8 qf[NP][KS];
    const int qrow = U.q0 + wave * 32 + c31;
#pragma unroll
    for (int p = 0; p < NP; ++p) { const bf16* qp = Qb + q_off(HQ, DK, U.b, U.hq0 + p, qrow) + 8 * hi;
#pragma unroll
        for (int ks = 0; ks < KS; ++ks) qf[p][ks] = *(const bf16x8*)(qp + 16 * ks); }
    int my_lo = 0, my_r = 0;
    if (NA) {
        for (int i = tid; i < 15 * 31; i += 512) ((LAS float*)(L + RPB_TAB))[i] = rpb[i] * LOG2E;
        my_r = (U.q0 >> 6) + (wave >> 1); my_lo = min(max(my_r - 4, 0), 24);
    }
    f32x16 o[NP][2]; float lsum[NP];
#pragma unroll
    for (int p = 0; p < NP; ++p) { lsum[p] = 0.f;
#pragma unroll
        for (int d0 = 0; d0 < 2; ++d0)
#pragma unroll
            for (int r = 0; r < 16; ++r) o[p][d0][r] = 0.f; }
    const float shift = Mb > 40.f ? Mb - 40.f : 0.f;
    constexpr int NI = (KP + 512) / 64;
    auto tile_of = [&](int it) { return it < U.n_loc ? U.t_lo + it : 32 + (it - U.n_loc); };
    const int n_st = (n_it + 1) >> 1;
#define ATT_ISSUE(st) do { _Pragma("unroll") for (int tt_ = 0; tt_ < 2; ++tt_) { const int it_ = 2 * (st) + tt_; if (it_ < n_it) { const int tile_ = tile_of(it_); \
        const unsigned dst_ = (unsigned)(((st) & 1) * 2 + tt_) * BUFSZ; \
        _Pragma("unroll") for (int j_ = 0; j_ < (NI + 7) / 8; ++j_) { const int ji = wave + 8 * j_; if (ji < NI) { const int pi = ji * 64 + lane; const bf16* src; \
            if (ji * 64 < KP) { const int ps = (ji * 64) / (DK * 8), pr = pi - ps * (DK * 8); src = Kb + ((size_t)((U.b * HK + U.hk0 + ps) * NKT + tile_)) * (DK * 64) + pr * 8; } \
            else src = Vb + ((size_t)((U.b * HV + U.hv) * NKT + tile_)) * 4096 + (pi - KP) * 8; \
            __builtin_amdgcn_global_load_lds((const unsigned*)src, (LAS unsigned*)(L + dst_ + ji * 1024), 16, 0, 0); } } } } } while (0)
#define ATT_KLOAD(KF_, KB_) do { _Pragma("unroll") for (int p_ = 0; p_ < NP; ++p_) _Pragma("unroll") for (int ks_ = 0; ks_ < KS; ++ks_) { \
        KF_[p_][2 * ks_] = *(const LAS bf16x8*)((KB_) + p_ * (DK * 128) + (2 * ks_ + hi) * 1024 + c31 * 16); \
        KF_[p_][2 * ks_ + 1] = *(const LAS bf16x8*)((KB_) + p_ * (DK * 128) + (2 * ks_ + hi) * 1024 + 512 + c31 * 16); } } while (0)
#define ATT_TILE(KF_, KB_, TILE_, LOCAL_, PF_) do { \
        const LAS unsigned char* vb_ = (KB_) + KP * 16; bf16x8 vf[8]; \
        _Pragma("unroll") for (int p = 0; p < NP; ++p) { \
            f32x16 p0, p1; \
            _Pragma("unroll") for (int r = 0; r < 16; ++r) { p0[r] = 0.f; p1[r] = 0.f; } \
            __builtin_amdgcn_sched_barrier(0); __builtin_amdgcn_s_setprio(1); \
            _Pragma("unroll") for (int ks = 0; ks < KS; ++ks) { \
                p0 = __builtin_amdgcn_mfma_f32_32x32x16_bf16(KF_[p][2 * ks], qf[p][ks], p0, 0, 0, 0); \
                p1 = __builtin_amdgcn_mfma_f32_32x32x16_bf16(KF_[p][2 * ks + 1], qf[p][ks], p1, 0, 0, 0); } \
            __builtin_amdgcn_s_setprio(0); __builtin_amdgcn_sched_barrier(0); \
            if (p == 0) { _Pragma("unroll") for (int s_ = 0; s_ < 4; ++s_) _Pragma("unroll") for (int d0 = 0; d0 < 2; ++d0) vf[2 * s_ + d0] = *(const LAS bf16x8*)(vb_ + ((2 * s_ + hi) * 64 + 32 * d0 + c31) * 16); } \
            if (p == NP - 1) { PF_; } \
            __builtin_amdgcn_sched_barrier(0); \
            if (shift > 0.f) { _Pragma("unroll") for (int r = 0; r < 16; ++r) { p0[r] -= shift; p1[r] -= shift; } } \
            if (LOCAL_) { \
                const int qc = (wave & 1) * 32 + c31, ws = min(max(qc - 8, 0), 48); \
                const LAS float* bt = (const LAS float*)(L + RPB_TAB) + ((TILE_) - my_r + 7) * 31 + 15 - qc + 4 * hi; \
                const int kb0 = 4 * hi - ws; \
                _Pragma("unroll") for (int r = 0; r < 16; ++r) { const int kc = (r & 3) + 8 * (r >> 2); \
                    const float b0 = bt[kc], b1 = bt[kc + 32]; \
                    p0[r] = ((unsigned)(kc + kb0) < 16u) ? __builtin_amdgcn_exp2f(p0[r] + b0) : 0.f; \
                    p1[r] = ((unsigned)(kc + 32 + kb0) < 16u) ? __builtin_amdgcn_exp2f(p1[r] + b1) : 0.f; } \
            } else { \
                _Pragma("unroll") for (int r = 0; r < 16; ++r) { p0[r] = __builtin_amdgcn_exp2f(p0[r]); p1[r] = __builtin_amdgcn_exp2f(p1[r]); } \
            } \
            float sa = 0.f, sb = 0.f; \
            _Pragma("unroll") for (int r = 0; r < 16; ++r) { sa += p0[r]; sb += p1[r]; } \
            lsum[p] += sa + sb; \
            v4u pa[4]; \
            pa[0].x = cvtpk(p0[0], p0[1]); pa[0].y = cvtpk(p0[2], p0[3]); pa[0].z = cvtpk(p0[4], p0[5]); pa[0].w = cvtpk(p0[6], p0[7]); \
            pa[1].x = cvtpk(p0[8], p0[9]); pa[1].y = cvtpk(p0[10], p0[11]); pa[1].z = cvtpk(p0[12], p0[13]); pa[1].w = cvtpk(p0[14], p0[15]); \
            pa[2].x = cvtpk(p1[0], p1[1]); pa[2].y = cvtpk(p1[2], p1[3]); pa[2].z = cvtpk(p1[4], p1[5]); pa[2].w = cvtpk(p1[6], p1[7]); \
            pa[3].x = cvtpk(p1[8], p1[9]); pa[3].y = cvtpk(p1[10], p1[11]); pa[3].z = cvtpk(p1[12], p1[13]); pa[3].w = cvtpk(p1[14], p1[15]); \
            __builtin_amdgcn_sched_barrier(0); __builtin_amdgcn_s_setprio(1); \
            _Pragma("unroll") for (int s_ = 0; s_ < 4; ++s_) _Pragma("unroll") for (int d0 = 0; d0 < 2; ++d0) \
                o[p][d0] = __builtin_amdgcn_mfma_f32_32x32x16_bf16(__builtin_bit_cast(bf16x8, pa[s_]), vf[2 * s_ + d0], o[p][d0], 0, 0, 0); \
            __builtin_amdgcn_s_setprio(0); __builtin_amdgcn_sched_barrier(0); \
        } } while (0)
    ATT_ISSUE(0);
    asm volatile("s_waitcnt vmcnt(0)" ::: "memory"); __syncthreads();
    bf16x8 kfA[NP][2 * KS], kfB[NP][2 * KS];
    for (int st = 0; st < n_st; ++st) {
        if (st + 1 < n_st) ATT_ISSUE(st + 1);
        const int it0 = 2 * st, it1 = it0 + 1;
        const int tile0 = tile_of(it0), tile1 = tile_of(it1);
        const bool has1 = it1 < n_it;
        const bool loc0 = NA && it0 < U.n_loc, loc1 = NA && it1 < U.n_loc;
        const bool act0 = !loc0 || (tile0 >= my_lo && tile0 < my_lo + 8), act1 = has1 && (!loc1 || (tile1 >= my_lo && tile1 < my_lo + 8));
        const LAS unsigned char* kb0p = L + ((st & 1) * 2) * BUFSZ; const LAS unsigned char* kb1p = kb0p + BUFSZ;
        if (act0) {
            ATT_KLOAD(kfA, kb0p);
            if (NP == 1) { ATT_TILE(kfA, kb0p, tile0, loc0, if (act1) ATT_KLOAD(kfB, kb1p)); }
            else { ATT_TILE(kfA, kb0p, tile0, loc0, (void)0); }
        }
        if (act1) {
            if (NP != 1 || !act0) ATT_KLOAD(kfB, kb1p);
            ATT_TILE(kfB, kb1p, tile1, loc1, (void)0);
        }
        asm volatile("s_waitcnt vmcnt(0)" ::: "memory"); __syncthreads();
    }
#undef ATT_TILE
#undef ATT_KLOAD
#undef ATT_ISSUE
    LAS float* lsc = (LAS float*)(L + WSC + wave * WSCSZ);
    LAS unsigned short* ost = (LAS unsigned short*)(L + WSC + wave * WSCSZ + 128);
#pragma unroll
    for (int p = 0; p < NP; ++p) {
        const float lt = sum32(lsum[p]);
        if (lane < 32) lsc[lane] = 1.f / lt;
        LDS_WAIT(); asm volatile("" ::: "memory");
#pragma unroll
        for (int r = 0; r < 16; ++r) { const float iv = lsc[crow(r, hi)]; o[p][0][r] *= iv; o[p][1][r] *= iv; }
        LDS_WAIT(); asm volatile("" ::: "memory");
        __builtin_amdgcn_sched_barrier(0);
    }
    f32x16 (&res)[2] = o[0];
    if (NP == 2) {
        const float g0 = subg[c31] * osc, g1 = subg[32 + c31] * osc;
#pragma unroll
        for (int r = 0; r < 16; ++r) { res[0][r] -= lam * o[NP - 1][0][r]; res[1][r] -= lam * o[NP - 1][1][r];
            float ss = res[0][r] * res[0][r] + res[1][r] * res[1][r];
            ss += swz<1>(ss); ss += swz<2>(ss); ss += swz<4>(ss); ss += swz<8>(ss); ss += swz<16>(ss);
            const float rs = rsq_f(ss * (1.f / 64.f) + EPS); res[0][r] *= rs * g0; res[1][r] *= rs * g1; }
    }
#pragma unroll
    for (int r = 0; r < 16; ++r)
#pragma unroll
        for (int d0 = 0; d0 < 2; ++d0) ost[crow(r, hi) * 64 + d0 * 32 + c31] = (unsigned short)pkc1(res[d0][r]);
    LDS_WAIT(); asm volatile("" ::: "memory");
    {
        const int qw = U.q0 + wave * 32;
        const size_t R0 = qw < SEQ ? (size_t)U.b * SEQ + qw : (size_t)ML + U.b * CTXL + (qw - SEQ);
#pragma unroll
        for (int i = 0; i < 4; ++i) { const int row = i * 8 + (lane >> 3), ch = lane & 7;
            const v4u v = *(const LAS v4u*)(ost + row * 64 + ch * 8);
            *(GAS v4u*)(MIX + (R0 + row) * DM + U.col0 + ch * 8) = v; }
    }
    LDS_WAIT(); asm volatile("" ::: "memory");
    __syncthreads();
}
}

__device__ __forceinline__ float maxabs_n(const float* g, int n, int lane) { float m = 0.f; for (int i = lane; i < n; i += 64) m = fmaxf(m, fabsf(g[i]));
    m = fmaxf(m, swz<1>(m)); m = fmaxf(m, swz<2>(m)); m = fmaxf(m, swz<4>(m)); m = fmaxf(m, swz<8>(m)); m = fmaxf(m, swz<16>(m)); return max32(m); }

template <int TY>
__device__ __forceinline__ void phase_attn_ty(const int wv, int l) {
    const Ctx C = make_ctx(wv);
    const bf16* Q = ((const bf16*)(wsp(C) + WS_QKV)); bf16* MIX = (bf16*)(wsp(C) + WS_MIX);
    const int NUT = (l == NL - 1) ? 256 : 384;
    const int vcu = C.gw >> 3;
    float Mb, lam = 0.f, osc = 1.f; const float* subg = nullptr;
    if (TY == 0) { Mb = LOG2E * 5.656854249492381f * maxabs_n(inp(C, 15) + l * 32, 32, C.lane) * maxabs_n(inp(C, 16) + l * 32, 32, C.lane);
        float s1 = 0.f, s2 = 0.f;
        for (int d = 0; d < 32; ++d) { s1 += inp(C, 17)[l * 32 + d] * inp(C, 18)[l * 32 + d]; s2 += inp(C, 19)[l * 32 + d] * inp(C, 20)[l * 32 + d]; }
        const float li = lambda_init(l); lam = expf(s1) - expf(s2) + li; osc = 1.f - li; subg = inp(C, 21) + l * 64; }
    else if (TY == 1) Mb = LOG2E * 9.797958971132712f * maxabs_n(inp(C, 13) + l * 96, 96, C.lane) * maxabs_n(inp(C, 14) + l * 96, 96, C.lane);
    else if (TY == 2) Mb = LOG2E * 8.f * maxabs_n(inp(C, 25) + l * 64, 64, C.lane) * maxabs_n(inp(C, 26) + l * 64, 64, C.lane);
    else Mb = LOG2E * 8.f * maxabs_n(inp(C, 22) + l * 64, 64, C.lane) * maxabs_n(inp(C, 23) + l * 64, 64, C.lane) + LOG2E * maxabs_n(inp(C, 24) + (size_t)l * 4 * 15 * 31, 4 * 15 * 31, C.lane);
    Mb = __uint_as_float(__builtin_amdgcn_readfirstlane(__float_as_uint(Mb)));
    for (int uu = vcu; uu < NUT; uu += C.G) {
        att::UnitDesc U; int h;
        if (uu < 256) { h = (uu >> 3) & 3; U.b = uu >> 5; U.q0 = (uu & 7) * 256; U.t_lo = 0; U.n_loc = 32; }
        else { const int i_ = uu - 256; if ((i_ >> 5) != TY) continue; h = i_ & 3; U.b = (i_ >> 2) & 7; U.q0 = SEQ; U.t_lo = 32; U.n_loc = 0; }
        if (TY == 0) { U.hq0 = 2 * h; U.hk0 = 2 * h; U.hv = h; U.col0 = 256 + 64 * h; att::attn_unit<32, 2, false>(C, Q + E_QD, 8, Q + E_KD, 8, Q + E_VD, 4, U, Mb, nullptr, lam, subg, osc, MIX); }
        else if (TY == 1) { U.hq0 = h; U.hk0 = h; U.hv = h; U.col0 = 64 * h; att::attn_unit<96, 1, false>(C, Q + E_QA, 4, Q + E_KA, 4, Q + E_VA, 4, U, Mb, nullptr, 0.f, nullptr, 1.f, MIX); }
        else if (TY == 2) { U.hq0 = h; U.hk0 = h >> 1; U.hv = h >> 1; U.col0 = 768 + 64 * h; att::attn_unit<64, 1, false>(C, Q + E_QG, 4, Q + E_KG, 2, Q + E_VG, 2, U, Mb, nullptr, 0.f, nullptr, 1.f, MIX); }
        else { if (uu < 256) { const int r0 = U.q0 >> 6; U.t_lo = min(max(r0 - 4, 0), 24); U.n_loc = min(max(r0 - 1, 0), 24) + 8 - U.t_lo; }
            U.hq0 = h; U.hk0 = h; U.hv = h; U.col0 = 512 + 64 * h; att::attn_unit<64, 1, true>(C, Q + E_QN, 4, Q + E_KN, 4, Q + E_VN, 4, U, Mb, inp(C, 24) + (size_t)(l * 4 + h) * 15 * 31, 0.f, nullptr, 1.f, MIX); }
    }
}
__device__ __forceinline__ void phase_attn(const int wv, int l) { phase_attn_ty<0>(wv, l); phase_attn_ty<1>(wv, l); phase_attn_ty<2>(wv, l); phase_attn_ty<3>(wv, l); }

#ifndef ATTN_NAIVE
#define ATTN_NAIVE 0
#endif
#ifndef PROBE_REP_S
#define PROBE_REP_S -1
#endif
#ifndef MK_PER_PHASE
#define MK_PER_PHASE 0
#endif
constexpr int PH_PRO = 0, PH_NORM0 = 1, PH_L0 = 2, PH_PER_LAYER = 11 + (PROBE_REP_S >= 0 ? 1 : 0);
constexpr int N_PHASES = PH_L0 + NL * PH_PER_LAYER - 1;
struct Args { const float* in[32]; float* out; unsigned char* ws; int ph_lo, ph_hi; };

__global__ void __launch_bounds__(NWAVES * 64, 2) fwd_kernel(Args args) {
    const int wv = __builtin_amdgcn_readfirstlane((int)threadIdx.x >> 6);
    const Ctx C = make_ctx(wv);
    for (int u = C.tid; u < 1024 / 4; u += NWAVES * 64) ((LAS unsigned*)(C.lds + LDSCTL_OFF))[u] = 0u;
    __syncthreads();
    if (C.tid < 34) ((LAS unsigned long long*)(C.lds + PT_OFF))[C.tid] = ((const __attribute__((address_space(4))) unsigned long long*)__builtin_amdgcn_kernarg_segment_ptr())[C.tid];
    volatile LAS unsigned* MISC = (volatile LAS unsigned*)(C.lds + MISC_OFF);
    __syncthreads();
    gu32* ctl = (gu32*)(wsp(C) + WS_CTL);
    XcdBarrier bar; bar.bar = (unsigned*)(ctl + CW_BAR); bar.x = 0; bar.st = nullptr; bar.wv = wv;
    const bool multi = (args.ph_hi - args.ph_lo) > 1;
    if (multi) { bar = xcd_barrier_post((unsigned*)(ctl + CW_BAR), MISC + 8); bar.wv = wv; }

    for (int ph = args.ph_lo; ph < args.ph_hi; ++ph) {
        const Ctx C = make_ctx(wv);
        if (ph == PH_PRO) phase_prologue(wv);
        else if (ph == PH_NORM0) phase_norm(wv, 0, 1, MT);
        else {
            const int l = (ph - PH_L0) / PH_PER_LAYER, s_raw = (ph - PH_L0) % PH_PER_LAYER, s = (PROBE_REP_S >= 0 && s_raw > PROBE_REP_S) ? s_raw - 1 : s_raw;
            const int Mrows = (l == NL - 1) ? ML : MT;
            {
            if (s == 0 || s == 2) {
                const bool mla = s == 2;
                pg8::Gemm g{mla ? (bf16*)(wsp(C) + WS_CQKV) : (bf16*)(wsp(C) + WS_XN), wptr(C, l, mla ? W_MLA : W_IN), MT, mla ? NMLA : NINP, mla ? KMLA : DM}; pg8::StaticOrder S; S.init(MT, mla ? NMLA : NINP, C.G, (int)blockIdx.x);
                pg8::EpiBf16<0> E{mla ? (bf16*)(wsp(C) + WS_MLAP) : (bf16*)(wsp(C) + WS_P), mla ? NMLA : NINP, nullptr, 0, 0, 1.f};
                pg8::gemm_phase<pg8::EpiBf16<0>, pg8::StaticOrder, true, true>(C.lds + RING_OFF, g, S, E, C.wave);
            } else if (s == 1) phase_prep1(wv, l);
            else if (s == 3) phase_prep2(wv, l);
#if ATTN_NAIVE
            else if (s == 4) phase_attn_naive(wv, l);
#else
            else if (s == 4) phase_attn(wv, l);
#endif
            else if (s == 5 || s == 9) {
                const bool dn = s == 9;
                pg8::Gemm g{dn ? (bf16*)(wsp(C) + WS_ACT) : (bf16*)(wsp(C) + WS_MIX), wptr(C, l, dn ? W_DOWN : W_OUT), Mrows, DM, dn ? DFF : DM}; pg8::StaticOrder S; S.init(Mrows, DM, C.G, (int)blockIdx.x);
                const bool first = (l == 0 && !dn);
                pg8::EpiResGate E{first ? inp(C, 0) : outp(C), first ? inp(C, 2) : (float*)(wsp(C) + WS_XC), outp(C), (float*)(wsp(C) + WS_XC), (float*)(wsp(C) + WS_MODS) + (size_t)l * 9 * 6144 + (dn ? 5120 : 2048)};
                pg8::gemm_phase<pg8::EpiResGate, pg8::StaticOrder, true, true>(C.lds + RING_OFF, g, S, E, C.wave);
            } else if (s == 6) phase_norm(wv, l, 2, Mrows);
            else if (s == 7) {
                pg8::Gemm g{(bf16*)(wsp(C) + WS_XN), wptr(C, l, W_UP), Mrows, NUP, DM}; pg8::StaticOrder S; S.init(Mrows, NUP, C.G, (int)blockIdx.x);
                pg8::EpiConvGate E{(bf16*)(wsp(C) + WS_ACT), (float*)(wsp(C) + WS_HALO), inp(C, 29) + (size_t)l * 3 * NUP, inp(C, 30) + (size_t)l * NUP, (PG8_LAS float*)(C.lds + EX_OFF)};
                pg8::gemm_phase<pg8::EpiConvGate, pg8::StaticOrder, true, true>(C.lds + RING_OFF, g, S, E, C.wave);
            } else if (s == 8) phase_fixup(wv, l);
            else phase_norm(wv, l + 1, 1, MT);
            }
        }
        if (ph + 1 < args.ph_hi) { XcdBarrier bb = bar; asm volatile("" : "+s"(bb.bar), "+s"(bb.x)); xcd_barrier(bb); }
    }
}

extern "C" void kernel_launch(void* const* d_in, const int* in_sizes, int n_in, void* d_out, int out_size, void* d_ws, size_t ws_size, hipStream_t stream) {
    static int grid = 0;
    if (grid == 0) {
        if (n_in != 32 || out_size != ML * DM || ws_size < WS_END) { fprintf(stderr, "kernel_launch: unexpected shapes (n_in %d out %d ws %zu)\n", n_in, out_size, ws_size); grid = -1; return; }
        int dev = 0, cus = 0;
        if (hipGetDevice(&dev) != hipSuccess || hipDeviceGetAttribute(&cus, hipDeviceAttributeMultiprocessorCount, dev) != hipSuccess) { grid = -1; return; }
        if (hipFuncSetAttribute((const void*)fwd_kernel, hipFuncAttributeMaxDynamicSharedMemorySize, LDS_BYTES) != hipSuccess) { fprintf(stderr, "kernel_launch: hipFuncSetAttribute failed\n"); grid = -1; return; }
        (void)hipGetLastError();
        grid = cus;
    }
    if (grid < 0) return;
    (void)hipMemsetAsync((char*)d_ws + WS_CTL, 0, CTL_ZERO_BYTES, stream);
    Args a{};
    for (int i = 0; i < 32; ++i) a.in[i] = (const float*)d_in[i];
    a.out = (float*)d_out; a.ws = (unsigned char*)d_ws;
#if MK_PER_PHASE
    for (int ph = 0; ph < N_PHASES; ++ph) { a.ph_lo = ph; a.ph_hi = ph + 1; hipLaunchKernelGGL(fwd_kernel, dim3(grid), dim3(NWAVES * 64), LDS_BYTES, stream, a); }
#else
    a.ph_lo = 0; a.ph_hi = N_PHASES; hipLaunchKernelGGL(fwd_kernel, dim3(grid), dim3(NWAVES * 64), LDS_BYTES, stream, a);
#endif
}
```

```cpp
#include <hip/hip_runtime.h>
#include <cstdio>
#include <cstdint>
__device__ __forceinline__ int otid(int wv) { int l; asm volatile("v_mbcnt_lo_u32_b32 %0, -1, 0\n\tv_mbcnt_hi_u32_b32 %0, -1, %0" : "=v"(l)); return wv * 64 + l; }
namespace pg8 {
#define PG8_LAS __attribute__((address_space(3)))
typedef unsigned short bf16_t;
typedef short bf16x8 __attribute__((ext_vector_type(8)));
typedef float f32x4 __attribute__((ext_vector_type(4)));
typedef unsigned u32x4 __attribute__((ext_vector_type(4)));
constexpr int BM = 256, BK = 64, HALF = 128, HTB = HALF * BK * 2  , STAGE_BYTES = 8 * HTB, NXCD = 8, WGM = 8;

__host__ __device__ __forceinline__ int lds_byte(int r, int c) { const int st = (r >> 4) * 2 + (c >> 5), rr = r & 15, cc = c & 31, ob = rr * 64 + cc * 2; return st * 1024 + (ob ^ (((ob >> 9) & 1) << 5)); }
__host__ __device__ __forceinline__ void stage_rc(int b, int& R, int& C) { const int st = b / 1024, sb = b % 1024, swz = sb ^ (((sb >> 9) & 1) << 5); R = (st >> 1) * 16 + swz / 64; C = (st & 1) * 32 + (swz % 64) / 2; }
__host__ __device__ __forceinline__ int perm32(int rho) { const int n = rho >> 4, i = rho & 15; return 8 * (i >> 2) + 4 * n + (i & 3); }

struct Unit { int pm, pn, kb, nt, sp; };
struct Gemm { const bf16_t* A; const bf16_t* Bt; int M, N, K; };

struct StaticOrder {
    int nM, nN, nwg, G, c;
    __host__ __device__ void init(int M, int N, int G_, int c_) { nM = M / BM; nN = N / BM; nwg = nM * nN; G = G_; c = c_; }
    __host__ __device__ __forceinline__ bool next(int i, Unit& u) const {
        const long L = (long)i * G + c; if (L >= nwg) { u.pm = 0; u.pn = 0; u.kb = 0; u.nt = 0; u.sp = 0; return false; }
        int wgid = (int)L; { const int q = nwg / NXCD, r = nwg % NXCD, xcd = wgid % NXCD, off = wgid / NXCD; wgid = (xcd < r ? xcd * (q + 1) : r * (q + 1) + (xcd - r) * q) + off; }
        const int nig = WGM * nN, gid = wgid / nig, fm = gid * WGM, gsz = (nM - fm) < WGM ? (nM - fm) : WGM;
        u.pm = fm + ((wgid % nig) % gsz); u.pn = (wgid % nig) / gsz; u.kb = 0; u.nt = 0; u.sp = 0; return true;
    }
    __device__ __forceinline__ void a_ready(const Unit&) const {}
    __device__ __forceinline__ void done(const Unit&) const {}
};

__device__ __forceinline__ unsigned cvt_pk_bf16(float lo, float hi) { unsigned r; asm volatile("v_cvt_pk_bf16_f32 %0, %1, %2" : "=v"(r) : "v"(lo), "v"(hi)); return r; }
typedef float f32x2 __attribute__((ext_vector_type(2)));
__device__ __forceinline__ f32x2 gelu_pk(f32x2 v) {
    const f32x2 av = __builtin_elementwise_abs(v), d = av * 0.2316418882f + 1.0f;
    f32x2 t; t.x = __builtin_amdgcn_rcpf(d.x); t.y = __builtin_amdgcn_rcpf(d.y);
    f32x2 q = t * 0.5307027145f + (-0.7265760135f); q = q * t + 0.7107068705f; q = q * t + (-0.142248368f); q = q * t + 0.127414796f; q = q * t;
    const f32x2 s = (v * v) * (-0.72134752044f);
    f32x2 e; e.x = __builtin_amdgcn_exp2f(s.x); e.y = __builtin_amdgcn_exp2f(s.y);
    const f32x2 m = v * (q * e), r = v - m;
    f32x2 o; o.x = v.x < 0.f ? m.x : r.x; o.y = v.y < 0.f ? m.y : r.y; return o;
}

template <int ACT  > struct EpiBf16 {
    static constexpr bool PERM = true, AFTER_DRAIN = false; static_assert(ACT == 0 || ACT == 1, "EpiBf16: ACT is 0 (none) or 1 (gelu_pk)");
    bf16_t* O; int ldc; const float* bias; int split_cols; size_t split_stride; float scale0;
    __device__ __forceinline__ void operator()(const f32x4 (&acc)[2][2][4][2], const Unit& u, int wr, int wc, int fr, int fq) const {
        const int row0 = u.pm * BM + wr * 64 + fr; int colt = u.pn * BM; bf16_t* base = O;
        float sc = 1.f; if (split_cols) { const int t = colt / split_cols; base += (size_t)t * split_stride; colt -= t * split_cols; if (t == 0) sc = scale0; }
        const int col0 = colt + wc * 32 + 8 * fq, bcol0 = u.pn * BM + wc * 32 + 8 * fq;
        f32x4 bv[2][2];
#pragma unroll
        for (int bj = 0; bj < 2; ++bj)
#pragma unroll
            for (int n = 0; n < 2; ++n) bv[bj][n] = bias ? *(const f32x4*)(bias + bcol0 + bj * HALF + 4 * n) : (f32x4){0.f, 0.f, 0.f, 0.f};
#pragma unroll
        for (int ai = 0; ai < 2; ++ai)
#pragma unroll
            for (int m = 0; m < 4; ++m) { bf16_t* rowp = base + (size_t)(row0 + ai * HALF + m * 16) * ldc + col0;
#pragma unroll
                for (int bj = 0; bj < 2; ++bj) { f32x4 v0 = acc[ai][bj][m][0] + bv[bj][0], v1 = acc[ai][bj][m][1] + bv[bj][1];
                    if (ACT == 1) { f32x2 a = gelu_pk((f32x2){v0[0], v0[1]}), b = gelu_pk((f32x2){v0[2], v0[3]}), c = gelu_pk((f32x2){v1[0], v1[1]}), d = gelu_pk((f32x2){v1[2], v1[3]});
                        v0 = (f32x4){a.x, a.y, b.x, b.y}; v1 = (f32x4){c.x, c.y, d.x, d.y}; }
                    v0 = v0 * sc; v1 = v1 * sc; u32x4 w; w.x = cvt_pk_bf16(v0[0], v0[1]); w.y = cvt_pk_bf16(v0[2], v0[3]); w.z = cvt_pk_bf16(v1[0], v1[1]); w.w = cvt_pk_bf16(v1[2], v1[3]);
                    *(u32x4*)(rowp + bj * HALF) = w; } }
    }
};

struct PanelStats {
    unsigned* xbuf;
    unsigned* cnt;
    unsigned* tmo;
    int ntn; float eps;
    unsigned code;
    __device__ __forceinline__ bool run(const f32x4 (&v)[2][2][4][2], const Unit& u, int wr, int wc, int fr, int fq, PG8_LAS unsigned char* lds, int wid, int lane) const {
        typedef float f32x2v __attribute__((ext_vector_type(2)));
        PG8_LAS f32x2v* P = (PG8_LAS f32x2v*)lds;
        PG8_LAS f32x2v* S = (PG8_LAS f32x2v*)(lds + 8192);
        PG8_LAS unsigned* flag = (PG8_LAS unsigned*)(lds + 8192 + 2048);
#pragma unroll
        for (int ai = 0; ai < 2; ++ai)
#pragma unroll
            for (int m = 0; m < 4; ++m) {
                float s = 0.f;
#pragma unroll
                for (int bj = 0; bj < 2; ++bj)
#pragma unroll
                    for (int n = 0; n < 2; ++n) { const f32x4 x = v[ai][bj][m][n]; s += (x[0] + x[1]) + (x[2] + x[3]); }
                s += __shfl_xor(s, 16); s += __shfl_xor(s, 32);
                const float mw = s * (1.0f / 64.0f); float q = 0.f;
#pragma unroll
                for (int bj = 0; bj < 2; ++bj)
#pragma unroll
                    for (int n = 0; n < 2; ++n) { const f32x4 d = v[ai][bj][m][n] - mw; q += (d[0] * d[0] + d[1] * d[1]) + (d[2] * d[2] + d[3] * d[3]); }
                q += __shfl_xor(q, 16); q += __shfl_xor(q, 32);
                if (fq == 0) P[(ai * HALF + wr * 64 + m * 16 + fr) * 4 + wc] = (f32x2v){mw, q};
            }
        asm volatile("s_waitcnt lgkmcnt(0)" ::: "memory"); __builtin_amdgcn_s_barrier(); asm volatile("" ::: "memory");
#if defined(BROKEN_EXCHANGE_NO_WAIT)
#warning BROKEN CONTROL BUILD: the row-statistics exchange does not wait; results are wrong by design
        if (blockIdx.x >= 64) { const long long t0_ = clock64(); while (clock64() - t0_ < 60000) __builtin_amdgcn_s_sleep(8); }
#endif
        const int row = wid * 32 + (lane & 31);
        if (lane < 32) {
            const f32x2v a = P[row * 4 + 0], b = P[row * 4 + 1], c = P[row * 4 + 2], d = P[row * 4 + 3];
            const float mt = (a.x + b.x + c.x + d.x) * 0.25f;
            const float da = a.x - mt, db = b.x - mt, dc = c.x - mt, dd = d.x - mt;
            const float m2 = (a.y + b.y) + (c.y + d.y) + 64.0f * ((da * da + db * db) + (dc * dc + dd * dd));
            unsigned long long* slot = (unsigned long long*)xbuf + ((size_t)(u.pm * BM + row) * 4 + u.pn);
            __hip_atomic_store(slot, ((unsigned long long)__float_as_uint(m2) << 32) | __float_as_uint(mt), __ATOMIC_RELAXED, __HIP_MEMORY_SCOPE_AGENT);
        }
        asm volatile("s_waitcnt vmcnt(0)" ::: "memory");
        if (lane == 0) __hip_atomic_fetch_add(cnt + 64 * u.pm, 1u, __ATOMIC_RELAXED, __HIP_MEMORY_SCOPE_AGENT);
        if (wid == 0) {
            bool dead = false; const unsigned long long t0 = __builtin_amdgcn_s_memrealtime(); const unsigned want = 8u * (unsigned)ntn;
            for (;;) {
#if defined(BROKEN_EXCHANGE_NO_WAIT)
                break;
#endif
                if ((unsigned)__builtin_amdgcn_readfirstlane(__hip_atomic_load(cnt + 64 * u.pm, __ATOMIC_RELAXED, __HIP_MEMORY_SCOPE_AGENT)) >= want) break;
                if (__builtin_amdgcn_s_memrealtime() - t0 > 2000000ull) {
                    if (lane == 0) { unsigned expect = 0u; __hip_atomic_compare_exchange_strong(tmo + 1, &expect, code | (unsigned)(u.pm & 0xff), __ATOMIC_RELAXED, __ATOMIC_RELAXED, __HIP_MEMORY_SCOPE_AGENT);
                                     __hip_atomic_store(tmo, 1u, __ATOMIC_RELAXED, __HIP_MEMORY_SCOPE_AGENT); }
                    dead = true; break; }
                __builtin_amdgcn_s_sleep(2);
            }
            __builtin_amdgcn_fence(__ATOMIC_ACQUIRE, "agent");
            if (lane == 0) flag[0] = dead ? 1u : 0u;
        }
        asm volatile("s_waitcnt vmcnt(0) lgkmcnt(0)" ::: "memory"); __builtin_amdgcn_s_barrier(); asm volatile("" ::: "memory");
        const bool bad = flag[0] != 0u;
        if (lane < 32) {
            const unsigned long long* slot = (const unsigned long long*)xbuf + (size_t)(u.pm * BM + row) * 4; float mt[4], m2[4]; float ms = 0.f;
#pragma unroll
            for (int t = 0; t < 4; ++t) { if (t < ntn) { const unsigned long long w = __hip_atomic_load(slot + t, __ATOMIC_RELAXED, __HIP_MEMORY_SCOPE_AGENT); mt[t] = __uint_as_float((unsigned)w); m2[t] = __uint_as_float((unsigned)(w >> 32)); } else { mt[t] = 0.f; m2[t] = 0.f; } ms += mt[t]; }
            const float mean = ms / (float)ntn; float q = 0.f;
#pragma unroll
            for (int t = 0; t < 4; ++t) if (t < ntn) { const float dm = mt[t] - mean; q += m2[t] + 256.0f * dm * dm; }
            S[row] = (f32x2v){mean, 1.0f / sqrtf(q / (256.0f * (float)ntn) + eps)};
        }
        asm volatile("s_waitcnt lgkmcnt(0)" ::: "memory"); __builtin_amdgcn_s_barrier(); asm volatile("" ::: "memory");
        return bad;
    }
};
struct EpiLnRes {
    static constexpr bool PERM = false, AFTER_DRAIN = true;
    const float* base; float* out; int ldc; const float* bias; PanelStats st; unsigned poison;
    __device__ __forceinline__ void fused(f32x4 (&acc)[2][2][4][2], const Unit& u, int wr, int wc, int fr, int fq, PG8_LAS unsigned char* lds, int wid, int lane) const {
        typedef float f32x2v __attribute__((ext_vector_type(2)));
        const PG8_LAS f32x2v* S = (const PG8_LAS f32x2v*)(lds + 8192);
        const int col0 = u.pn * BM + wc * 32 + 4 * fq;
#pragma unroll
        for (int bj = 0; bj < 2; ++bj)
#pragma unroll
            for (int n = 0; n < 2; ++n) { const f32x4 bv = bias ? *(const f32x4*)(bias + col0 + bj * HALF + n * 16) : (f32x4){0.f, 0.f, 0.f, 0.f};
#pragma unroll
                for (int ai = 0; ai < 2; ++ai)
#pragma unroll
                    for (int m = 0; m < 4; ++m) acc[ai][bj][m][n] += bv; }
        f32x4 pre[4][2][2];
#pragma unroll
        for (int m = 0; m < 4; ++m) { const size_t off = (size_t)(u.pm * BM + wr * 64 + m * 16 + fr) * ldc + col0;
#pragma unroll
            for (int bj = 0; bj < 2; ++bj)
#pragma unroll
                for (int n = 0; n < 2; ++n) pre[m][bj][n] = *(const f32x4*)(base + off + bj * HALF + n * 16); }
        const bool bad = st.run(acc, u, wr, wc, fr, fq, lds, wid, lane) || poison != 0u;
        const float qnan = __builtin_nanf("");
#pragma unroll
        for (int ai = 0; ai < 2; ++ai)
#pragma unroll
            for (int m = 0; m < 4; ++m) { const int r = ai * HALF + wr * 64 + m * 16 + fr; const f32x2v sr = S[r]; const size_t off = (size_t)(u.pm * BM + r) * ldc + col0;
#pragma unroll
                for (int bj = 0; bj < 2; ++bj)
#pragma unroll
                    for (int n = 0; n < 2; ++n) { const f32x4 bs = ai == 0 ? pre[m][bj][n] : *(const f32x4*)(base + off + bj * HALF + n * 16); f32x4 o = bs + (acc[ai][bj][m][n] - sr.x) * sr.y;
                        if (bad) o = (f32x4){qnan, qnan, qnan, qnan}; *(f32x4*)(out + off + bj * HALF + n * 16) = o; }
                if (m & 1) asm volatile("" ::: "memory"); }
    }
};
struct EpiLnResLn {
    static constexpr bool PERM = false, AFTER_DRAIN = true;
    const float* base; float* out; bf16_t* xn; int ldc; const float* bias; PanelStats st1, st2; unsigned poison;
    __device__ __forceinline__ void fused(f32x4 (&acc)[2][2][4][2], const Unit& u, int wr, int wc, int fr, int fq, PG8_LAS unsigned char* lds, int wid, int lane) const {
        typedef float f32x2v __attribute__((ext_vector_type(2))); typedef unsigned u32x2v __attribute__((ext_vector_type(2)));
        const PG8_LAS f32x2v* S = (const PG8_LAS f32x2v*)(lds + 8192);
        const int col0 = u.pn * BM + wc * 32 + 4 * fq;
#pragma unroll
        for (int bj = 0; bj < 2; ++bj)
#pragma unroll
            for (int n = 0; n < 2; ++n) { const f32x4 bv = bias ? *(const f32x4*)(bias + col0 + bj * HALF + n * 16) : (f32x4){0.f, 0.f, 0.f, 0.f};
#pragma unroll
                for (int ai = 0; ai < 2; ++ai)
#pragma unroll
                    for (int m = 0; m < 4; ++m) acc[ai][bj][m][n] += bv; }
        bool bad = st1.run(acc, u, wr, wc, fr, fq, lds, wid, lane) || poison != 0u;
        const float qnan = __builtin_nanf("");
#pragma unroll
        for (int ai = 0; ai < 2; ++ai)
#pragma unroll
            for (int m = 0; m < 4; ++m) { const int r = ai * HALF + wr * 64 + m * 16 + fr; const f32x2v sr = S[r]; const size_t off = (size_t)(u.pm * BM + r) * ldc + col0;
#pragma unroll
                for (int bj = 0; bj < 2; ++bj)
#pragma unroll
                    for (int n = 0; n < 2; ++n) { const f32x4 bs = *(const f32x4*)(base + off + bj * HALF + n * 16); acc[ai][bj][m][n] = bs + (acc[ai][bj][m][n] - sr.x) * sr.y; }
                asm volatile("" : "+v"(acc[ai][0][m][0]), "+v"(acc[ai][0][m][1]), "+v"(acc[ai][1][m][0]), "+v"(acc[ai][1][m][1]));
                if (m & 1) asm volatile("" ::: "memory"); }
        const bool bad1 = bad;
        bad = st2.run(acc, u, wr, wc, fr, fq, lds, wid, lane) || bad;
#pragma unroll
        for (int ai = 0; ai < 2; ++ai)
#pragma unroll
            for (int m = 0; m < 4; ++m) { const int r = ai * HALF + wr * 64 + m * 16 + fr; const f32x2v sr = S[r]; const size_t off = (size_t)(u.pm * BM + r) * ldc + col0;
#pragma unroll
                for (int bj = 0; bj < 2; ++bj)
#pragma unroll
                    for (int n = 0; n < 2; ++n) { const f32x4 x1 = acc[ai][bj][m][n]; *(f32x4*)(out + off + bj * HALF + n * 16) = bad1 ? (f32x4){qnan, qnan, qnan, qnan} : x1;
                        const f32x4 o = (x1 - sr.x) * sr.y; u32x2v w; w.x = cvt_pk_bf16(o[0], o[1]); w.y = cvt_pk_bf16(o[2], o[3]);
                        if (bad) { w.x = 0x7fc07fc0u; w.y = 0x7fc07fc0u; } *(u32x2v*)(xn + off + bj * HALF + n * 16) = w; }
                asm volatile("" ::: "memory"); }
    }
};

template <class Epi, class Sched, bool ALIGN_EPI = false, bool SP2 = false>
__device__ __forceinline__ void gemm_phase(PG8_LAS unsigned char* lds, const Gemm g, const Sched& S, const Epi& E, const int wv) {
    const int tid = otid(wv), wid = __builtin_amdgcn_readfirstlane(tid >> 6), lane = tid & 63, wr = wid >> 2, wc = wid & 3, fr = lane & 15, fq = lane >> 4;
    const int K = g.K, nt = K / BK;
    unsigned voffA[2], voffB[2];
#pragma unroll
    for (int i = 0; i < 2; ++i) { int R, C; stage_rc(tid * 16 + i * 8192, R, C); const int Rb = Epi::PERM ? ((R & ~31) + perm32(R & 31)) : R;
        voffA[i] = (unsigned)(R * K + C) * 2u; voffB[i] = (unsigned)(Rb * K + C) * 2u; }
    const size_t kstep = (size_t)(BK * 2);
    const size_t hstep = (size_t)HALF * K * 2;
    const size_t tstep = 2 * hstep;
    const unsigned ldsw = (unsigned)wid * 1024u;
    const int aoff = lds_byte(wr * 64 + fr, fq * 8), boff = lds_byte(wc * 32 + fr, fq * 8);
#define PG8_SA(b, h) (((b) * 2 + (h)) * HTB)
#define PG8_SB(b, h) ((4 + (b) * 2 + (h)) * HTB)
#define PG8_STAGE(bufoff, gbase, voff) do { _Pragma("unroll") for (int _i = 0; _i < 2; ++_i) \
        __builtin_amdgcn_global_load_lds((const unsigned*)((const char*)(gbase) + (voff)[_i]), (PG8_LAS unsigned*)(lds + (bufoff) + ldsw + _i * 8192), 16, 0, 0); } while (0)
#define PG8_LDA(dst, b, h) do { _Pragma("unroll") for (int m = 0; m < 4; ++m) _Pragma("unroll") for (int k = 0; k < 2; ++k) dst[m][k] = *(const PG8_LAS bf16x8*)(lds + PG8_SA(b, h) + aoff + m * 2048 + k * 1024); } while (0)
#define PG8_LDB(dst, b, h) do { _Pragma("unroll") for (int n = 0; n < 2; ++n) _Pragma("unroll") for (int k = 0; k < 2; ++k) dst[n][k] = *(const PG8_LAS bf16x8*)(lds + PG8_SB(b, h) + boff + n * 2048 + k * 1024); } while (0)
#define PG8_MMA(ai, bj, At, Bt) do { __builtin_amdgcn_s_setprio(1); _Pragma("unroll") for (int m = 0; m < 4; ++m) _Pragma("unroll") for (int n = 0; n < 2; ++n) _Pragma("unroll") for (int k = 0; k < 2; ++k) \
        acc[ai][bj][m][n] = __builtin_amdgcn_mfma_f32_16x16x32_bf16(Bt[n][k], At[m][k], acc[ai][bj][m][n], 0, 0, 0); __builtin_amdgcn_s_setprio(0); } while (0)
#define PG8_WAIT_V(n) asm volatile("s_waitcnt vmcnt(" #n ")" ::: "memory")
#define PG8_WAIT_L(n) asm volatile("s_waitcnt lgkmcnt(" #n ")" ::: "memory")
#define PG8_BAR __builtin_amdgcn_s_barrier()
#define PG8_SCHED __builtin_amdgcn_sched_barrier(0)
    Unit cur, nxt; int ui = 0;
    if (!S.next(0, cur)) return;
    f32x4 acc[2][2][4][2];
#pragma unroll
    for (int a = 0; a < 2; ++a)
#pragma unroll
        for (int b = 0; b < 2; ++b)
#pragma unroll
            for (int m = 0; m < 4; ++m)
#pragma unroll
                for (int n = 0; n < 2; ++n) acc[a][b][m][n] = (f32x4){0.f, 0.f, 0.f, 0.f};
    bf16x8 At[4][2], B0[2][2], B1[2][2];
    const char* cA = (const char*)g.A + (size_t)cur.pm * tstep + (size_t)cur.kb * kstep; const char* cB = (const char*)g.Bt + (size_t)cur.pn * tstep + (size_t)cur.kb * kstep;
    S.a_ready(cur);
    if constexpr (SP2) {
        PG8_STAGE(PG8_SB(0, 0), cB, voffB); PG8_STAGE(PG8_SB(0, 1), cB + hstep, voffB); PG8_STAGE(PG8_SA(0, 0), cA, voffA); PG8_STAGE(PG8_SA(0, 1), cA + hstep, voffA);
        if (wr == 1) PG8_BAR;
        PG8_WAIT_V(2); PG8_BAR;
        PG8_STAGE(PG8_SB(1, 0), cB + kstep, voffB); PG8_STAGE(PG8_SA(1, 0), cA + kstep, voffA); PG8_STAGE(PG8_SB(1, 1), cB + hstep + kstep, voffB);
        PG8_WAIT_V(6); PG8_BAR;
    } else {
        PG8_STAGE(PG8_SB(0, 0), cB, voffB); PG8_STAGE(PG8_SA(0, 0), cA, voffA); PG8_STAGE(PG8_SB(0, 1), cB + hstep, voffB); PG8_STAGE(PG8_SA(0, 1), cA + hstep, voffA);
        if (wr == 1) PG8_BAR;
        PG8_WAIT_V(4); PG8_BAR;
        PG8_STAGE(PG8_SB(1, 0), cB + kstep, voffB); PG8_STAGE(PG8_SA(1, 0), cA + kstep, voffA); PG8_STAGE(PG8_SB(1, 1), cB + hstep + kstep, voffB);
        PG8_WAIT_V(6); PG8_BAR;
    }
    for (;;) {
        const bool has_next = S.next(ui + 1, nxt);
        const char* nA = has_next ? (const char*)g.A + (size_t)nxt.pm * tstep + (size_t)nxt.kb * kstep : cA; const char* nB = has_next ? (const char*)g.Bt + (size_t)nxt.pn * tstep + (size_t)nxt.kb * kstep : cB;
        const int cnt = cur.nt ? cur.nt : nt;
        for (int t = 0; t < cnt; t += 2) {
            const bool last = (t == cnt - 2);
            const char* a1 = cA + (size_t)(t + 1) * kstep;
            const char* a2 = last ? nA : cA + (size_t)(t + 2) * kstep; const char* b2 = last ? nB : cB + (size_t)(t + 2) * kstep;
            const char* a3 = a2 + kstep; const char* b3 = b2 + kstep;
            if (last && has_next) S.a_ready(nxt);
            if constexpr (SP2) {
            PG8_LDB(B0, 0, 0); PG8_LDB(B1, 0, 1); PG8_SCHED; PG8_LDA(At, 0, 0); PG8_STAGE(PG8_SA(1, 1), a1 + hstep, voffA);
            PG8_WAIT_V(8); PG8_WAIT_L(0); PG8_BAR; PG8_MMA(0, 0, At, B0); PG8_MMA(0, 1, At, B1); PG8_BAR; PG8_SCHED;
            PG8_LDA(At, 0, 1); PG8_STAGE(PG8_SB(0, 0), b2, voffB); PG8_STAGE(PG8_SB(0, 1), b2 + hstep, voffB); PG8_STAGE(PG8_SA(0, 0), a2, voffA);
            PG8_WAIT_V(8); PG8_WAIT_L(0); PG8_BAR; PG8_MMA(1, 0, At, B0); PG8_MMA(1, 1, At, B1); PG8_BAR; PG8_SCHED;
            PG8_LDB(B0, 1, 0); PG8_LDB(B1, 1, 1); PG8_SCHED; PG8_LDA(At, 1, 0); PG8_STAGE(PG8_SA(0, 1), a2 + hstep, voffA);
            PG8_WAIT_V(8); PG8_WAIT_L(0); PG8_BAR; PG8_MMA(0, 0, At, B0); PG8_MMA(0, 1, At, B1); PG8_BAR; PG8_SCHED;
            PG8_LDA(At, 1, 1); PG8_STAGE(PG8_SB(1, 0), b3, voffB); PG8_STAGE(PG8_SB(1, 1), b3 + hstep, voffB); PG8_STAGE(PG8_SA(1, 0), a3, voffA);
            PG8_WAIT_V(8); PG8_WAIT_L(0); PG8_BAR; PG8_MMA(1, 0, At, B0); PG8_MMA(1, 1, At, B1); PG8_BAR; PG8_SCHED;
            } else {
            PG8_LDB(B0, 0, 0); PG8_SCHED; PG8_LDA(At, 0, 0); PG8_STAGE(PG8_SA(1, 1), a1 + hstep, voffA);
            PG8_WAIT_L(8); PG8_BAR; PG8_WAIT_L(0); PG8_MMA(0, 0, At, B0); PG8_BAR; PG8_SCHED;
            PG8_LDB(B1, 0, 1); PG8_STAGE(PG8_SB(0, 0), b2, voffB);
            PG8_BAR; PG8_WAIT_L(0); PG8_MMA(0, 1, At, B1); PG8_BAR;
            PG8_LDA(At, 0, 1); PG8_STAGE(PG8_SA(0, 0), a2, voffA);
            PG8_BAR; PG8_WAIT_L(0); PG8_MMA(1, 0, At, B0); PG8_BAR; PG8_SCHED;
            PG8_STAGE(PG8_SB(0, 1), b2 + hstep, voffB);
            PG8_WAIT_V(6); PG8_BAR; PG8_MMA(1, 1, At, B1); PG8_BAR;
            PG8_LDB(B0, 1, 0); PG8_SCHED; PG8_LDA(At, 1, 0); PG8_STAGE(PG8_SA(0, 1), a2 + hstep, voffA);
            PG8_WAIT_L(8); PG8_BAR; PG8_WAIT_L(0); PG8_MMA(0, 0, At, B0); PG8_BAR; PG8_SCHED;
            PG8_LDB(B1, 1, 1); PG8_STAGE(PG8_SB(1, 0), b3, voffB);
            PG8_BAR; PG8_WAIT_L(0); PG8_MMA(0, 1, At, B1); PG8_BAR;
            PG8_LDA(At, 1, 1); PG8_STAGE(PG8_SA(1, 0), a3, voffA);
            PG8_BAR; PG8_WAIT_L(0); PG8_MMA(1, 0, At, B0); PG8_BAR; PG8_SCHED;
            PG8_STAGE(PG8_SB(1, 1), b3 + hstep, voffB);
            PG8_WAIT_V(6); PG8_BAR; PG8_MMA(1, 1, At, B1); PG8_BAR;
            }
        }
        if constexpr (ALIGN_EPI) { if (wr == 0) PG8_BAR; }
        if constexpr (!Epi::AFTER_DRAIN) { E(acc, cur, wr, wc, fr, fq); S.done(cur); }
        if (!has_next) break;
#pragma unroll
        for (int a = 0; a < 2; ++a)
#pragma unroll
            for (int b = 0; b < 2; ++b)
#pragma unroll
                for (int m = 0; m < 4; ++m)
#pragma unroll
                    for (int n = 0; n < 2; ++n) acc[a][b][m][n] = (f32x4){0.f, 0.f, 0.f, 0.f};
        cur = nxt; cA = nA; cB = nB; ++ui;
        if constexpr (ALIGN_EPI) { if (wr == 1) PG8_BAR; }
    }
    PG8_WAIT_V(0);
    if constexpr (!ALIGN_EPI) { if (wr == 0) PG8_BAR; }
    PG8_BAR;
    if constexpr (Epi::AFTER_DRAIN) { E.fused(acc, cur, wr, wc, fr, fq, lds, wid, lane); S.done(cur); }
#undef PG8_SA
#undef PG8_SB
#undef PG8_STAGE
#undef PG8_LDA
#undef PG8_LDB
#undef PG8_MMA
#undef PG8_WAIT_V
#undef PG8_WAIT_L
#undef PG8_BAR
#undef PG8_SCHED
}
}

#ifndef PG8_SP2
#define PG8_SP2 true
#endif
#ifndef PG8_ALIGN
#define PG8_ALIGN true
#endif
#define GAS __attribute__((address_space(1)))
#define LAS __attribute__((address_space(3)))
typedef unsigned short bf16;
typedef unsigned v4u __attribute__((ext_vector_type(4)));
typedef float f32x4 __attribute__((ext_vector_type(4)));
typedef short bf16x8 __attribute__((ext_vector_type(8)));
typedef GAS unsigned gu32;
typedef GAS unsigned long long gu64;
#define RLX_AGENT __ATOMIC_RELAXED, __HIP_MEMORY_SCOPE_AGENT
#define LDS_WAIT() asm volatile("s_waitcnt lgkmcnt(0)" ::: "memory")
#define VM_WAIT() asm volatile("s_waitcnt vmcnt(0)" ::: "memory")
__device__ __forceinline__ unsigned long long rt() { return __builtin_amdgcn_s_memrealtime(); }
__device__ __forceinline__ unsigned f2bf(float f) { unsigned u = __builtin_bit_cast(unsigned, f); return (u + 0x7fffu + ((u >> 16) & 1u)) >> 16; }
__device__ __forceinline__ unsigned pk2(float lo, float hi) { return f2bf(lo) | (f2bf(hi) << 16); }

#define XB_TMO      128
#define XB_XCNT(j)  (256  + 64 * (j))
#define XB_XSUB(j)  (1280 + 64 * (j))
#define XB_XGEN(j)  (2304 + 64 * (j))
#define XB_TOP      3328
#define XB_TOPGEN   3392
#define XCD_BAR_WORDS 3456
#define XB_SPIN_CAP (1u << 18)

__device__ __forceinline__ unsigned xb_ld(unsigned* p)              { return __hip_atomic_load(p, __ATOMIC_RELAXED, __HIP_MEMORY_SCOPE_AGENT); }
__device__ __forceinline__ unsigned xb_add(unsigned* p, unsigned v) { return __hip_atomic_fetch_add(p, v, __ATOMIC_RELAXED, __HIP_MEMORY_SCOPE_AGENT); }
__device__ __forceinline__ unsigned xb_xcc_id() { return (unsigned)__builtin_amdgcn_s_getreg((3 << 11) | 20) & 0xFu; }
#define XB_SPIN(cond, bar) do { unsigned _sp = 0; while (cond) { __builtin_amdgcn_s_sleep(1); \
    if ((++_sp & 255u) == 0u) { if (xb_ld(&(bar)[XB_TMO])) break; if (_sp > XB_SPIN_CAP) { atomicAdd(&(bar)[XB_TMO], 1u); break; } } } } while (0)

struct XcdBarrier {
    unsigned* bar; unsigned x;
    volatile LAS unsigned* st;
    int wv;
};

__device__ __forceinline__ XcdBarrier xcd_barrier_post(unsigned* bar, volatile LAS unsigned* st) {
    XcdBarrier b; b.bar = bar; b.x = xb_xcc_id(); b.st = st;
    if (threadIdx.x == 0) (void)xb_add(&bar[XB_XCNT(b.x)], 1u);
    return b;
}
__device__ __forceinline__ void xcd_barrier_complete(unsigned* bar, unsigned x, unsigned& nloc, unsigned& nx) {
    const unsigned G = gridDim.x * gridDim.y * gridDim.z;
    unsigned sum, cnt, mine, sp = 0u;
    for (;;) {
        sum = 0u; cnt = 0u; mine = 0u;
#pragma unroll
        for (unsigned j = 0; j < 16; ++j) { const unsigned c = xb_ld(&bar[XB_XCNT(j)]); sum += c; cnt += (c > 0u) ? 1u : 0u; mine = (j == x) ? c : mine; }
        if (sum == G) break;
        __builtin_amdgcn_s_sleep(1);
        if ((++sp & 255u) == 0u) { if (xb_ld(&bar[XB_TMO])) break; if (sp > XB_SPIN_CAP) { atomicAdd(&bar[XB_TMO], 1u); break; } }
    }
    nloc = mine > 0u ? mine : 1u; nx = cnt > 0u ? cnt : 1u;
}

__device__ __forceinline__ void xcd_barrier(const XcdBarrier& b) {
    asm volatile("s_waitcnt vmcnt(0)" ::: "memory");
    __syncthreads();
    if (otid(b.wv) == 0) {
        unsigned* bar = b.bar;
        __builtin_amdgcn_s_waitcnt(0);
        unsigned nloc = b.st[0], nx = b.st[1];
        if (nloc == 0u) { xcd_barrier_complete(bar, b.x, nloc, nx); b.st[0] = nloc; b.st[1] = nx; }
        const unsigned old = xb_add(&bar[XB_XSUB(b.x)], 1u);
        const unsigned gen = old / nloc;
        if (old + 1u == (gen + 1u) * nloc) {
            __builtin_amdgcn_fence(__ATOMIC_RELEASE, "agent");
            asm volatile("s_waitcnt vmcnt(0)" ::: "memory");
            const unsigned og = xb_add(&bar[XB_TOP], 1u);
            const unsigned tg = og / nx;
            if (og + 1u == (tg + 1u) * nx) xb_add(&bar[XB_TOPGEN], 1u);
            else XB_SPIN(xb_ld(&bar[XB_TOPGEN]) == tg, bar);
            __builtin_amdgcn_fence(__ATOMIC_ACQUIRE, "agent");
            xb_add(&bar[XB_XGEN(b.x)], 1u);
            asm volatile("s_waitcnt vmcnt(0)" ::: "memory");
        } else {
            XB_SPIN(xb_ld(&bar[XB_XGEN(b.x)]) == gen, bar);
            __builtin_amdgcn_fence(__ATOMIC_ACQUIRE, "agent");
            asm volatile("s_waitcnt vmcnt(0)" ::: "memory");
        }
    }
    __syncthreads();
}


constexpr int NB = 8, SEQ = 2048, CTXL = 256, DM = 1024, NL = 4;
constexpr int ML = NB * SEQ, MC = NB * CTXL, MT = ML + MC;
constexpr int NIN = 2464, NINP = 2560, DFF = 2816, NUP = 5632, KMLA = 384, NMLA = 1024;
constexpr int NKEY = SEQ + CTXL, NKT = NKEY / 64;
constexpr float EPS = 1e-6f;
constexpr float LOG2E = 1.4426950408889634f;
constexpr int PC_CQ = 0, PC_CKV = 256, PC_KR = 384, PC_DQ = 512, PC_DK = 768, PC_DV = 1024, PC_NQ = 1280, PC_NK = 1536, PC_NV = 1792, PC_GQ = 2048, PC_GK = 2304, PC_GV = 2432;

constexpr size_t MiB = 1u << 20;
constexpr size_t WS_CTL = 0, CTL_ZERO_BYTES = 1 * MiB;
constexpr size_t WS_MODS = 1 * MiB;
constexpr size_t WS_ROPE32 = 2 * MiB;
constexpr size_t WS_ROPE64 = 2 * MiB + 262144;
constexpr size_t WS_W = 3 * MiB;
constexpr size_t W_IN = 0, W_OUT = W_IN + (size_t)NINP * DM * 2, W_UP = W_OUT + (size_t)DM * DM * 2, W_DOWN = W_UP + (size_t)NUP * DM * 2, W_MLA = W_DOWN + (size_t)DM * DFF * 2, W_LAYER = W_MLA + (size_t)NMLA * KMLA * 2;
static_assert(W_LAYER == 25427968, "weights per layer");
constexpr size_t WS_XC = 100 * MiB;
constexpr size_t WS_R2 = 108 * MiB;
constexpr size_t WS_XN = WS_R2, WS_MLAP = WS_R2, WS_CQKV = WS_R2 + 36 * MiB;
constexpr size_t WS_R1 = 158 * MiB;
constexpr size_t WS_P = WS_R1, WS_QKV = WS_R1 + 90 * MiB, WS_MIX = WS_R1, WS_ACT = WS_R1, WS_HALO = WS_R1 + 100 * MiB;
constexpr size_t WS_SLAB = WS_R1 + 110 * MiB;
constexpr size_t WS_END = WS_R1 + 198 * MiB;
static_assert(WS_W + NL * W_LAYER <= WS_XC, "weights fit");
static_assert((size_t)MT * NINP * 2 <= 90 * MiB && (size_t)MT * DFF * 2 <= 100 * MiB && (size_t)72 * 4 * NUP * 4 <= 8 * MiB, "R1 map");
constexpr size_t E_QA = 0, E_KA = E_QA + (size_t)NB * 4 * NKEY * 96, E_VA = E_KA + (size_t)NB * 4 * NKEY * 96, E_QD = E_VA + (size_t)NB * 4 * NKEY * 64,
                 E_KD = E_QD + (size_t)NB * 8 * NKEY * 32, E_VD = E_KD + (size_t)NB * 8 * NKEY * 32, E_QN = E_VD + (size_t)NB * 4 * NKEY * 64, E_KN = E_QN + (size_t)NB * 4 * NKEY * 64,
                 E_VN = E_KN + (size_t)NB * 4 * NKEY * 64, E_QG = E_VN + (size_t)NB * 4 * NKEY * 64, E_KG = E_QG + (size_t)NB * 4 * NKEY * 64, E_VG = E_KG + (size_t)NB * 2 * NKEY * 64,
                 E_END = E_VG + (size_t)NB * 2 * NKEY * 64;
static_assert(E_END * 2 <= 108 * MiB, "QKV map");
constexpr int CW_TMO = 0, CW_CODE = 1, CW_BAR = 4096;

constexpr int RING_OFF = 0, RING_BYTES = 131072;
constexpr int LDSCTL_OFF = RING_BYTES, MISC_OFF = LDSCTL_OFF + 320;
constexpr int EX_OFF = RING_BYTES + 1024;
constexpr int CWL_OFF = EX_OFF + 8192;
constexpr int LDS_BYTES = 147456;
static_assert(CWL_OFF + 4096 <= LDS_BYTES, "LDS map");
constexpr int NWAVES = 8;

typedef float f32x2v __attribute__((ext_vector_type(2)));
typedef unsigned u32x2v __attribute__((ext_vector_type(2)));

__device__ __forceinline__ float bf2f(unsigned short v) { return __uint_as_float((unsigned)v << 16); }
__device__ __forceinline__ float bflo(unsigned w) { return __uint_as_float(w << 16); }
__device__ __forceinline__ float bfhi(unsigned w) { return __uint_as_float(w & 0xffff0000u); }
template <int M> __device__ __forceinline__ float swz(float v) { static_assert(M >= 1 && M < 32, "xor mask within 32 lanes"); return __int_as_float(__builtin_amdgcn_ds_swizzle(__float_as_int(v), (M << 10) | 0x1f)); }
__device__ __forceinline__ float sum32(float v) { auto r = __builtin_amdgcn_permlane32_swap(__float_as_uint(v), __float_as_uint(v), false, false); return __uint_as_float(r[0]) + __uint_as_float(r[1]); }
__device__ __forceinline__ float max32(float v) { auto r = __builtin_amdgcn_permlane32_swap(__float_as_uint(v), __float_as_uint(v), false, false); return fmaxf(__uint_as_float(r[0]), __uint_as_float(r[1])); }
__device__ __forceinline__ float wave_sum(float v) { v += swz<1>(v); v += swz<2>(v); v += swz<4>(v); v += swz<8>(v); v += swz<16>(v); return sum32(v); }
template <int CTRL> __device__ __forceinline__ float dpp_mov(float v) { return __int_as_float(__builtin_amdgcn_update_dpp(0, __float_as_int(v), CTRL, 0xf, 0xf, false)); }
__device__ __forceinline__ float silu_f(float x) { return x / (1.f + __expf(-x)); }
__device__ __forceinline__ float rsq_f(float x) { return __builtin_amdgcn_rsqf(x); }
typedef __bf16 bf16x2h __attribute__((ext_vector_type(2)));
__device__ __forceinline__ unsigned pkc(float lo, float hi) { f32x2v v = {lo, hi}; bf16x2h b = __builtin_convertvector(v, bf16x2h); return __builtin_bit_cast(unsigned, b); }
__device__ __forceinline__ unsigned pkc1(float v) { return pkc(v, 0.f) & 0xffffu; }

__device__ __forceinline__ size_t q_off(int H, int DK, int b, int h, int q) { return ((size_t)(b * H + h) * NKEY + q) * DK; }
__device__ __forceinline__ size_t k_off(int H, int DK, int b, int h, int key, int d) { return ((((size_t)(b * H + h) * NKT + (key >> 6)) * (DK >> 3) + (d >> 3)) * 64 + (key & 63)) * 8 + (d & 7); }
__device__ __forceinline__ size_t v_off(int H, int b, int h, int key, int dv) {
    const int kk = key & 63, s = kk >> 4, i = kk & 15, hh = (i >> 2) & 1, j = (i & 3) + 4 * (i >> 3);
    return ((((size_t)(b * H + h) * NKT + (key >> 6)) * 8 + (s * 2 + hh)) * 64 + dv) * 8 + j;
}

constexpr int PT_OFF = LDSCTL_OFF + 512;
struct Ctx {
    LAS unsigned char* lds;
    int tid, lane, wave, G, gw, NGW;
};
extern __shared__ __attribute__((aligned(16))) unsigned char lds_raw[];
__device__ __forceinline__ Ctx make_ctx(const int wv) {
    unsigned zl = 0; asm volatile("" : "+s"(zl));
    Ctx C; C.lds = (LAS unsigned char*)lds_raw + zl;
    int w = wv; asm volatile("" : "+s"(w));
    const int t = otid(w);
    C.tid = t; C.lane = t & 63; C.wave = w;
    C.G = gridDim.x; { const int bx = blockIdx.x; const int vcu = (C.G % 8 == 0) ? (bx % 8) * (C.G / 8) + bx / 8 : bx; C.gw = vcu * NWAVES + C.wave; } C.NGW = C.G * NWAVES;
    return C;
}
__device__ __forceinline__ unsigned long long ptab(const Ctx& C, int i) {
    const unsigned long long p = ((const LAS unsigned long long*)(C.lds + PT_OFF))[i];
    const unsigned lo = __builtin_amdgcn_readfirstlane((unsigned)p), hi = __builtin_amdgcn_readfirstlane((unsigned)(p >> 32));
    return ((unsigned long long)hi << 32) | lo;
}
__device__ __forceinline__ const float* inp(const Ctx& C, int i) { return (const float*)ptab(C, i); }
__device__ __forceinline__ float* outp(const Ctx& C) { return (float*)ptab(C, 32); }
__device__ __forceinline__ unsigned char* wsp(const Ctx& C) { return (unsigned char*)ptab(C, 33); }
__device__ __forceinline__ bf16* wptr(const Ctx& C, int l, size_t off) { return (bf16*)(wsp(C) + WS_W + (size_t)l * W_LAYER + off); }
__device__ __forceinline__ float lambda_init(int l) { return l == 0 ? 0.2f : l == 1 ? (float)(0.8 - 0.6 * 0.7408182206817179) : l == 2 ? (float)(0.8 - 0.6 * 0.5488116360940264) : (float)(0.8 - 0.6 * 0.4065696597405991); }

namespace pg8 {
struct EpiResGate {
    static constexpr bool PERM = false, AFTER_DRAIN = false;
    const float* base_lat; const float* base_ctx; float* out_lat; float* out_ctx; const float* gate; float* slab; int dry;
    __device__ __forceinline__ void operator()(const f32x4 (&acc)[2][2][4][2], const Unit& u, int wr, int wc, int fr, int fq) const {
        const bool lat = u.pm < 64; const int bidx = lat ? (u.pm >> 3) : 8;
        const size_t rowt = lat ? (size_t)u.pm * BM : (size_t)(u.pm - 64) * BM;
        const float* base = (lat ? base_lat : base_ctx) + rowt * DM; float* out = (lat ? out_lat : out_ctx) + rowt * DM;
        const int row0 = wr * 64 + fr, col0 = u.pn * BM + wc * 32 + 4 * fq;
        f32x4 gv[2][2];
#pragma unroll
        for (int bj = 0; bj < 2; ++bj)
#pragma unroll
            for (int n = 0; n < 2; ++n) gv[bj][n] = *(const f32x4*)(gate + (size_t)bidx * 6144 + col0 + bj * HALF + n * 16);
#pragma unroll
        for (int ai = 0; ai < 2; ++ai)
#pragma unroll
            for (int m = 0; m < 4; ++m) { const size_t off = (size_t)(row0 + ai * HALF + m * 16) * DM + col0;
#pragma unroll
                for (int bj = 0; bj < 2; ++bj)
#pragma unroll
                    for (int n = 0; n < 2; ++n) {
                        if (dry) { f32x4 d = gv[bj][n] * acc[ai][bj][m][n]; if (!u.nt) d += *(const f32x4*)(base + off + bj * HALF + n * 16); asm volatile("" :: "v"(d)); }
                        else if (u.nt) *(f32x4*)(slab + (size_t)u.sp * ((size_t)MC * DM) + rowt * DM + off + bj * HALF + n * 16) = gv[bj][n] * acc[ai][bj][m][n];
                        else { const f32x4 bs = *(const f32x4*)(base + off + bj * HALF + n * 16); *(f32x4*)(out + off + bj * HALF + n * 16) = bs + gv[bj][n] * acc[ai][bj][m][n]; } }
                if (m & 1) asm volatile("" ::: "memory"); }
    }
};
struct SplitOrder {
    StaticOrder lat; int G, c, nsub, q, r;
    __device__ __forceinline__ void init(int G_, int c_, bool with_ctx, int nt_total) { lat.init(ML, DM, G_, c_); G = G_; c = c_; nsub = with_ctx ? 128 : 0; q = (nt_total >> 1) >> 2; r = (nt_total >> 1) & 3; }
    __device__ __forceinline__ bool next(int i, Unit& u) const {
        const long L = (long)i * G + c;
        Unit a; const bool okl = lat.next(i, a);
        const int j = (int)(L - 256), cu = j >> 2, sp = j & 3; const bool sub = L >= 256;
        u.pm = sub ? 64 + (cu >> 2) : a.pm; u.pn = sub ? (cu & 3) : a.pn; u.kb = sub ? 2 * (sp * q + (sp < r ? sp : r)) : 0; u.nt = sub ? 2 * (q + (sp < r ? 1 : 0)) : 0; u.sp = sub ? sp : 0;
        return sub ? (j < nsub) : okl;
    }
    __device__ __forceinline__ void a_ready(const Unit&) const {}
    __device__ __forceinline__ void done(const Unit&) const {}
};
__device__ __forceinline__ f32x4 sel4(bool c, const f32x4 a, const f32x4 b) { f32x4 r; r[0] = c ? a[0] : b[0]; r[1] = c ? a[1] : b[1]; r[2] = c ? a[2] : b[2]; r[3] = c ? a[3] : b[3]; return r; }
__device__ __forceinline__ float silu1(float x) { return x * __builtin_amdgcn_rcpf(1.f + __expf(-x)); }
struct EpiConvGate {
    static constexpr bool PERM = true, AFTER_DRAIN = false;
    bf16_t* ACT; float* HALO; const float* cw; const float* cb; PG8_LAS float* EX;
    __device__ __forceinline__ void operator()(const f32x4 (&acc)[2][2][4][2], const Unit& u, int wr, int wc, int fr, int fq) const {
        const int lane = fq * 16 + fr;
        const int jc = u.pn * 128 + wc * 32 + 8 * fq;
        PG8_LAS float* CWL = EX + 2048;
        unsigned cwl_lane = (unsigned)(uintptr_t)(CWL + wc * 32 + 8 * fq); asm volatile("" : "+v"(cwl_lane));
        {   const int tid = (wr * 4 + wc) * 64 + lane, row = tid >> 7, cp = tid & 127, bj = cp >> 6, cc = (cp & 63) * 2;
            const float* src = (row < 3 ? cw + (size_t)row * NUP : cb) + bj * DFF + u.pn * 128 + cc;
            *(PG8_LAS f32x2v*)(CWL + row * 256 + bj * 128 + cc) = *(const f32x2v*)src; }
        if (fr == 0) {
#pragma unroll
            for (int ai = 0; ai < 2; ++ai)
#pragma unroll
                for (int bj = 0; bj < 2; ++bj)
#pragma unroll
                    for (int n = 0; n < 2; ++n) *(PG8_LAS f32x4*)(EX + ((((wr * 4 + wc) * 2 + ai) * 2 + 0) * 64 + bj * 32 + 8 * fq + 4 * n)) = acc[ai][bj][0][n];
        }
        if (fr == 15) {
#pragma unroll
            for (int ai = 0; ai < 2; ++ai)
#pragma unroll
                for (int bj = 0; bj < 2; ++bj)
#pragma unroll
                    for (int n = 0; n < 2; ++n) *(PG8_LAS f32x4*)(EX + ((((wr * 4 + wc) * 2 + ai) * 2 + 1) * 64 + bj * 32 + 8 * fq + 4 * n)) = acc[ai][bj][3][n];
        }
        asm volatile("s_waitcnt lgkmcnt(0)" ::: "memory"); __builtin_amdgcn_s_barrier(); asm volatile("" ::: "memory");
        if (u.pm < 64) {
            float* hb = HALO + (size_t)u.pm * 4 * NUP;
            if (wr == 0 && fr < 2) {
#pragma unroll
                for (int bj = 0; bj < 2; ++bj)
#pragma unroll
                    for (int n = 0; n < 2; ++n) *(f32x4*)(hb + (size_t)fr * NUP + bj * DFF + jc + 4 * n) = acc[0][bj][0][n];
            }
            if (wr == 1 && fr >= 14) {
#pragma unroll
                for (int bj = 0; bj < 2; ++bj)
#pragma unroll
                    for (int n = 0; n < 2; ++n) *(f32x4*)(hb + (size_t)(fr - 12) * NUP + bj * DFF + jc + 4 * n) = acc[1][bj][3][n];
            }
        }
        const bool f0 = fr == 0, f15 = fr == 15;
#pragma unroll
        for (int ai = 0; ai < 2; ++ai) {
            const int g = 2 * ai + wr;
            const int gp = g - 1, gn = g + 1;
            unsigned pk[4][4];
#pragma unroll
            for (int n = 0; n < 2; ++n)
#pragma unroll
                for (int ep = 0; ep < 2; ++ep) {
                    float cv[2][2][4];
#pragma unroll
                    for (int bj = 0; bj < 2; ++bj) {
                        const int c = bj * 128 + 4 * n + 2 * ep;
                        const PG8_LAS float* cl = (const PG8_LAS float*)(uintptr_t)cwl_lane;
                        const f32x2v w0 = *(const PG8_LAS f32x2v*)(cl + c), w1 = *(const PG8_LAS f32x2v*)(cl + 256 + c), w2 = *(const PG8_LAS f32x2v*)(cl + 512 + c), bb = *(const PG8_LAS f32x2v*)(cl + 768 + c);
                        f32x2v bprev = {0.f, 0.f}, bnext = {0.f, 0.f};
                        if (gp >= 0) bprev = *(const PG8_LAS f32x2v*)(EX + (((((gp & 1) * 4 + wc) * 2 + (gp >> 1)) * 2 + 1) * 64 + bj * 32 + 8 * fq + 4 * n + 2 * ep));
                        if (gn <= 3) bnext = *(const PG8_LAS f32x2v*)(EX + (((((gn & 1) * 4 + wc) * 2 + (gn >> 1)) * 2 + 0) * 64 + bj * 32 + 8 * fq + 4 * n + 2 * ep));
#pragma unroll
                        for (int e2 = 0; e2 < 2; ++e2) {
                            const int e = 2 * ep + e2;
                            float r[4], l[4];
#pragma unroll
                            for (int m = 0; m < 4; ++m) { r[m] = dpp_mov<0x121>(acc[ai][bj][m][n][e]); l[m] = dpp_mov<0x12f>(acc[ai][bj][m][n][e]); }
#pragma unroll
                            for (int m = 0; m < 4; ++m) {
                                const float pv = f0 ? (m > 0 ? r[m > 0 ? m - 1 : 0] : bprev[e2]) : r[m];
                                const float nx = f15 ? (m < 3 ? l[m < 3 ? m + 1 : 3] : bnext[e2]) : l[m];
                                cv[bj][e2][m] = w0[e2] * pv + w1[e2] * acc[ai][bj][m][n][e] + w2[e2] * nx + bb[e2];
                            }
                        }
                    }
#pragma unroll
                    for (int m = 0; m < 4; ++m) pk[m][n * 2 + ep] = cvt_pk_bf16(silu1(cv[1][0][m]) * cv[0][0][m], silu1(cv[1][1][m]) * cv[0][1][m]);
                    __builtin_amdgcn_sched_barrier(0);
                }
#pragma unroll
            for (int m = 0; m < 4; ++m) {
                const size_t row = (size_t)u.pm * BM + ai * HALF + wr * 64 + m * 16 + fr;
                u32x4 w; w.x = pk[m][0]; w.y = pk[m][1]; w.z = pk[m][2]; w.w = pk[m][3];
                *(u32x4*)(ACT + row * DFF + jc) = w;
            }
            __builtin_amdgcn_sched_barrier(0);
        }
    }
};
}

__device__ __forceinline__ void transpose_item(const float* W, int N, int k0, int n0, bf16* WT, int ldt, int kcol0, int orow0, LAS float* scr, int lane) {
    f32x4 w[8];
#pragma unroll
    for (int i = 0; i < 8; ++i) w[i] = *(const f32x4*)(W + (size_t)(k0 + 8 * i + (lane >> 3)) * N + n0 + 4 * (lane & 7));
#pragma unroll
    for (int i = 0; i < 8; ++i) { LAS float* d = scr + (8 * i + (lane >> 3)) * 33 + 4 * (lane & 7); d[0] = w[i][0]; d[1] = w[i][1]; d[2] = w[i][2]; d[3] = w[i][3]; }
    LDS_WAIT(); asm volatile("" ::: "memory");
    const int c = lane & 7;
#pragma unroll
    for (int j = 0; j < 4; ++j) { const int n = (lane >> 3) + 8 * j; const LAS float* s = scr + (8 * c) * 33 + n;
        v4u o; o.x = pkc(s[0 * 33], s[1 * 33]); o.y = pkc(s[2 * 33], s[3 * 33]); o.z = pkc(s[4 * 33], s[5 * 33]); o.w = pkc(s[6 * 33], s[7 * 33]);
        *(GAS v4u*)(WT + (size_t)(orow0 + n) * ldt + kcol0 + k0 + 8 * c) = o; }
    LDS_WAIT(); asm volatile("" ::: "memory");
}
__device__ __forceinline__ void phase_prologue(const int wv) {
    const Ctx C = make_ctx(wv);
    {
        LAS float* S = (LAS float*)(C.lds);
        LAS float* red = (LAS float*)(C.lds + 40960);
        const float* cin = inp(C, 1); const float* cctx = inp(C, 3); const float* wmod = inp(C, 4); const float* bmod = inp(C, 5);
        for (int i = C.tid; i < 9 * 1024; i += 512) { const int r = i >> 10, k = i & 1023; const float v = (r < 8) ? cin[r * 1024 + k] : cctx[k]; S[i] = v / (1.f + expf(-v)); }
        __syncthreads();
        for (int it = blockIdx.x; it < NL * 192; it += C.G) {
            const int l = it / 192, col0 = (it % 192) * 32;
            const float* W = wmod + (size_t)l * 1024 * 6144 + col0 + 4 * (C.lane & 7);
            f32x4 acc[9];
#pragma unroll
            for (int r = 0; r < 9; ++r) acc[r] = (f32x4){0.f, 0.f, 0.f, 0.f};
            const int kb = C.wave * 128 + (C.lane >> 3);
#pragma unroll 4
            for (int i = 0; i < 16; ++i) { const int k = kb + 8 * i; const f32x4 w = *(const f32x4*)(W + (size_t)k * 6144);
#pragma unroll
                for (int r = 0; r < 9; ++r) acc[r] += w * S[r * 1024 + k]; }
#pragma unroll
            for (int r = 0; r < 9; ++r)
#pragma unroll
                for (int e = 0; e < 4; ++e) { float v = acc[r][e]; v += swz<8>(v); v += swz<16>(v); acc[r][e] = sum32(v); }
            if (C.lane < 8) {
#pragma unroll
                for (int r = 0; r < 9; ++r) *(LAS f32x4*)(red + (C.wave * 9 + r) * 32 + 4 * C.lane) = acc[r];
            }
            __syncthreads();
            if (C.tid < 288) { const int r = C.tid >> 5, cc = C.tid & 31; float s = 0.f;
#pragma unroll
                for (int w = 0; w < 8; ++w) s += red[(w * 9 + r) * 32 + cc];
                ((float*)(wsp(C) + WS_MODS))[(size_t)(l * 9 + r) * 6144 + col0 + cc] = s + bmod[l * 6144 + col0 + cc]; }
            __syncthreads();
        }
    }
    {
        LAS float* scr = (LAS float*)(C.lds + 49152 + C.wave * 9216);
        constexpr int I_IN = 16 * 77, I_OUT = 16 * 32, I_UP = 16 * 176, I_DN = 44 * 32, I_UQ = 4 * 12, I_UKV = 2 * 16, I_L = I_IN + I_OUT + I_UP + I_DN + I_UQ + I_UKV;
        for (int it = C.gw; it < NL * I_L; it += C.NGW) {
            const int l = it / I_L; int r = it % I_L;
            if (r < I_IN) { const int kb = r / 77, nb = r % 77, n0 = nb * 32; transpose_item(inp(C, 7) + (size_t)l * DM * NIN, NIN, kb * 64, n0, wptr(C, l, W_IN), DM, 0, n0 < 416 ? n0 : n0 + 96, scr, C.lane); continue; } r -= I_IN;
            if (r < I_OUT) { const int kb = r / 32, nb = r % 32; transpose_item(inp(C, 8) + (size_t)l * DM * DM, DM, kb * 64, nb * 32, wptr(C, l, W_OUT), DM, 0, nb * 32, scr, C.lane); continue; } r -= I_OUT;
            if (r < I_UP) { const int kb = r / 176, nb = r % 176, n0 = nb * 32, bj = n0 >= DFF ? 1 : 0, j0 = n0 - bj * DFF;
                transpose_item(inp(C, 28) + (size_t)l * DM * NUP, NUP, kb * 64, n0, wptr(C, l, W_UP), DM, 0, 256 * (j0 >> 7) + 128 * bj + (j0 & 127), scr, C.lane); continue; } r -= I_UP;
            if (r < I_DN) { const int kb = r / 32, nb = r % 32; transpose_item(inp(C, 31) + (size_t)l * DFF * DM, DM, kb * 64, nb * 32, wptr(C, l, W_DOWN), DFF, 0, nb * 32, scr, C.lane); continue; } r -= I_DN;
            if (r < I_UQ) { const int kb = r / 12, nb = r % 12; transpose_item(inp(C, 10) + (size_t)l * 256 * 384, 384, kb * 64, nb * 32, wptr(C, l, W_MLA), KMLA, 0, nb * 32, scr, C.lane); continue; } r -= I_UQ;
            { const int kb = r / 16, nb = r % 16; transpose_item(inp(C, 12) + (size_t)l * 128 * 512, 512, kb * 64, nb * 32, wptr(C, l, W_MLA), KMLA, 256, 512 + nb * 32, scr, C.lane); }
        }
        const int gt = C.gw * 64 + C.lane, NGT = C.NGW * 64;
        const v4u z = {0u, 0u, 0u, 0u};
        for (int i = gt; i < NL * 96 * 128; i += NGT) { const int l = i / (96 * 128), r = i % (96 * 128); *(GAS v4u*)(wptr(C, l, W_IN) + (size_t)(416 + r / 128) * DM + (r % 128) * 8) = z; }
        for (int i = gt; i < NL * 1024 * 48; i += NGT) { const int l = i / (1024 * 48), r = (i / 48) % 1024, k = (i % 48) * 8;
            const bool zero = (r < 384) ? (k >= 256) : (r < 512) ? true : (k < 256);
            if (zero) *(GAS v4u*)(wptr(C, l, W_MLA) + (size_t)r * KMLA + k) = z; }
        float* r32 = (float*)(wsp(C) + WS_ROPE32); float* r64 = (float*)(wsp(C) + WS_ROPE64);
        for (int i = gt; i < 2048 * 48; i += NGT) {
            const int pos = i / 48, e = i % 48; const float row = (float)(pos >> 6), col = (float)(pos & 63);
            if (e < 16) { const int f = e & 7; const float inv = powf(10000.f, -(float)f / 8.f); const float a = (e < 8 ? row : col) * inv; r32[(pos * 16 + e) * 2] = cosf(a); r32[(pos * 16 + e) * 2 + 1] = sinf(a); }
            else { const int e2 = e - 16, f = e2 & 15; const float inv = powf(10000.f, -(float)f / 16.f); const float a = (e2 < 16 ? row : col) * inv; r64[(pos * 32 + e2) * 2] = cosf(a); r64[(pos * 32 + e2) * 2 + 1] = sinf(a); }
        }
    }
}

__device__ __forceinline__ void phase_norm(const int wv, int l, int which, int nrows) {
    const Ctx C = make_ctx(wv);
    const bool first = (l == 0 && which == 1);
    const bool slabbed = !first;
    const float* xl = first ? inp(C, 0) : outp(C); const float* xc = (l == 0 && which <= 2 && (first || which == 2)) ? inp(C, 2) : ((float*)(wsp(C) + WS_XC));
    float* XCw = (float*)(wsp(C) + WS_XC); const float* slab = (const float*)(wsp(C) + WS_SLAB);
    const float* gv = (which == 1 ? inp(C, 6) : inp(C, 27)) + l * DM;
    f32x4 g4[4];
#pragma unroll
    for (int j = 0; j < 4; ++j) g4[j] = *(const f32x4*)(gv + 4 * C.lane + 256 * j);
    bf16* XN = (bf16*)(wsp(C) + WS_XN); const float* mods = (const float*)(wsp(C) + WS_MODS);
    for (int R0 = C.gw; R0 < nrows; R0 += 3 * C.NGW) {
        f32x4 v[3][4]; float ss[3];
#pragma unroll
        for (int u = 0; u < 3; ++u) { const int R = R0 + u * C.NGW; ss[u] = 0.f;
            if (R < nrows) { const float* src = R < ML ? xl + (size_t)R * DM : xc + (size_t)(R - ML) * DM;
#pragma unroll
                for (int j = 0; j < 4; ++j) v[u][j] = *(const f32x4*)(src + 4 * C.lane + 256 * j);
                if (R >= ML && slabbed) {
#pragma unroll
                    for (int sp = 0; sp < 4; ++sp)
#pragma unroll
                        for (int j = 0; j < 4; ++j) v[u][j] += *(const f32x4*)(slab + ((size_t)sp * MC + (R - ML)) * DM + 4 * C.lane + 256 * j);
#pragma unroll
                    for (int j = 0; j < 4; ++j) *(f32x4*)(XCw + (size_t)(R - ML) * DM + 4 * C.lane + 256 * j) = v[u][j];
                }
#pragma unroll
                for (int j = 0; j < 4; ++j) { ss[u] += (v[u][j][0] * v[u][j][0] + v[u][j][1] * v[u][j][1]) + (v[u][j][2] * v[u][j][2] + v[u][j][3] * v[u][j][3]); } } }
#pragma unroll
        for (int u = 0; u < 3; ++u) ss[u] = wave_sum(ss[u]);
#pragma unroll
        for (int u = 0; u < 3; ++u) { const int R = R0 + u * C.NGW;
            if (R < nrows) { const float rs = rsq_f(ss[u] * (1.f / DM) + EPS);
                const int bidx = R < ML ? (R >> 11) : 8; const float* md = mods + (size_t)(l * 9 + bidx) * 6144 + (which == 1 ? 0 : 3072);
#pragma unroll
                for (int j = 0; j < 4; ++j) {
                    const f32x4 sh = *(const f32x4*)(md + 4 * C.lane + 256 * j), sc = *(const f32x4*)(md + 1024 + 4 * C.lane + 256 * j);
                    const f32x4 y = (v[u][j] * rs) * g4[j] * (sc + 1.f) + sh;
                    u32x2v w; w.x = pkc(y[0], y[1]); w.y = pkc(y[2], y[3]);
                    *(u32x2v*)(XN + (size_t)R * DM + 4 * C.lane + 256 * j) = w; } } }
    }
}

__device__ __forceinline__ void row_info(int R, int& b, int& qi, int& pos) {
    if (R < ML) { b = R >> 11; qi = R & 2047; pos = qi; } else { const int r = R - ML; b = r >> 8; qi = 2048 + (r & 255); pos = -1; }
}
template <int MAXO> __device__ __forceinline__ float red_xor(float v) { v += swz<1>(v); v += swz<2>(v); v += swz<4>(v); if (MAXO >= 8) v += swz<8>(v); if (MAXO >= 16) v += swz<16>(v); return v; }

constexpr int TB = 8;
__device__ __forceinline__ void phase_prep1(const int wv, int l) {
    const Ctx C = make_ctx(wv);
    LAS unsigned char* img = C.lds + C.wave * 16384;
    bf16* Q = ((bf16*)(wsp(C) + WS_QKV));
    const bf16* P = (const bf16*)(wsp(C) + WS_P); bf16* CQKV = (bf16*)(wsp(C) + WS_CQKV);
    const float* rope32 = (const float*)(wsp(C) + WS_ROPE32); const float* rope64 = (const float*)(wsp(C) + WS_ROPE64);
    const float C32 = 0.17677669529663687f * LOG2E, C64 = 0.125f * LOG2E;
    const int lane = C.lane;
    for (int item = C.gw; item < 3 * (MT / 16); item += C.NGW) {
        const int part = item / (MT / 16), g = item % (MT / 16), R0 = 16 * g;
        int b, qi0, pos0; row_info(R0, b, qi0, pos0);
        const int tile = qi0 >> 6, sidx = (qi0 >> 4) & 3;
        if (part == 0) {
            const int gi = lane >> 3, lg = lane & 7, d0 = 4 * lg, ti0 = ((lg & 4) ? 8 : 0) + 4 * (lg & 1); const bool rot = pos0 >= 0;
            const float* gq = inp(C, 15) + l * 32 + d0; const float* gk = inp(C, 16) + l * 32 + d0;
            float gqv[4], gkv[4];
#pragma unroll
            for (int e = 0; e < 4; ++e) { gqv[e] = gq[e]; gkv[e] = gk[e]; }
            for (int t0 = 0; t0 < 16; t0 += TB) {
            u32x2v wq4[TB], wk4[TB], wv4[TB]; f32x4 rt4[TB][2];
#pragma unroll
            for (int tt = 0; tt < TB; ++tt) { const bf16* pr = P + (size_t)(R0 + t0 + tt) * NINP; wq4[tt] = *(const u32x2v*)(pr + PC_DQ + 4 * lane); wk4[tt] = *(const u32x2v*)(pr + PC_DK + 4 * lane); wv4[tt] = *(const u32x2v*)(pr + PC_DV + 4 * lane);
                const float* rp = rope32 + ((rot ? pos0 + t0 + tt : 0) * 16 + ti0) * 2; rt4[tt][0] = *(const f32x4*)rp; rt4[tt][1] = *(const f32x4*)(rp + 4); }
#pragma unroll
            for (int tt = 0; tt < TB; ++tt) {
                const int t = t0 + tt;
                const u32x2v wq = wq4[tt], wk = wk4[tt], wvv = wv4[tt];
#pragma unroll
                for (int qk = 0; qk < 2; ++qk) {
                    const u32x2v w = qk ? wk : wq; float v[4] = {bflo(w.x), bfhi(w.x), bflo(w.y), bfhi(w.y)};
                    float ss = (v[0] * v[0] + v[1] * v[1]) + (v[2] * v[2] + v[3] * v[3]); ss = red_xor<4>(ss);
                    const float rs = rsq_f(ss * (1.f / 32.f) + EPS);
                    float y[4];
#pragma unroll
                    for (int e = 0; e < 4; ++e) y[e] = v[e] * rs * (qk ? gkv[e] : gqv[e]);
#pragma unroll
                    for (int e = 0; e < 4; ++e) { const float pp = swz<2>(y[e]); const float cs = rot ? rt4[tt][e >> 1][2 * (e & 1)] : 1.f, sn = rot ? rt4[tt][e >> 1][2 * (e & 1) + 1] : 0.f;
                        v[e] = y[e] * cs + ((lg & 2) ? pp : -pp) * sn; }
                    if (qk == 0) { u32x2v o; o.x = pkc(v[0] * C32, v[1] * C32); o.y = pkc(v[2] * C32, v[3] * C32); *(u32x2v*)(Q + E_QD + q_off(8, 32, b, gi, qi0 + t) + d0) = o; }
                    else { u32x2v o; o.x = pkc(v[0], v[1]); o.y = pkc(v[2], v[3]); *(LAS u32x2v*)(img + ((gi * 4 + (d0 >> 3)) * 16 + t) * 16 + (d0 & 7) * 2) = o; }
                }
                {   const int h = lane >> 4, dv0 = 4 * (lane & 15), hh = (t >> 2) & 1, j = (t & 3) + 4 * (t >> 3);
                    LAS unsigned short* vp = (LAS unsigned short*)(img + 8192 + ((h * 2 + hh) * 64 + dv0) * 16 + j * 2);
                    vp[0] = (unsigned short)(wvv.x & 0xffff); vp[8] = (unsigned short)(wvv.x >> 16); vp[16] = (unsigned short)(wvv.y & 0xffff); vp[24] = (unsigned short)(wvv.y >> 16); }
            }
            }
            LDS_WAIT(); asm volatile("" ::: "memory");
#pragma unroll
            for (int i = 0; i < 8; ++i) { const int pc = lane + 64 * i; const int gi2 = pc >> 6, ch = (pc >> 4) & 3, t = pc & 15;
                *(GAS v4u*)(Q + E_KD + k_off(8, 32, b, gi2, qi0 + t, 8 * ch)) = *(const LAS v4u*)(img + pc * 16); }
#pragma unroll
            for (int i = 0; i < 8; ++i) { const int pc = lane + 64 * i; const int h = pc >> 7, hh = (pc >> 6) & 1, dv = pc & 63;
                *(GAS v4u*)(Q + E_VD + ((((size_t)(b * 4 + h) * NKT + tile) * 8 + (sidx * 2 + hh)) * 64 + dv) * 8) = *(const LAS v4u*)(img + 8192 + pc * 16); }
        } else if (part == 1) {
            const int h = lane >> 4, d0 = 4 * (lane & 15);
            const float* gq = inp(C, 22) + l * 64 + d0; const float* gk = inp(C, 23) + l * 64 + d0;
            float gqv[4], gkv[4];
#pragma unroll
            for (int e = 0; e < 4; ++e) { gqv[e] = gq[e]; gkv[e] = gk[e]; }
            for (int t0 = 0; t0 < 16; t0 += TB) {
            u32x2v wq4[TB], wk4[TB], wv4[TB];
#pragma unroll
            for (int tt = 0; tt < TB; ++tt) { const bf16* pr = P + (size_t)(R0 + t0 + tt) * NINP; wq4[tt] = *(const u32x2v*)(pr + PC_NQ + 4 * lane); wk4[tt] = *(const u32x2v*)(pr + PC_NK + 4 * lane); wv4[tt] = *(const u32x2v*)(pr + PC_NV + 4 * lane); }
#pragma unroll
            for (int tt = 0; tt < TB; ++tt) {
                const int t = t0 + tt;
                const u32x2v wq = wq4[tt], wk = wk4[tt], wvv = wv4[tt];
#pragma unroll
                for (int qk = 0; qk < 2; ++qk) {
                    const u32x2v w = qk ? wk : wq; float v[4] = {bflo(w.x), bfhi(w.x), bflo(w.y), bfhi(w.y)};
                    float ss = (v[0] * v[0] + v[1] * v[1]) + (v[2] * v[2] + v[3] * v[3]); ss = red_xor<8>(ss);
                    const float rs = rsq_f(ss * (1.f / 64.f) + EPS);
#pragma unroll
                    for (int e = 0; e < 4; ++e) v[e] = v[e] * rs * (qk ? gkv[e] : gqv[e]);
                    if (qk == 0) { u32x2v o; o.x = pkc(v[0] * C64, v[1] * C64); o.y = pkc(v[2] * C64, v[3] * C64); *(u32x2v*)(Q + E_QN + q_off(4, 64, b, h, qi0 + t) + d0) = o; }
                    else { u32x2v o; o.x = pkc(v[0], v[1]); o.y = pkc(v[2], v[3]); *(LAS u32x2v*)(img + ((h * 8 + (d0 >> 3)) * 16 + t) * 16 + (d0 & 7) * 2) = o; }
                }
                {   const int hh = (t >> 2) & 1, j = (t & 3) + 4 * (t >> 3);
                    LAS unsigned short* vp = (LAS unsigned short*)(img + 8192 + ((h * 2 + hh) * 64 + d0) * 16 + j * 2);
                    vp[0] = (unsigned short)(wvv.x & 0xffff); vp[8] = (unsigned short)(wvv.x >> 16); vp[16] = (unsigned short)(wvv.y & 0xffff); vp[24] = (unsigned short)(wvv.y >> 16); }
            }
            }
            LDS_WAIT(); asm volatile("" ::: "memory");
#pragma unroll
            for (int i = 0; i < 8; ++i) { const int pc = lane + 64 * i; const int h2 = pc >> 7, ch = (pc >> 4) & 7, t = pc & 15;
                *(GAS v4u*)(Q + E_KN + k_off(4, 64, b, h2, qi0 + t, 8 * ch)) = *(const LAS v4u*)(img + pc * 16); }
#pragma unroll
            for (int i = 0; i < 8; ++i) { const int pc = lane + 64 * i; const int h2 = pc >> 7, hh = (pc >> 6) & 1, dv = pc & 63;
                *(GAS v4u*)(Q + E_VN + ((((size_t)(b * 4 + h2) * NKT + tile) * 8 + (sidx * 2 + hh)) * 64 + dv) * 8) = *(const LAS v4u*)(img + 8192 + pc * 16); }
        } else {
            const int h = lane >> 4, lh = lane & 15, d0 = 4 * lh;
            const int hk = lane >> 5, ll = lane & 31, dk0 = 2 * ll;
            const int tiq = ((lh & 8) ? 16 : 0) + 4 * (lh & 3), tik = ((ll & 16) ? 16 : 0) + 2 * (ll & 7); const bool rot = pos0 >= 0;
            const float* gq = inp(C, 25) + l * 64 + d0; const float* gk = inp(C, 26) + l * 64 + dk0;
            const float* ga = inp(C, 9) + l * 256 + 4 * lane; const float* gb = inp(C, 11) + l * 128 + 2 * lane;
            float gqv[4], gav[4], gkv[2], gbv[2];
#pragma unroll
            for (int e = 0; e < 4; ++e) { gqv[e] = gq[e]; gav[e] = ga[e]; }
            gkv[0] = gk[0]; gkv[1] = gk[1]; gbv[0] = gb[0]; gbv[1] = gb[1];
            for (int t0 = 0; t0 < 16; t0 += TB) {
            u32x2v wa4[TB], wq4[TB]; unsigned wb4[TB], wk4[TB], wv4[TB]; f32x4 rq4[TB][2], rk4[TB];
#pragma unroll
            for (int tt = 0; tt < TB; ++tt) { const bf16* pr = P + (size_t)(R0 + t0 + tt) * NINP; wa4[tt] = *(const u32x2v*)(pr + PC_CQ + 4 * lane); wq4[tt] = *(const u32x2v*)(pr + PC_GQ + 4 * lane);
                wb4[tt] = *(const unsigned*)(pr + PC_CKV + 2 * lane); wk4[tt] = *(const unsigned*)(pr + PC_GK + 2 * lane); wv4[tt] = *(const unsigned*)(pr + PC_GV + 2 * lane);
                const float* rp = rope64 + (rot ? pos0 + t0 + tt : 0) * 64; rq4[tt][0] = *(const f32x4*)(rp + 2 * tiq); rq4[tt][1] = *(const f32x4*)(rp + 2 * tiq + 4); rk4[tt] = *(const f32x4*)(rp + 2 * tik); }
#pragma unroll
            for (int tt = 0; tt < TB; ++tt) {
                const int t = t0 + tt; const int R = R0 + t;
                const u32x2v wa = wa4[tt], wq = wq4[tt]; const unsigned wb = wb4[tt], wk = wk4[tt], wvv = wv4[tt];
                {   float v[4] = {bflo(wa.x), bfhi(wa.x), bflo(wa.y), bfhi(wa.y)};
                    const float rs = rsq_f(wave_sum((v[0] * v[0] + v[1] * v[1]) + (v[2] * v[2] + v[3] * v[3])) * (1.f / 256.f) + EPS);
                    u32x2v o; o.x = pkc(v[0] * rs * gav[0], v[1] * rs * gav[1]); o.y = pkc(v[2] * rs * gav[2], v[3] * rs * gav[3]);
                    *(u32x2v*)(CQKV + (size_t)R * KMLA + 4 * lane) = o; }
                {   const float v0 = bflo(wb), v1 = bfhi(wb);
                    const float rs = rsq_f(wave_sum(v0 * v0 + v1 * v1) * (1.f / 128.f) + EPS);
                    *(unsigned*)(CQKV + (size_t)R * KMLA + 256 + 2 * lane) = pkc(v0 * rs * gbv[0], v1 * rs * gbv[1]); }
                {   float v[4] = {bflo(wq.x), bfhi(wq.x), bflo(wq.y), bfhi(wq.y)};
                    float ss = (v[0] * v[0] + v[1] * v[1]) + (v[2] * v[2] + v[3] * v[3]); ss = red_xor<8>(ss);
                    const float rs = rsq_f(ss * (1.f / 64.f) + EPS);
                    float y[4];
#pragma unroll
                    for (int e = 0; e < 4; ++e) y[e] = v[e] * rs * gqv[e];
#pragma unroll
                    for (int e = 0; e < 4; ++e) { const float pp = swz<4>(y[e]); const float cs = rot ? rq4[tt][e >> 1][2 * (e & 1)] : 1.f, sn = rot ? rq4[tt][e >> 1][2 * (e & 1) + 1] : 0.f;
                        v[e] = y[e] * cs + ((lh & 4) ? pp : -pp) * sn; }
                    u32x2v o; o.x = pkc(v[0] * C64, v[1] * C64); o.y = pkc(v[2] * C64, v[3] * C64); *(u32x2v*)(Q + E_QG + q_off(4, 64, b, h, qi0 + t) + d0) = o; }
                {   float v[2] = {bflo(wk), bfhi(wk)};
                    float ss = v[0] * v[0] + v[1] * v[1]; ss = red_xor<16>(ss);
                    const float rs = rsq_f(ss * (1.f / 64.f) + EPS);
                    float y[2] = {v[0] * rs * gkv[0], v[1] * rs * gkv[1]};
#pragma unroll
                    for (int e = 0; e < 2; ++e) { const float pp = swz<8>(y[e]); const float cs = rot ? rk4[tt][2 * e] : 1.f, sn = rot ? rk4[tt][2 * e + 1] : 0.f;
                        v[e] = y[e] * cs + ((ll & 8) ? pp : -pp) * sn; }
                    *(LAS unsigned*)(img + ((hk * 8 + (dk0 >> 3)) * 16 + t) * 16 + (dk0 & 7) * 2) = pkc(v[0], v[1]); }
                {   const int hh = (t >> 2) & 1, j = (t & 3) + 4 * (t >> 3);
                    LAS unsigned short* vp = (LAS unsigned short*)(img + 8192 + ((hk * 2 + hh) * 64 + dk0) * 16 + j * 2);
                    vp[0] = (unsigned short)(wvv & 0xffff); vp[8] = (unsigned short)(wvv >> 16); }
            }
            }
            LDS_WAIT(); asm volatile("" ::: "memory");
#pragma unroll
            for (int i = 0; i < 4; ++i) { const int pc = lane + 64 * i; const int h2 = pc >> 7, ch = (pc >> 4) & 7, t = pc & 15;
                *(GAS v4u*)(Q + E_KG + k_off(2, 64, b, h2, qi0 + t, 8 * ch)) = *(const LAS v4u*)(img + pc * 16); }
#pragma unroll
            for (int i = 0; i < 4; ++i) { const int pc = lane + 64 * i; const int h2 = pc >> 7, hh = (pc >> 6) & 1, dv = pc & 63;
                *(GAS v4u*)(Q + E_VG + ((((size_t)(b * 2 + h2) * NKT + tile) * 8 + (sidx * 2 + hh)) * 64 + dv) * 8) = *(const LAS v4u*)(img + 8192 + pc * 16); }
        }
        LDS_WAIT(); asm volatile("" ::: "memory");
    }
}

__device__ __forceinline__ void phase_prep2(const int wv, int l) {
    const Ctx C = make_ctx(wv);
    LAS unsigned char* img = C.lds + C.wave * 16384;
    bf16* Q = ((bf16*)(wsp(C) + WS_QKV));
    const bf16* P = (const bf16*)(wsp(C) + WS_P); const bf16* MLAP = (const bf16*)(wsp(C) + WS_MLAP);
    const float* rope32 = (const float*)(wsp(C) + WS_ROPE32);
    const float C96 = 0.10206207261596575f * LOG2E;
    const int lane = C.lane, h = lane >> 4, c = lane & 15; const bool on = c < 12;
    constexpr int TB = 4;
    for (int item = C.gw; item < 3 * (MT / 16); item += C.NGW) {
        const int pass = item / (MT / 16), g = item % (MT / 16), R0 = 16 * g;
        int b, qi0, pos0; row_info(R0, b, qi0, pos0);
        const int tile = qi0 >> 6, sidx = (qi0 >> 4) & 3;
        if (l == NL - 1 && pass == 0 && pos0 < 0) continue;
        const bool rot = pos0 >= 0;
        if (pass < 2) {
            float gv[8];
            { const float* gp = inp(C, pass ? 14 : 13) + l * 96 + 8 * (on ? c : 0);
#pragma unroll
              for (int e = 0; e < 8; ++e) gv[e] = gp[e]; }
            for (int t0 = 0; t0 < 16; t0 += TB) {
                v4u w4[TB]; f32x4 rt[TB][4];
#pragma unroll
                for (int tt = 0; tt < TB; ++tt) { const size_t R = R0 + t0 + tt;
                    const bf16* src = pass == 0 ? MLAP + R * NMLA + h * 96 + 8 * c : (c < 8 ? MLAP + R * NMLA + 512 + h * 128 + 8 * c : P + R * NINP + PC_KR + 8 * (c - 8));
                    const v4u z = {0u, 0u, 0u, 0u}; w4[tt] = on ? *(const GAS v4u*)src : z;
                    const float* rp = rope32 + ((rot ? pos0 + t0 + tt : 0) * 16 + (c >= 10 ? 8 : 0)) * 2;
#pragma unroll
                    for (int k4 = 0; k4 < 4; ++k4) rt[tt][k4] = *(const f32x4*)(rp + 4 * k4); }
#pragma unroll
                for (int tt = 0; tt < TB; ++tt) {
                    const int t = t0 + tt;
                    float v[8] = {bflo(w4[tt].x), bfhi(w4[tt].x), bflo(w4[tt].y), bfhi(w4[tt].y), bflo(w4[tt].z), bfhi(w4[tt].z), bflo(w4[tt].w), bfhi(w4[tt].w)};
                    float ss = ((v[0] * v[0] + v[1] * v[1]) + (v[2] * v[2] + v[3] * v[3])) + ((v[4] * v[4] + v[5] * v[5]) + (v[6] * v[6] + v[7] * v[7]));
                    ss = red_xor<8>(ss);
                    const float rs = rsq_f(ss * (1.f / 96.f) + EPS);
#pragma unroll
                    for (int e = 0; e < 8; ++e) v[e] = v[e] * rs * gv[e];
#pragma unroll
                    for (int e = 0; e < 8; ++e) { const float pp = swz<1>(v[e]); const bool rr = rot && c >= 8; const float cs = rr ? rt[tt][e >> 1][2 * (e & 1)] : 1.f, sn = rr ? rt[tt][e >> 1][2 * (e & 1) + 1] : 0.f;
                        v[e] = v[e] * cs + ((c & 1) ? pp : -pp) * sn; }
                    if (pass == 0) { v4u o; o.x = pkc(v[0] * C96, v[1] * C96); o.y = pkc(v[2] * C96, v[3] * C96); o.z = pkc(v[4] * C96, v[5] * C96); o.w = pkc(v[6] * C96, v[7] * C96);
                        if (on) *(GAS v4u*)(Q + E_QA + q_off(4, 96, b, h, qi0 + t) + 8 * c) = o; }
                    else { v4u o; o.x = pkc(v[0], v[1]); o.y = pkc(v[2], v[3]); o.z = pkc(v[4], v[5]); o.w = pkc(v[6], v[7]);
                        if (on) *(LAS v4u*)(img + ((h * 12 + c) * 16 + t) * 16) = o; }
                }
            }
            if (pass == 1) {
                LDS_WAIT(); asm volatile("" ::: "memory");
#pragma unroll
                for (int i = 0; i < 12; ++i) { const int pc = lane + 64 * i; const int h2 = pc / 192, ch = (pc >> 4) % 12, t = pc & 15;
                    *(GAS v4u*)(Q + E_KA + k_off(4, 96, b, h2, qi0 + t, 8 * ch)) = *(const LAS v4u*)(img + pc * 16); }
            }
        } else {
            for (int t0 = 0; t0 < 16; t0 += TB) {
                v4u w4[TB];
#pragma unroll
                for (int tt = 0; tt < TB; ++tt) { const size_t R = R0 + t0 + tt; const v4u z = {0u, 0u, 0u, 0u}; w4[tt] = c < 8 ? *(const GAS v4u*)(MLAP + R * NMLA + 512 + h * 128 + 64 + 8 * c) : z; }
#pragma unroll
                for (int tt = 0; tt < TB; ++tt) { const int t = t0 + tt, hh = (t >> 2) & 1, j = (t & 3) + 4 * (t >> 3);
                    LAS unsigned short* vp = (LAS unsigned short*)(img + ((h * 2 + hh) * 64 + 8 * c) * 16 + j * 2);
                    if (c < 8) { vp[0] = (unsigned short)(w4[tt].x & 0xffff); vp[8] = (unsigned short)(w4[tt].x >> 16); vp[16] = (unsigned short)(w4[tt].y & 0xffff); vp[24] = (unsigned short)(w4[tt].y >> 16);
                        vp[32] = (unsigned short)(w4[tt].z & 0xffff); vp[40] = (unsigned short)(w4[tt].z >> 16); vp[48] = (unsigned short)(w4[tt].w & 0xffff); vp[56] = (unsigned short)(w4[tt].w >> 16); } }
            }
            LDS_WAIT(); asm volatile("" ::: "memory");
#pragma unroll
            for (int i = 0; i < 8; ++i) { const int pc = lane + 64 * i; const int h2 = pc >> 7, hh = (pc >> 6) & 1, dv = pc & 63;
                *(GAS v4u*)(Q + E_VA + ((((size_t)(b * 4 + h2) * NKT + tile) * 8 + (sidx * 2 + hh)) * 64 + dv) * 8) = *(const LAS v4u*)(img + pc * 16); }
        }
        LDS_WAIT(); asm volatile("" ::: "memory");
    }
}

template <int DK, int HQ, int HK, int HV, bool NA>
__device__ __forceinline__ void naive_attn_one(const bf16* Qb, const bf16* Kb, const bf16* Vb, const float* rpb, int b, int hq, int hk, int hv, int qi, float (&o)[64]) {
    float q[DK];
    { const bf16* qp = Qb + q_off(HQ, DK, b, hq, qi);
#pragma unroll
      for (int c = 0; c < DK / 8; ++c) { const v4u w = *(const v4u*)(qp + 8 * c); q[8 * c] = bflo(w.x); q[8 * c + 1] = bfhi(w.x); q[8 * c + 2] = bflo(w.y); q[8 * c + 3] = bfhi(w.y); q[8 * c + 4] = bflo(w.z); q[8 * c + 5] = bfhi(w.z); q[8 * c + 6] = bflo(w.w); q[8 * c + 7] = bfhi(w.w); } }
    float m = -1e30f, ls = 0.f;
#pragma unroll
    for (int d = 0; d < 64; ++d) o[d] = 0.f;
    const bool isctx = qi >= SEQ;
    const int r = qi >> 6, qc = qi & 63;
    const int rs0 = min(max(r - 4, 0), 24), ws0 = min(max(qc - 8, 0), 48);
    const int nloc = isctx ? 0 : (NA ? 128 : SEQ);
    const int ntot = nloc + CTXL;
    for (int it = 0; it < ntot; ++it) {
        int key; float bias = 0.f;
        if (it < nloc) {
            if (NA) { const int kr = rs0 + (it >> 4), kc = ws0 + (it & 15); key = kr * 64 + kc; bias = rpb[(kr - r + 7) * 31 + min(max(kc - qc + 15, 0), 30)] * LOG2E; }
            else key = it;
        } else key = SEQ + (it - nloc);
        float s = bias;
#pragma unroll
        for (int c = 0; c < DK / 8; ++c) { const v4u w = *(const v4u*)(Kb + k_off(HK, DK, b, hk, key, 8 * c));
            s += q[8 * c] * bflo(w.x) + q[8 * c + 1] * bfhi(w.x) + q[8 * c + 2] * bflo(w.y) + q[8 * c + 3] * bfhi(w.y) + q[8 * c + 4] * bflo(w.z) + q[8 * c + 5] * bfhi(w.z) + q[8 * c + 6] * bflo(w.w) + q[8 * c + 7] * bfhi(w.w); }
        if (s > m) { const float a = exp2f(m - s); ls *= a;
#pragma unroll
            for (int d = 0; d < 64; ++d) o[d] *= a;
            m = s; }
        const float p = exp2f(s - m); ls += p;
        const bf16* vp = Vb + v_off(HV, b, hv, key, 0);
#pragma unroll
        for (int d = 0; d < 64; ++d) { o[d] += p * bf2f(vp[8 * d]); if ((d & 15) == 15) asm volatile("" ::: "memory"); }
    }
    const float inv = 1.f / ls;
#pragma unroll
    for (int d = 0; d < 64; ++d) o[d] *= inv;
}
__device__ __forceinline__ void store_mix(const Ctx& C, int b, int qi, int col0, const float (&o)[64]) {
    const size_t R = qi < SEQ ? (size_t)b * SEQ + qi : (size_t)ML + b * CTXL + (qi - SEQ);
    bf16* dst = ((bf16*)(wsp(C) + WS_MIX)) + R * DM + col0;
#pragma unroll
    for (int d = 0; d < 64; d += 8) { v4u w; w.x = pkc(o[d], o[d + 1]); w.y = pkc(o[d + 2], o[d + 3]); w.z = pkc(o[d + 4], o[d + 5]); w.w = pkc(o[d + 6], o[d + 7]); *(v4u*)(dst + d) = w; }
}
__device__ __forceinline__ void phase_attn_naive(const int wv, int l) {
    const Ctx C = make_ctx(wv);
    const bf16* Q = ((bf16*)(wsp(C) + WS_QKV));
    const int gt = C.gw * 64 + C.lane, NGT = C.NGW * 64;
    constexpr int PER = NB * 4 * NKEY;
    for (int idx = gt; idx < 5 * PER; idx += NGT) {
        const int mixer = idx < 3 * PER ? idx / PER : 3;
        const int r0 = mixer < 3 ? idx % PER : (idx - 3 * PER) >> 1, pair = idx & 1;
        const int b = r0 / (4 * NKEY), h = (r0 / NKEY) % 4, qi = r0 % NKEY;
        if (l == NL - 1 && qi >= SEQ) continue;
        float o[64];
        if (mixer == 0) { naive_attn_one<96, 4, 4, 4, false>(Q + E_QA, Q + E_KA, Q + E_VA, nullptr, b, h, h, h, qi, o); store_mix(C, b, qi, h * 64, o); }
        else if (mixer == 1) { naive_attn_one<64, 4, 4, 4, true>(Q + E_QN, Q + E_KN, Q + E_VN, inp(C, 24) + (size_t)(l * 4 + h) * 15 * 31, b, h, h, h, qi, o); store_mix(C, b, qi, 512 + h * 64, o); }
        else if (mixer == 2) { naive_attn_one<64, 4, 2, 2, false>(Q + E_QG, Q + E_KG, Q + E_VG, nullptr, b, h, h >> 1, h >> 1, qi, o); store_mix(C, b, qi, 768 + h * 64, o); }
        else {
            naive_attn_one<32, 8, 8, 4, false>(Q + E_QD, Q + E_KD, Q + E_VD, nullptr, b, 2 * h + pair, 2 * h + pair, h, qi, o);
            float s1 = 0.f, s2 = 0.f;
            for (int d = 0; d < 32; ++d) { s1 += inp(C, 17)[l * 32 + d] * inp(C, 18)[l * 32 + d]; s2 += inp(C, 19)[l * 32 + d] * inp(C, 20)[l * 32 + d]; }
            const float li = lambda_init(l), lam = expf(s1) - expf(s2) + li;
            float ss = 0.f;
#pragma unroll
            for (int d = 0; d < 64; ++d) { const float other = swz<1>(o[d]); o[d] = o[d] - lam * other; ss += o[d] * o[d]; }
            const float rs = rsq_f(ss * (1.f / 64.f) + EPS);
#pragma unroll
            for (int d = 0; d < 64; ++d) o[d] = o[d] * rs * inp(C, 21)[l * 64 + d] * (1.f - li);
            if (pair == 0) store_mix(C, b, qi, 256 + h * 64, o);
        }
    }
}

__device__ __forceinline__ void phase_fixup(const int wv, int l) {
    const Ctx C = make_ctx(wv);
    const int gt = C.gw * 64 + C.lane, NGT = C.NGW * 64;
    const float* cw = inp(C, 29) + (size_t)l * 3 * NUP; const float* cb = inp(C, 30) + (size_t)l * NUP;
    for (int idx = gt; idx < 56 * 2 * DFF; idx += NGT) {
        const int j = idx % DFF, w = (idx / DFF) & 1, bi = idx / (2 * DFF), pm = (bi / 7) * 8 + (bi % 7);
        const float* h0 = ((float*)(wsp(C) + WS_HALO)) + (size_t)pm * 4 * NUP; const float* h1 = h0 + 4 * NUP;
        float cva[2];
#pragma unroll
        for (int t = 0; t < 2; ++t) { const int c = t * DFF + j;
            const float up = w == 0 ? h0[2 * NUP + c] : h0[3 * NUP + c], uc = w == 0 ? h0[3 * NUP + c] : h1[c], un = w == 0 ? h1[c] : h1[NUP + c];
            cva[t] = cw[c] * up + cw[NUP + c] * uc + cw[2 * NUP + c] * un + cb[c]; }
        const size_t row = (size_t)pm * 256 + 255 + w;
        ((bf16*)(wsp(C) + WS_ACT))[row * DFF + j] = (bf16)f2bf(pg8::silu1(cva[1]) * cva[0]);
    }
}

#ifndef ATT_KNOB
#define ATT_KNOB 0
#endif
#if ATT_KNOB == 1
#define ATT_SB() do { if (NP == 2) __builtin_amdgcn_sched_barrier(0); } while (0)
#define ATT_PRIO(x) __builtin_amdgcn_s_setprio(x)
#elif ATT_KNOB == 2
#define ATT_SB() __builtin_amdgcn_sched_barrier(0)
#define ATT_PRIO(x) do {} while (0)
#else
#define ATT_SB() __builtin_amdgcn_sched_barrier(0)
#define ATT_PRIO(x) __builtin_amdgcn_s_setprio(x)
#endif
namespace att {
typedef float f32x16 __attribute__((ext_vector_type(16)));
typedef __bf16 bf16x2_t __attribute__((ext_vector_type(2)));
__device__ __forceinline__ unsigned cvtpk(float lo, float hi) { f32x2v v = {lo, hi}; bf16x2_t b = __builtin_convertvector(v, bf16x2_t); return __builtin_bit_cast(unsigned, b); }
__device__ __forceinline__ int crow(int r, int hi) { return (r & 3) + 8 * (r >> 2) + 4 * hi; }
constexpr int BUF0 = 0, BUFSZ = 20480, WSC = 4 * BUFSZ  , WSCSZ = 4224, RPB = WSC + 8 * WSCSZ  , RPB_TAB = RPB + 512;
static_assert(RPB_TAB + 15 * 31 * 4 + 1024 <= RING_BYTES, "attention LDS map");

struct UnitDesc { int b, hq0, hk0, hv, q0, t_lo, n_loc, col0; };

template <int DK, int NP, bool NA>
__device__ __forceinline__ void attn_unit(const Ctx& C, const bf16* Qb, int HQ, const bf16* Kb, int HK, const bf16* Vb, int HV, const UnitDesc U, const float Mb,
                                          const float* rpb  , const float lam, const float* subg, const float osc, bf16* MIX) {
    constexpr int KS = DK / 16;
    constexpr int KP = NP * DK * 8;
    constexpr int NLD = (KP + 512 + 511) / 512;
    const int lane = C.lane, wave = C.wave, tid = C.tid, c31 = lane & 31, hi = lane >> 5;
    LAS unsigned char* L = C.lds;
    const int n_it = U.n_loc + 4;
    constexpr int NI = (KP + 512) / 64;
    auto tile_of = [&](int it) { return it < U.n_loc ? U.t_lo + it : 32 + (it - U.n_loc); };
    const int n_st = (n_it + 1) >> 1;
#define ATT_ISSUE(st) do { _Pragma("unroll") for (int tt_ = 0; tt_ < 2; ++tt_) { const int it_ = 2 * (st) + tt_; if (it_ < n_it) { const int tile_ = tile_of(it_); \
        const unsigned dst_ = (unsigned)(((st) & 1) * 2 + tt_) * BUFSZ; \
        _Pragma("unroll") for (int j_ = 0; j_ < (NI + 7) / 8; ++j_) { const int ji = wave + 8 * j_; if (ji < NI) { const int pi = ji * 64 + lane; const bf16* src; \
            if (ji * 64 < KP) { const int ps = (ji * 64) / (DK * 8), pr = pi - ps * (DK * 8); src = Kb + ((size_t)((U.b * HK + U.hk0 + ps) * NKT + tile_)) * (DK * 64) + pr * 8; } \
            else src = Vb + ((size_t)((U.b * HV + U.hv) * NKT + tile_)) * 4096 + (pi - KP) * 8; \
            __builtin_amdgcn_global_load_lds((const unsigned*)src, (LAS unsigned*)(L + dst_ + ji * 1024), 16, 0, 0); } } } } } while (0)
    ATT_ISSUE(0);
    bf16x8 qf[NP][KS];
    const int qrow = U.q0 + wave * 32 + c31;
#pragma unroll
    for (int p = 0; p < NP; ++p) { const bf16* qp = Qb + q_off(HQ, DK, U.b, U.hq0 + p, qrow) + 8 * hi;
#pragma unroll
        for (int ks = 0; ks < KS; ++ks) qf[p][ks] = *(const bf16x8*)(qp + 16 * ks); }
    int my_lo = 0, my_r = 0;
    if (NA) {
        for (int i = tid; i < 15 * 31; i += 512) ((LAS float*)(L + RPB_TAB))[i] = rpb[i] * LOG2E;
        my_r = (U.q0 >> 6) + (wave >> 1); my_lo = min(max(my_r - 4, 0), 24);
    }
    f32x16 o[NP][2]; f32x16 lacc[NP];
    const bf16x8 ones = {0x3f80, 0x3f80, 0x3f80, 0x3f80, 0x3f80, 0x3f80, 0x3f80, 0x3f80};
#pragma unroll
    for (int p = 0; p < NP; ++p) {
#pragma unroll
        for (int r = 0; r < 16; ++r) lacc[p][r] = 0.f;
#pragma unroll
        for (int d0 = 0; d0 < 2; ++d0)
#pragma unroll
            for (int r = 0; r < 16; ++r) o[p][d0][r] = 0.f; }
    const float shift = Mb > 40.f ? Mb - 40.f : 0.f;
#define ATT_KLOAD(KF_, KB_) do { _Pragma("unroll") for (int p_ = 0; p_ < NP; ++p_) _Pragma("unroll") for (int ks_ = 0; ks_ < KS; ++ks_) { \
        KF_[p_][2 * ks_] = *(const LAS bf16x8*)((KB_) + p_ * (DK * 128) + (2 * ks_ + hi) * 1024 + c31 * 16); \
        KF_[p_][2 * ks_ + 1] = *(const LAS bf16x8*)((KB_) + p_ * (DK * 128) + (2 * ks_ + hi) * 1024 + 512 + c31 * 16); } } while (0)
#define ATT_TILE(KF_, KB_, TILE_, LOCAL_, PF_) do { \
        const LAS unsigned char* vb_ = (KB_) + KP * 16; bf16x8 vf[8]; \
        _Pragma("unroll") for (int p = 0; p < NP; ++p) { \
            f32x16 p0, p1; \
            _Pragma("unroll") for (int r = 0; r < 16; ++r) { p0[r] = 0.f; p1[r] = 0.f; } \
            ATT_SB(); ATT_PRIO(1); \
            _Pragma("unroll") for (int ks = 0; ks < KS; ++ks) { \
                p0 = __builtin_amdgcn_mfma_f32_32x32x16_bf16(KF_[p][2 * ks], qf[p][ks], p0, 0, 0, 0); \
                p1 = __builtin_amdgcn_mfma_f32_32x32x16_bf16(KF_[p][2 * ks + 1], qf[p][ks], p1, 0, 0, 0); } \
            ATT_PRIO(0); ATT_SB(); \
            if (p == 0) { _Pragma("unroll") for (int s_ = 0; s_ < 4; ++s_) _Pragma("unroll") for (int d0 = 0; d0 < 2; ++d0) vf[2 * s_ + d0] = *(const LAS bf16x8*)(vb_ + ((2 * s_ + hi) * 64 + 32 * d0 + c31) * 16); } \
            if (p == NP - 1) { PF_; } \
            ATT_SB(); \
            if (shift > 0.f) { _Pragma("unroll") for (int r = 0; r < 16; ++r) { p0[r] -= shift; p1[r] -= shift; } } \
            if (LOCAL_) { \
                const int qc = (wave & 1) * 32 + c31, ws = min(max(qc - 8, 0), 48); \
                const LAS float* bt = (const LAS float*)(L + RPB_TAB) + ((TILE_) - my_r + 7) * 31 + 15 - qc + 4 * hi; \
                const int kb0 = 4 * hi - ws; \
                _Pragma("unroll") for (int r = 0; r < 16; ++r) { const int kc = (r & 3) + 8 * (r >> 2); \
                    const float b0 = bt[kc], b1 = bt[kc + 32]; \
                    p0[r] = ((unsigned)(kc + kb0) < 16u) ? __builtin_amdgcn_exp2f(p0[r] + b0) : 0.f; \
                    p1[r] = ((unsigned)(kc + 32 + kb0) < 16u) ? __builtin_amdgcn_exp2f(p1[r] + b1) : 0.f; } \
            } else { \
                _Pragma("unroll") for (int r = 0; r < 16; ++r) { p0[r] = __builtin_amdgcn_exp2f(p0[r]); p1[r] = __builtin_amdgcn_exp2f(p1[r]); } \
            } \
            v4u pa[4]; \
            pa[0].x = cvtpk(p0[0], p0[1]); pa[0].y = cvtpk(p0[2], p0[3]); pa[0].z = cvtpk(p0[4], p0[5]); pa[0].w = cvtpk(p0[6], p0[7]); \
            pa[1].x = cvtpk(p0[8], p0[9]); pa[1].y = cvtpk(p0[10], p0[11]); pa[1].z = cvtpk(p0[12], p0[13]); pa[1].w = cvtpk(p0[14], p0[15]); \
            pa[2].x = cvtpk(p1[0], p1[1]); pa[2].y = cvtpk(p1[2], p1[3]); pa[2].z = cvtpk(p1[4], p1[5]); pa[2].w = cvtpk(p1[6], p1[7]); \
            pa[3].x = cvtpk(p1[8], p1[9]); pa[3].y = cvtpk(p1[10], p1[11]); pa[3].z = cvtpk(p1[12], p1[13]); pa[3].w = cvtpk(p1[14], p1[15]); \
            ATT_SB(); ATT_PRIO(1); \
            _Pragma("unroll") for (int s_ = 0; s_ < 4; ++s_) { _Pragma("unroll") for (int d0 = 0; d0 < 2; ++d0) \
                o[p][d0] = __builtin_amdgcn_mfma_f32_32x32x16_bf16(__builtin_bit_cast(bf16x8, pa[s_]), vf[2 * s_ + d0], o[p][d0], 0, 0, 0); \
                lacc[p] = __builtin_amdgcn_mfma_f32_32x32x16_bf16(__builtin_bit_cast(bf16x8, pa[s_]), ones, lacc[p], 0, 0, 0); } \
            ATT_PRIO(0); ATT_SB(); \
        } } while (0)
    asm volatile("s_waitcnt vmcnt(0)" ::: "memory"); __syncthreads();
    bf16x8 kfA[NP][2 * KS], kfB[NP][2 * KS];
    for (int st = 0; st < n_st; ++st) {
        if (st + 1 < n_st) ATT_ISSUE(st + 1);
        const int it0 = 2 * st, it1 = it0 + 1;
        const int tile0 = tile_of(it0), tile1 = tile_of(it1);
        const bool has1 = it1 < n_it;
        const bool loc0 = NA && it0 < U.n_loc, loc1 = NA && it1 < U.n_loc;
        const bool act0 = !loc0 || (tile0 >= my_lo && tile0 < my_lo + 8), act1 = has1 && (!loc1 || (tile1 >= my_lo && tile1 < my_lo + 8));
        const LAS unsigned char* kb0p = L + ((st & 1) * 2) * BUFSZ; const LAS unsigned char* kb1p = kb0p + BUFSZ;
        if (act0) {
            ATT_KLOAD(kfA, kb0p);
            if (NP == 1) { ATT_TILE(kfA, kb0p, tile0, loc0, if (act1) ATT_KLOAD(kfB, kb1p)); }
            else { ATT_TILE(kfA, kb0p, tile0, loc0, (void)0); }
        }
        if (act1) {
            if (NP != 1 || !act0) ATT_KLOAD(kfB, kb1p);
            ATT_TILE(kfB, kb1p, tile1, loc1, (void)0);
        }
        asm volatile("s_waitcnt vmcnt(0)" ::: "memory"); __syncthreads();
    }
#undef ATT_TILE
#undef ATT_KLOAD
#undef ATT_ISSUE
    LAS float* lsc = (LAS float*)(L + WSC + wave * WSCSZ);
    LAS unsigned short* ost = (LAS unsigned short*)(L + WSC + wave * WSCSZ + 128);
#pragma unroll
    for (int p = 0; p < NP; ++p) {
#pragma unroll
        for (int r = 0; r < 16; ++r) { const float iv = __builtin_amdgcn_rcpf(lacc[p][r]); o[p][0][r] *= iv; o[p][1][r] *= iv; }
        __builtin_amdgcn_sched_barrier(0);
    }
    f32x16 (&res)[2] = o[0];
    if (NP == 2) {
        const float g0 = subg[c31] * osc, g1 = subg[32 + c31] * osc;
#pragma unroll
        for (int r = 0; r < 16; ++r) { res[0][r] -= lam * o[NP - 1][0][r]; res[1][r] -= lam * o[NP - 1][1][r];
            float ss = res[0][r] * res[0][r] + res[1][r] * res[1][r];
            ss += swz<1>(ss); ss += swz<2>(ss); ss += swz<4>(ss); ss += swz<8>(ss); ss += swz<16>(ss);
            const float rs = rsq_f(ss * (1.f / 64.f) + EPS); res[0][r] *= rs * g0; res[1][r] *= rs * g1; }
    }
#pragma unroll
    for (int r = 0; r < 16; ++r)
#pragma unroll
        for (int d0 = 0; d0 < 2; ++d0) ost[crow(r, hi) * 64 + d0 * 32 + c31] = (unsigned short)pkc1(res[d0][r]);
    LDS_WAIT(); asm volatile("" ::: "memory");
    {
        const int qw = U.q0 + wave * 32;
        const size_t R0 = qw < SEQ ? (size_t)U.b * SEQ + qw : (size_t)ML + U.b * CTXL + (qw - SEQ);
#pragma unroll
        for (int i = 0; i < 4; ++i) { const int row = i * 8 + (lane >> 3), ch = lane & 7;
            const v4u v = *(const LAS v4u*)(ost + row * 64 + ch * 8);
            *(GAS v4u*)(MIX + (R0 + row) * DM + U.col0 + ch * 8) = v; }
    }
    LDS_WAIT(); asm volatile("" ::: "memory");
    __syncthreads();
}
}

__device__ __forceinline__ float maxabs_n(const float* g, int n, int lane) { float m = 0.f; for (int i = lane; i < n; i += 64) m = fmaxf(m, fabsf(g[i]));
    m = fmaxf(m, swz<1>(m)); m = fmaxf(m, swz<2>(m)); m = fmaxf(m, swz<4>(m)); m = fmaxf(m, swz<8>(m)); m = fmaxf(m, swz<16>(m)); return max32(m); }

template <int TY>
__device__ __forceinline__ void phase_attn_ty(const int wv, int l) {
    const Ctx C = make_ctx(wv);
    const bf16* Q = ((const bf16*)(wsp(C) + WS_QKV)); bf16* MIX = (bf16*)(wsp(C) + WS_MIX);
    const int NUT = (l == NL - 1) ? 256 : 384;
    const int vcu = C.gw >> 3;
    float Mb, lam = 0.f, osc = 1.f; const float* subg = nullptr;
    if (TY == 0) { Mb = LOG2E * 5.656854249492381f * maxabs_n(inp(C, 15) + l * 32, 32, C.lane) * maxabs_n(inp(C, 16) + l * 32, 32, C.lane);
        float s1 = 0.f, s2 = 0.f;
        for (int d = 0; d < 32; ++d) { s1 += inp(C, 17)[l * 32 + d] * inp(C, 18)[l * 32 + d]; s2 += inp(C, 19)[l * 32 + d] * inp(C, 20)[l * 32 + d]; }
        const float li = lambda_init(l); lam = expf(s1) - expf(s2) + li; osc = 1.f - li; subg = inp(C, 21) + l * 64; }
    else if (TY == 1) Mb = LOG2E * 9.797958971132712f * maxabs_n(inp(C, 13) + l * 96, 96, C.lane) * maxabs_n(inp(C, 14) + l * 96, 96, C.lane);
    else if (TY == 2) Mb = LOG2E * 8.f * maxabs_n(inp(C, 25) + l * 64, 64, C.lane) * maxabs_n(inp(C, 26) + l * 64, 64, C.lane);
    else Mb = LOG2E * 8.f * maxabs_n(inp(C, 22) + l * 64, 64, C.lane) * maxabs_n(inp(C, 23) + l * 64, 64, C.lane) + LOG2E * maxabs_n(inp(C, 24) + (size_t)l * 4 * 15 * 31, 4 * 15 * 31, C.lane);
    Mb = __uint_as_float(__builtin_amdgcn_readfirstlane(__float_as_uint(Mb)));
    for (int uu = vcu; uu < NUT; uu += C.G) {
        att::UnitDesc U; int h;
        if (uu < 256) { h = (uu >> 3) & 3; U.b = uu >> 5; U.q0 = (uu & 7) * 256; U.t_lo = 0; U.n_loc = 32; }
        else { const int i_ = uu - 256; if ((i_ >> 5) != TY) continue; h = i_ & 3; U.b = (i_ >> 2) & 7; U.q0 = SEQ; U.t_lo = 32; U.n_loc = 0; }
        if (TY == 0) { U.hq0 = 2 * h; U.hk0 = 2 * h; U.hv = h; U.col0 = 256 + 64 * h; att::attn_unit<32, 2, false>(C, Q + E_QD, 8, Q + E_KD, 8, Q + E_VD, 4, U, Mb, nullptr, lam, subg, osc, MIX); }
        else if (TY == 1) { U.hq0 = h; U.hk0 = h; U.hv = h; U.col0 = 64 * h; att::attn_unit<96, 1, false>(C, Q + E_QA, 4, Q + E_KA, 4, Q + E_VA, 4, U, Mb, nullptr, 0.f, nullptr, 1.f, MIX); }
        else if (TY == 2) { U.hq0 = h; U.hk0 = h >> 1; U.hv = h >> 1; U.col0 = 768 + 64 * h; att::attn_unit<64, 1, false>(C, Q + E_QG, 4, Q + E_KG, 2, Q + E_VG, 2, U, Mb, nullptr, 0.f, nullptr, 1.f, MIX); }
        else { if (uu < 256) { const int r0 = U.q0 >> 6; U.t_lo = min(max(r0 - 4, 0), 24); U.n_loc = min(max(r0 - 1, 0), 24) + 8 - U.t_lo; }
            U.hq0 = h; U.hk0 = h; U.hv = h; U.col0 = 512 + 64 * h; att::attn_unit<64, 1, true>(C, Q + E_QN, 4, Q + E_KN, 4, Q + E_VN, 4, U, Mb, inp(C, 24) + (size_t)(l * 4 + h) * 15 * 31, 0.f, nullptr, 1.f, MIX); }
    }
}
__device__ __forceinline__ void phase_attn(const int wv, int l) { phase_attn_ty<0>(wv, l); phase_attn_ty<1>(wv, l); phase_attn_ty<2>(wv, l); phase_attn_ty<3>(wv, l); }

#ifndef ATTN_NAIVE
#define ATTN_NAIVE 0
#endif
#ifndef PROBE_REP_S
#define PROBE_REP_S -1
#endif
#ifndef PROBE_PRO
#define PROBE_PRO 0
#endif
#ifndef MK_PER_PHASE
#define MK_PER_PHASE 0
#endif
constexpr int PH_PRO = 0, PH_NORM0 = 1, PH_L0 = 2, PH_PER_LAYER = 11 + (PROBE_REP_S >= 0 ? 1 : 0);
constexpr int N_PHASES = PH_L0 + NL * PH_PER_LAYER - 1;
struct Args { const float* in[32]; float* out; unsigned char* ws; int ph_lo, ph_hi; };

__global__ void __launch_bounds__(NWAVES * 64, 2) fwd_kernel(Args args) {
    const int wv = __builtin_amdgcn_readfirstlane((int)threadIdx.x >> 6);
    const Ctx C = make_ctx(wv);
    for (int u = C.tid; u < 1024 / 4; u += NWAVES * 64) ((LAS unsigned*)(C.lds + LDSCTL_OFF))[u] = 0u;
    __syncthreads();
    if (C.tid < 34) ((LAS unsigned long long*)(C.lds + PT_OFF))[C.tid] = ((const __attribute__((address_space(4))) unsigned long long*)__builtin_amdgcn_kernarg_segment_ptr())[C.tid];
    volatile LAS unsigned* MISC = (volatile LAS unsigned*)(C.lds + MISC_OFF);
    __syncthreads();
    gu32* ctl = (gu32*)(wsp(C) + WS_CTL);
    XcdBarrier bar; bar.bar = (unsigned*)(ctl + CW_BAR); bar.x = 0; bar.st = nullptr; bar.wv = wv;
    const bool multi = (args.ph_hi - args.ph_lo) > 1;
    if (multi) { bar = xcd_barrier_post((unsigned*)(ctl + CW_BAR), MISC + 8); bar.wv = wv; }

    for (int ph = args.ph_lo; ph < args.ph_hi; ++ph) {
        const Ctx C = make_ctx(wv);
        if (ph == PH_PRO) { phase_prologue(wv);
#if PROBE_PRO
            __syncthreads(); phase_prologue(wv);
#endif
        }
        else if (ph == PH_NORM0) phase_norm(wv, 0, 1, MT);
        else {
            const int l = (ph - PH_L0) / PH_PER_LAYER, s_raw = (ph - PH_L0) % PH_PER_LAYER, s = (PROBE_REP_S >= 0 && s_raw > PROBE_REP_S) ? s_raw - 1 : s_raw;
            const int Mrows = (l == NL - 1) ? ML : MT;
            {
            if (s == 0 || s == 2) {
                const bool mla = s == 2;
                pg8::Gemm g{mla ? (bf16*)(wsp(C) + WS_CQKV) : (bf16*)(wsp(C) + WS_XN), wptr(C, l, mla ? W_MLA : W_IN), MT, mla ? NMLA : NINP, mla ? KMLA : DM}; pg8::StaticOrder S; S.init(MT, mla ? NMLA : NINP, C.G, (int)blockIdx.x);
                pg8::EpiBf16<0> E{mla ? (bf16*)(wsp(C) + WS_MLAP) : (bf16*)(wsp(C) + WS_P), mla ? NMLA : NINP, nullptr, 0, 0, 1.f};
                pg8::gemm_phase<pg8::EpiBf16<0>, pg8::StaticOrder, true, true>(C.lds + RING_OFF, g, S, E, C.wave);
            } else if (s == 1) phase_prep1(wv, l);
            else if (s == 3) phase_prep2(wv, l);
#if ATTN_NAIVE
            else if (s == 4) phase_attn_naive(wv, l);
#else
            else if (s == 4) phase_attn(wv, l);
#endif
            else if (s == 5 || s == 9) {
                const bool dn = s == 9;
                pg8::Gemm g{dn ? (bf16*)(wsp(C) + WS_ACT) : (bf16*)(wsp(C) + WS_MIX), wptr(C, l, dn ? W_DOWN : W_OUT), Mrows, DM, dn ? DFF : DM}; pg8::SplitOrder S; S.init(C.G, (int)blockIdx.x, l != NL - 1, dn ? DFF / 64 : DM / 64);
                const bool first = (l == 0 && !dn);
                pg8::EpiResGate E{first ? inp(C, 0) : outp(C), first ? inp(C, 2) : (float*)(wsp(C) + WS_XC), outp(C), (float*)(wsp(C) + WS_XC), (float*)(wsp(C) + WS_MODS) + (size_t)l * 9 * 6144 + (dn ? 5120 : 2048), (float*)(wsp(C) + WS_SLAB), (PROBE_REP_S >= 0 && s_raw == PROBE_REP_S) ? 1 : 0};
                pg8::gemm_phase<pg8::EpiResGate, pg8::SplitOrder, true, true>(C.lds + RING_OFF, g, S, E, C.wave);
            } else if (s == 6) phase_norm(wv, l, 2, Mrows);
            else if (s == 7) {
                pg8::Gemm g{(bf16*)(wsp(C) + WS_XN), wptr(C, l, W_UP), Mrows, NUP, DM}; pg8::StaticOrder S; S.init(Mrows, NUP, C.G, (int)blockIdx.x);
                pg8::EpiConvGate E{(bf16*)(wsp(C) + WS_ACT), (float*)(wsp(C) + WS_HALO), inp(C, 29) + (size_t)l * 3 * NUP, inp(C, 30) + (size_t)l * NUP, (PG8_LAS float*)(C.lds + EX_OFF)};
                pg8::gemm_phase<pg8::EpiConvGate, pg8::StaticOrder, true, true>(C.lds + RING_OFF, g, S, E, C.wave);
            } else if (s == 8) phase_fixup(wv, l);
            else phase_norm(wv, l + 1, 1, MT);
            }
        }
        if (ph + 1 < args.ph_hi) { XcdBarrier bb = bar; asm volatile("" : "+s"(bb.bar), "+s"(bb.x)); xcd_barrier(bb); }
    }
}

extern "C" void kernel_launch(void* const* d_in, const int* in_sizes, int n_in, void* d_out, int out_size, void* d_ws, size_t ws_size, hipStream_t stream) {
    static int grid = 0;
    if (grid == 0) {
        if (n_in != 32 || out_size != ML * DM || ws_size < WS_END) { fprintf(stderr, "kernel_launch: unexpected shapes (n_in %d out %d ws %zu)\n", n_in, out_size, ws_size); grid = -1; return; }
        int dev = 0, cus = 0;
        if (hipGetDevice(&dev) != hipSuccess || hipDeviceGetAttribute(&cus, hipDeviceAttributeMultiprocessorCount, dev) != hipSuccess) { grid = -1; return; }
        if (hipFuncSetAttribute((const void*)fwd_kernel, hipFuncAttributeMaxDynamicSharedMemorySize, LDS_BYTES) != hipSuccess) { fprintf(stderr, "kernel_launch: hipFuncSetAttribute failed\n"); grid = -1; return; }
        (void)hipGetLastError();
        grid = cus;
    }
    if (grid < 0) return;
    (void)hipMemsetAsync((char*)d_ws + WS_CTL, 0, CTL_ZERO_BYTES, stream);
    Args a{};
    for (int i = 0; i < 32; ++i) a.in[i] = (const float*)d_in[i];
    a.out = (float*)d_out; a.ws = (unsigned char*)d_ws;
#if MK_PER_PHASE
    for (int ph = 0; ph < N_PHASES; ++ph) { a.ph_lo = ph; a.ph_hi = ph + 1; hipLaunchKernelGGL(fwd_kernel, dim3(grid), dim3(NWAVES * 64), LDS_BYTES, stream, a); }
#else
    a.ph_lo = 0; a.ph_hi = N_PHASES; hipLaunchKernelGGL(fwd_kernel, dim3(grid), dim3(NWAVES * 64), LDS_BYTES, stream, a);
#endif
}
```

```cpp
#include <hip/hip_runtime.h>
#include <cstdio>
#include <cstdint>
__device__ __forceinline__ int otid(int wv) { int l; asm volatile("v_mbcnt_lo_u32_b32 %0, -1, 0\n\tv_mbcnt_hi_u32_b32 %0, -1, %0" : "=v"(l)); return wv * 64 + l; }
namespace pg8 {
#define PG8_LAS __attribute__((address_space(3)))
typedef unsigned short bf16_t;
typedef short bf16x8 __attribute__((ext_vector_type(8)));
typedef float f32x4 __attribute__((ext_vector_type(4)));
typedef unsigned u32x4 __attribute__((ext_vector_type(4)));
constexpr int BM = 256, BK = 64, HALF = 128, HTB = HALF * BK * 2  , STAGE_BYTES = 8 * HTB, NXCD = 8, WGM = 8;

__host__ __device__ __forceinline__ int lds_byte(int r, int c) { const int st = (r >> 4) * 2 + (c >> 5), rr = r & 15, cc = c & 31, ob = rr * 64 + cc * 2; return st * 1024 + (ob ^ (((ob >> 9) & 1) << 5)); }
__host__ __device__ __forceinline__ void stage_rc(int b, int& R, int& C) { const int st = b / 1024, sb = b % 1024, swz = sb ^ (((sb >> 9) & 1) << 5); R = (st >> 1) * 16 + swz / 64; C = (st & 1) * 32 + (swz % 64) / 2; }
__host__ __device__ __forceinline__ int perm32(int rho) { const int n = rho >> 4, i = rho & 15; return 8 * (i >> 2) + 4 * n + (i & 3); }

struct Unit { int pm, pn, kb, nt, sp; };
struct Gemm { const bf16_t* A; const bf16_t* Bt; int M, N, K; };

struct StaticOrder {
    int nM, nN, nwg, G, c;
    __host__ __device__ void init(int M, int N, int G_, int c_) { nM = M / BM; nN = N / BM; nwg = nM * nN; G = G_; c = c_; }
    __host__ __device__ __forceinline__ bool next(int i, Unit& u) const {
        const long L = (long)i * G + c; if (L >= nwg) { u.pm = 0; u.pn = 0; u.kb = 0; u.nt = 0; u.sp = 0; return false; }
        int wgid = (int)L; { const int q = nwg / NXCD, r = nwg % NXCD, xcd = wgid % NXCD, off = wgid / NXCD; wgid = (xcd < r ? xcd * (q + 1) : r * (q + 1) + (xcd - r) * q) + off; }
        const int nig = WGM * nN, gid = wgid / nig, fm = gid * WGM, gsz = (nM - fm) < WGM ? (nM - fm) : WGM;
        u.pm = fm + ((wgid % nig) % gsz); u.pn = (wgid % nig) / gsz; u.kb = 0; u.nt = 0; u.sp = 0; return true;
    }
    __device__ __forceinline__ void a_ready(const Unit&) const {}
    __device__ __forceinline__ void done(const Unit&) const {}
};

__device__ __forceinline__ unsigned cvt_pk_bf16(float lo, float hi) { unsigned r; asm volatile("v_cvt_pk_bf16_f32 %0, %1, %2" : "=v"(r) : "v"(lo), "v"(hi)); return r; }
typedef float f32x2 __attribute__((ext_vector_type(2)));
__device__ __forceinline__ f32x2 gelu_pk(f32x2 v) {
    const f32x2 av = __builtin_elementwise_abs(v), d = av * 0.2316418882f + 1.0f;
    f32x2 t; t.x = __builtin_amdgcn_rcpf(d.x); t.y = __builtin_amdgcn_rcpf(d.y);
    f32x2 q = t * 0.5307027145f + (-0.7265760135f); q = q * t + 0.7107068705f; q = q * t + (-0.142248368f); q = q * t + 0.127414796f; q = q * t;
    const f32x2 s = (v * v) * (-0.72134752044f);
    f32x2 e; e.x = __builtin_amdgcn_exp2f(s.x); e.y = __builtin_amdgcn_exp2f(s.y);
    const f32x2 m = v * (q * e), r = v - m;
    f32x2 o; o.x = v.x < 0.f ? m.x : r.x; o.y = v.y < 0.f ? m.y : r.y; return o;
}

template <int ACT  > struct EpiBf16 {
    static constexpr bool PERM = true, AFTER_DRAIN = false, ROWPERM = false; static_assert(ACT == 0 || ACT == 1, "EpiBf16: ACT is 0 (none) or 1 (gelu_pk)");
    bf16_t* O; int ldc; const float* bias; int split_cols; size_t split_stride; float scale0;
    __device__ __forceinline__ void operator()(const f32x4 (&acc)[2][2][4][2], const Unit& u, int wr, int wc, int fr, int fq) const {
        const int row0 = u.pm * BM + wr * 64 + fr; int colt = u.pn * BM; bf16_t* base = O;
        float sc = 1.f; if (split_cols) { const int t = colt / split_cols; base += (size_t)t * split_stride; colt -= t * split_cols; if (t == 0) sc = scale0; }
        const int col0 = colt + wc * 32 + 8 * fq, bcol0 = u.pn * BM + wc * 32 + 8 * fq;
        f32x4 bv[2][2];
#pragma unroll
        for (int bj = 0; bj < 2; ++bj)
#pragma unroll
            for (int n = 0; n < 2; ++n) bv[bj][n] = bias ? *(const f32x4*)(bias + bcol0 + bj * HALF + 4 * n) : (f32x4){0.f, 0.f, 0.f, 0.f};
#pragma unroll
        for (int ai = 0; ai < 2; ++ai)
#pragma unroll
            for (int m = 0; m < 4; ++m) { bf16_t* rowp = base + (size_t)(row0 + ai * HALF + m * 16) * ldc + col0;
#pragma unroll
                for (int bj = 0; bj < 2; ++bj) { f32x4 v0 = acc[ai][bj][m][0] + bv[bj][0], v1 = acc[ai][bj][m][1] + bv[bj][1];
                    if (ACT == 1) { f32x2 a = gelu_pk((f32x2){v0[0], v0[1]}), b = gelu_pk((f32x2){v0[2], v0[3]}), c = gelu_pk((f32x2){v1[0], v1[1]}), d = gelu_pk((f32x2){v1[2], v1[3]});
                        v0 = (f32x4){a.x, a.y, b.x, b.y}; v1 = (f32x4){c.x, c.y, d.x, d.y}; }
                    v0 = v0 * sc; v1 = v1 * sc; u32x4 w; w.x = cvt_pk_bf16(v0[0], v0[1]); w.y = cvt_pk_bf16(v0[2], v0[3]); w.z = cvt_pk_bf16(v1[0], v1[1]); w.w = cvt_pk_bf16(v1[2], v1[3]);
                    *(u32x4*)(rowp + bj * HALF) = w; } }
    }
};

struct PanelStats {
    unsigned* xbuf;
    unsigned* cnt;
    unsigned* tmo;
    int ntn; float eps;
    unsigned code;
    __device__ __forceinline__ bool run(const f32x4 (&v)[2][2][4][2], const Unit& u, int wr, int wc, int fr, int fq, PG8_LAS unsigned char* lds, int wid, int lane) const {
        typedef float f32x2v __attribute__((ext_vector_type(2)));
        PG8_LAS f32x2v* P = (PG8_LAS f32x2v*)lds;
        PG8_LAS f32x2v* S = (PG8_LAS f32x2v*)(lds + 8192);
        PG8_LAS unsigned* flag = (PG8_LAS unsigned*)(lds + 8192 + 2048);
#pragma unroll
        for (int ai = 0; ai < 2; ++ai)
#pragma unroll
            for (int m = 0; m < 4; ++m) {
                float s = 0.f;
#pragma unroll
                for (int bj = 0; bj < 2; ++bj)
#pragma unroll
                    for (int n = 0; n < 2; ++n) { const f32x4 x = v[ai][bj][m][n]; s += (x[0] + x[1]) + (x[2] + x[3]); }
                s += __shfl_xor(s, 16); s += __shfl_xor(s, 32);
                const float mw = s * (1.0f / 64.0f); float q = 0.f;
#pragma unroll
                for (int bj = 0; bj < 2; ++bj)
#pragma unroll
                    for (int n = 0; n < 2; ++n) { const f32x4 d = v[ai][bj][m][n] - mw; q += (d[0] * d[0] + d[1] * d[1]) + (d[2] * d[2] + d[3] * d[3]); }
                q += __shfl_xor(q, 16); q += __shfl_xor(q, 32);
                if (fq == 0) P[(ai * HALF + wr * 64 + m * 16 + fr) * 4 + wc] = (f32x2v){mw, q};
            }
        asm volatile("s_waitcnt lgkmcnt(0)" ::: "memory"); __builtin_amdgcn_s_barrier(); asm volatile("" ::: "memory");
#if defined(BROKEN_EXCHANGE_NO_WAIT)
#warning BROKEN CONTROL BUILD: the row-statistics exchange does not wait; results are wrong by design
        if (blockIdx.x >= 64) { const long long t0_ = clock64(); while (clock64() - t0_ < 60000) __builtin_amdgcn_s_sleep(8); }
#endif
        const int row = wid * 32 + (lane & 31);
        if (lane < 32) {
            const f32x2v a = P[row * 4 + 0], b = P[row * 4 + 1], c = P[row * 4 + 2], d = P[row * 4 + 3];
            const float mt = (a.x + b.x + c.x + d.x) * 0.25f;
            const float da = a.x - mt, db = b.x - mt, dc = c.x - mt, dd = d.x - mt;
            const float m2 = (a.y + b.y) + (c.y + d.y) + 64.0f * ((da * da + db * db) + (dc * dc + dd * dd));
            unsigned long long* slot = (unsigned long long*)xbuf + ((size_t)(u.pm * BM + row) * 4 + u.pn);
            __hip_atomic_store(slot, ((unsigned long long)__float_as_uint(m2) << 32) | __float_as_uint(mt), __ATOMIC_RELAXED, __HIP_MEMORY_SCOPE_AGENT);
        }
        asm volatile("s_waitcnt vmcnt(0)" ::: "memory");
        if (lane == 0) __hip_atomic_fetch_add(cnt + 64 * u.pm, 1u, __ATOMIC_RELAXED, __HIP_MEMORY_SCOPE_AGENT);
        if (wid == 0) {
            bool dead = false; const unsigned long long t0 = __builtin_amdgcn_s_memrealtime(); const unsigned want = 8u * (unsigned)ntn;
            for (;;) {
#if defined(BROKEN_EXCHANGE_NO_WAIT)
                break;
#endif
                if ((unsigned)__builtin_amdgcn_readfirstlane(__hip_atomic_load(cnt + 64 * u.pm, __ATOMIC_RELAXED, __HIP_MEMORY_SCOPE_AGENT)) >= want) break;
                if (__builtin_amdgcn_s_memrealtime() - t0 > 2000000ull) {
                    if (lane == 0) { unsigned expect = 0u; __hip_atomic_compare_exchange_strong(tmo + 1, &expect, code | (unsigned)(u.pm & 0xff), __ATOMIC_RELAXED, __ATOMIC_RELAXED, __HIP_MEMORY_SCOPE_AGENT);
                                     __hip_atomic_store(tmo, 1u, __ATOMIC_RELAXED, __HIP_MEMORY_SCOPE_AGENT); }
                    dead = true; break; }
                __builtin_amdgcn_s_sleep(2);
            }
            __builtin_amdgcn_fence(__ATOMIC_ACQUIRE, "agent");
            if (lane == 0) flag[0] = dead ? 1u : 0u;
        }
        asm volatile("s_waitcnt vmcnt(0) lgkmcnt(0)" ::: "memory"); __builtin_amdgcn_s_barrier(); asm volatile("" ::: "memory");
        const bool bad = flag[0] != 0u;
        if (lane < 32) {
            const unsigned long long* slot = (const unsigned long long*)xbuf + (size_t)(u.pm * BM + row) * 4; float mt[4], m2[4]; float ms = 0.f;
#pragma unroll
            for (int t = 0; t < 4; ++t) { if (t < ntn) { const unsigned long long w = __hip_atomic_load(slot + t, __ATOMIC_RELAXED, __HIP_MEMORY_SCOPE_AGENT); mt[t] = __uint_as_float((unsigned)w); m2[t] = __uint_as_float((unsigned)(w >> 32)); } else { mt[t] = 0.f; m2[t] = 0.f; } ms += mt[t]; }
            const float mean = ms / (float)ntn; float q = 0.f;
#pragma unroll
            for (int t = 0; t < 4; ++t) if (t < ntn) { const float dm = mt[t] - mean; q += m2[t] + 256.0f * dm * dm; }
            S[row] = (f32x2v){mean, 1.0f / sqrtf(q / (256.0f * (float)ntn) + eps)};
        }
        asm volatile("s_waitcnt lgkmcnt(0)" ::: "memory"); __builtin_amdgcn_s_barrier(); asm volatile("" ::: "memory");
        return bad;
    }
};
struct EpiLnRes {
    static constexpr bool PERM = false, AFTER_DRAIN = true, ROWPERM = false;
    const float* base; float* out; int ldc; const float* bias; PanelStats st; unsigned poison;
    __device__ __forceinline__ void fused(f32x4 (&acc)[2][2][4][2], const Unit& u, int wr, int wc, int fr, int fq, PG8_LAS unsigned char* lds, int wid, int lane) const {
        typedef float f32x2v __attribute__((ext_vector_type(2)));
        const PG8_LAS f32x2v* S = (const PG8_LAS f32x2v*)(lds + 8192);
        const int col0 = u.pn * BM + wc * 32 + 4 * fq;
#pragma unroll
        for (int bj = 0; bj < 2; ++bj)
#pragma unroll
            for (int n = 0; n < 2; ++n) { const f32x4 bv = bias ? *(const f32x4*)(bias + col0 + bj * HALF + n * 16) : (f32x4){0.f, 0.f, 0.f, 0.f};
#pragma unroll
                for (int ai = 0; ai < 2; ++ai)
#pragma unroll
                    for (int m = 0; m < 4; ++m) acc[ai][bj][m][n] += bv; }
        f32x4 pre[4][2][2];
#pragma unroll
        for (int m = 0; m < 4; ++m) { const size_t off = (size_t)(u.pm * BM + wr * 64 + m * 16 + fr) * ldc + col0;
#pragma unroll
            for (int bj = 0; bj < 2; ++bj)
#pragma unroll
                for (int n = 0; n < 2; ++n) pre[m][bj][n] = *(const f32x4*)(base + off + bj * HALF + n * 16); }
        const bool bad = st.run(acc, u, wr, wc, fr, fq, lds, wid, lane) || poison != 0u;
        const float qnan = __builtin_nanf("");
#pragma unroll
        for (int ai = 0; ai < 2; ++ai)
#pragma unroll
            for (int m = 0; m < 4; ++m) { const int r = ai * HALF + wr * 64 + m * 16 + fr; const f32x2v sr = S[r]; const size_t off = (size_t)(u.pm * BM + r) * ldc + col0;
#pragma unroll
                for (int bj = 0; bj < 2; ++bj)
#pragma unroll
                    for (int n = 0; n < 2; ++n) { const f32x4 bs = ai == 0 ? pre[m][bj][n] : *(const f32x4*)(base + off + bj * HALF + n * 16); f32x4 o = bs + (acc[ai][bj][m][n] - sr.x) * sr.y;
                        if (bad) o = (f32x4){qnan, qnan, qnan, qnan}; *(f32x4*)(out + off + bj * HALF + n * 16) = o; }
                if (m & 1) asm volatile("" ::: "memory"); }
    }
};
struct EpiLnResLn {
    static constexpr bool PERM = false, AFTER_DRAIN = true, ROWPERM = false;
    const float* base; float* out; bf16_t* xn; int ldc; const float* bias; PanelStats st1, st2; unsigned poison;
    __device__ __forceinline__ void fused(f32x4 (&acc)[2][2][4][2], const Unit& u, int wr, int wc, int fr, int fq, PG8_LAS unsigned char* lds, int wid, int lane) const {
        typedef float f32x2v __attribute__((ext_vector_type(2))); typedef unsigned u32x2v __attribute__((ext_vector_type(2)));
        const PG8_LAS f32x2v* S = (const PG8_LAS f32x2v*)(lds + 8192);
        const int col0 = u.pn * BM + wc * 32 + 4 * fq;
#pragma unroll
        for (int bj = 0; bj < 2; ++bj)
#pragma unroll
            for (int n = 0; n < 2; ++n) { const f32x4 bv = bias ? *(const f32x4*)(bias + col0 + bj * HALF + n * 16) : (f32x4){0.f, 0.f, 0.f, 0.f};
#pragma unroll
                for (int ai = 0; ai < 2; ++ai)
#pragma unroll
                    for (int m = 0; m < 4; ++m) acc[ai][bj][m][n] += bv; }
        bool bad = st1.run(acc, u, wr, wc, fr, fq, lds, wid, lane) || poison != 0u;
        const float qnan = __builtin_nanf("");
#pragma unroll
        for (int ai = 0; ai < 2; ++ai)
#pragma unroll
            for (int m = 0; m < 4; ++m) { const int r = ai * HALF + wr * 64 + m * 16 + fr; const f32x2v sr = S[r]; const size_t off = (size_t)(u.pm * BM + r) * ldc + col0;
#pragma unroll
                for (int bj = 0; bj < 2; ++bj)
#pragma unroll
                    for (int n = 0; n < 2; ++n) { const f32x4 bs = *(const f32x4*)(base + off + bj * HALF + n * 16); acc[ai][bj][m][n] = bs + (acc[ai][bj][m][n] - sr.x) * sr.y; }
                asm volatile("" : "+v"(acc[ai][0][m][0]), "+v"(acc[ai][0][m][1]), "+v"(acc[ai][1][m][0]), "+v"(acc[ai][1][m][1]));
                if (m & 1) asm volatile("" ::: "memory"); }
        const bool bad1 = bad;
        bad = st2.run(acc, u, wr, wc, fr, fq, lds, wid, lane) || bad;
#pragma unroll
        for (int ai = 0; ai < 2; ++ai)
#pragma unroll
            for (int m = 0; m < 4; ++m) { const int r = ai * HALF + wr * 64 + m * 16 + fr; const f32x2v sr = S[r]; const size_t off = (size_t)(u.pm * BM + r) * ldc + col0;
#pragma unroll
                for (int bj = 0; bj < 2; ++bj)
#pragma unroll
                    for (int n = 0; n < 2; ++n) { const f32x4 x1 = acc[ai][bj][m][n]; *(f32x4*)(out + off + bj * HALF + n * 16) = bad1 ? (f32x4){qnan, qnan, qnan, qnan} : x1;
                        const f32x4 o = (x1 - sr.x) * sr.y; u32x2v w; w.x = cvt_pk_bf16(o[0], o[1]); w.y = cvt_pk_bf16(o[2], o[3]);
                        if (bad) { w.x = 0x7fc07fc0u; w.y = 0x7fc07fc0u; } *(u32x2v*)(xn + off + bj * HALF + n * 16) = w; }
                asm volatile("" ::: "memory"); }
    }
};

template <class Epi, class Sched, bool ALIGN_EPI = false, bool SP2 = false>
__device__ __forceinline__ void gemm_phase(PG8_LAS unsigned char* lds, const Gemm g, const Sched& S, const Epi& E, const int wv) {
    const int tid = otid(wv), wid = __builtin_amdgcn_readfirstlane(tid >> 6), lane = tid & 63, wr = wid >> 2, wc = wid & 3, fr = lane & 15, fq = lane >> 4;
    const int K = g.K, nt = K / BK;
    unsigned voffA[2], voffB[2];
#pragma unroll
    for (int i = 0; i < 2; ++i) { int R, C; stage_rc(tid * 16 + i * 8192, R, C); const int Rb = Epi::PERM ? ((R & ~31) + perm32(R & 31)) : R;
        const int Ra = Epi::ROWPERM ? ((R & ~63) | ((R & 15) << 2) | ((R >> 4) & 3)) : R;
        voffA[i] = (unsigned)(Ra * K + C) * 2u; voffB[i] = (unsigned)(Rb * K + C) * 2u; }
    const size_t kstep = (size_t)(BK * 2);
    const size_t hstep = (size_t)HALF * K * 2;
    const size_t tstep = 2 * hstep;
    const unsigned ldsw = (unsigned)wid * 1024u;
    const int aoff = lds_byte(wr * 64 + fr, fq * 8), boff = lds_byte(wc * 32 + fr, fq * 8);
#define PG8_SA(b, h) (((b) * 2 + (h)) * HTB)
#define PG8_SB(b, h) ((4 + (b) * 2 + (h)) * HTB)
#define PG8_STAGE(bufoff, gbase, voff) do { _Pragma("unroll") for (int _i = 0; _i < 2; ++_i) \
        __builtin_amdgcn_global_load_lds((const unsigned*)((const char*)(gbase) + (voff)[_i]), (PG8_LAS unsigned*)(lds + (bufoff) + ldsw + _i * 8192), 16, 0, 0); } while (0)
#define PG8_LDA(dst, b, h) do { _Pragma("unroll") for (int m = 0; m < 4; ++m) _Pragma("unroll") for (int k = 0; k < 2; ++k) dst[m][k] = *(const PG8_LAS bf16x8*)(lds + PG8_SA(b, h) + aoff + m * 2048 + k * 1024); } while (0)
#define PG8_LDB(dst, b, h) do { _Pragma("unroll") for (int n = 0; n < 2; ++n) _Pragma("unroll") for (int k = 0; k < 2; ++k) dst[n][k] = *(const PG8_LAS bf16x8*)(lds + PG8_SB(b, h) + boff + n * 2048 + k * 1024); } while (0)
#define PG8_MMA(ai, bj, At, Bt) do { __builtin_amdgcn_s_setprio(1); _Pragma("unroll") for (int m = 0; m < 4; ++m) _Pragma("unroll") for (int n = 0; n < 2; ++n) _Pragma("unroll") for (int k = 0; k < 2; ++k) \
        acc[ai][bj][m][n] = __builtin_amdgcn_mfma_f32_16x16x32_bf16(Bt[n][k], At[m][k], acc[ai][bj][m][n], 0, 0, 0); __builtin_amdgcn_s_setprio(0); } while (0)
#define PG8_WAIT_V(n) asm volatile("s_waitcnt vmcnt(" #n ")" ::: "memory")
#define PG8_WAIT_L(n) asm volatile("s_waitcnt lgkmcnt(" #n ")" ::: "memory")
#define PG8_BAR __builtin_amdgcn_s_barrier()
#define PG8_SCHED __builtin_amdgcn_sched_barrier(0)
    Unit cur, nxt; int ui = 0;
    if (!S.next(0, cur)) return;
    f32x4 acc[2][2][4][2];
#pragma unroll
    for (int a = 0; a < 2; ++a)
#pragma unroll
        for (int b = 0; b < 2; ++b)
#pragma unroll
            for (int m = 0; m < 4; ++m)
#pragma unroll
                for (int n = 0; n < 2; ++n) acc[a][b][m][n] = (f32x4){0.f, 0.f, 0.f, 0.f};
    bf16x8 At[4][2], B0[2][2], B1[2][2];
    const char* cA = (const char*)g.A + (size_t)cur.pm * tstep + (size_t)cur.kb * kstep; const char* cB = (const char*)g.Bt + (size_t)cur.pn * tstep + (size_t)cur.kb * kstep;
    S.a_ready(cur);
    if constexpr (SP2) {
        PG8_STAGE(PG8_SB(0, 0), cB, voffB); PG8_STAGE(PG8_SB(0, 1), cB + hstep, voffB); PG8_STAGE(PG8_SA(0, 0), cA, voffA); PG8_STAGE(PG8_SA(0, 1), cA + hstep, voffA);
        if (wr == 1) PG8_BAR;
        PG8_WAIT_V(2); PG8_BAR;
        PG8_STAGE(PG8_SB(1, 0), cB + kstep, voffB); PG8_STAGE(PG8_SA(1, 0), cA + kstep, voffA); PG8_STAGE(PG8_SB(1, 1), cB + hstep + kstep, voffB);
        PG8_WAIT_V(6); PG8_BAR;
    } else {
        PG8_STAGE(PG8_SB(0, 0), cB, voffB); PG8_STAGE(PG8_SA(0, 0), cA, voffA); PG8_STAGE(PG8_SB(0, 1), cB + hstep, voffB); PG8_STAGE(PG8_SA(0, 1), cA + hstep, voffA);
        if (wr == 1) PG8_BAR;
        PG8_WAIT_V(4); PG8_BAR;
        PG8_STAGE(PG8_SB(1, 0), cB + kstep, voffB); PG8_STAGE(PG8_SA(1, 0), cA + kstep, voffA); PG8_STAGE(PG8_SB(1, 1), cB + hstep + kstep, voffB);
        PG8_WAIT_V(6); PG8_BAR;
    }
    for (;;) {
        const bool has_next = S.next(ui + 1, nxt);
        const char* nA = has_next ? (const char*)g.A + (size_t)nxt.pm * tstep + (size_t)nxt.kb * kstep : cA; const char* nB = has_next ? (const char*)g.Bt + (size_t)nxt.pn * tstep + (size_t)nxt.kb * kstep : cB;
        const int cnt = cur.nt ? cur.nt : nt;
        for (int t = 0; t < cnt; t += 2) {
            const bool last = (t == cnt - 2);
            const char* a1 = cA + (size_t)(t + 1) * kstep;
            const char* a2 = last ? nA : cA + (size_t)(t + 2) * kstep; const char* b2 = last ? nB : cB + (size_t)(t + 2) * kstep;
            const char* a3 = a2 + kstep; const char* b3 = b2 + kstep;
            if (last && has_next) S.a_ready(nxt);
            if constexpr (SP2) {
            PG8_LDB(B0, 0, 0); PG8_LDB(B1, 0, 1); PG8_SCHED; PG8_LDA(At, 0, 0); PG8_STAGE(PG8_SA(1, 1), a1 + hstep, voffA);
            PG8_WAIT_V(8); PG8_WAIT_L(0); PG8_BAR; PG8_MMA(0, 0, At, B0); PG8_MMA(0, 1, At, B1); PG8_BAR; PG8_SCHED;
            PG8_LDA(At, 0, 1); PG8_STAGE(PG8_SB(0, 0), b2, voffB); PG8_STAGE(PG8_SB(0, 1), b2 + hstep, voffB); PG8_STAGE(PG8_SA(0, 0), a2, voffA);
            PG8_WAIT_V(8); PG8_WAIT_L(0); PG8_BAR; PG8_MMA(1, 0, At, B0); PG8_MMA(1, 1, At, B1); PG8_BAR; PG8_SCHED;
            PG8_LDB(B0, 1, 0); PG8_LDB(B1, 1, 1); PG8_SCHED; PG8_LDA(At, 1, 0); PG8_STAGE(PG8_SA(0, 1), a2 + hstep, voffA);
            PG8_WAIT_V(8); PG8_WAIT_L(0); PG8_BAR; PG8_MMA(0, 0, At, B0); PG8_MMA(0, 1, At, B1); PG8_BAR; PG8_SCHED;
            PG8_LDA(At, 1, 1); PG8_STAGE(PG8_SB(1, 0), b3, voffB); PG8_STAGE(PG8_SB(1, 1), b3 + hstep, voffB); PG8_STAGE(PG8_SA(1, 0), a3, voffA);
            PG8_WAIT_V(8); PG8_WAIT_L(0); PG8_BAR; PG8_MMA(1, 0, At, B0); PG8_MMA(1, 1, At, B1); PG8_BAR; PG8_SCHED;
            } else {
            PG8_LDB(B0, 0, 0); PG8_SCHED; PG8_LDA(At, 0, 0); PG8_STAGE(PG8_SA(1, 1), a1 + hstep, voffA);
            PG8_WAIT_L(8); PG8_BAR; PG8_WAIT_L(0); PG8_MMA(0, 0, At, B0); PG8_BAR; PG8_SCHED;
            PG8_LDB(B1, 0, 1); PG8_STAGE(PG8_SB(0, 0), b2, voffB);
            PG8_BAR; PG8_WAIT_L(0); PG8_MMA(0, 1, At, B1); PG8_BAR;
            PG8_LDA(At, 0, 1); PG8_STAGE(PG8_SA(0, 0), a2, voffA);
            PG8_BAR; PG8_WAIT_L(0); PG8_MMA(1, 0, At, B0); PG8_BAR; PG8_SCHED;
            PG8_STAGE(PG8_SB(0, 1), b2 + hstep, voffB);
            PG8_WAIT_V(6); PG8_BAR; PG8_MMA(1, 1, At, B1); PG8_BAR;
            PG8_LDB(B0, 1, 0); PG8_SCHED; PG8_LDA(At, 1, 0); PG8_STAGE(PG8_SA(0, 1), a2 + hstep, voffA);
            PG8_WAIT_L(8); PG8_BAR; PG8_WAIT_L(0); PG8_MMA(0, 0, At, B0); PG8_BAR; PG8_SCHED;
            PG8_LDB(B1, 1, 1); PG8_STAGE(PG8_SB(1, 0), b3, voffB);
            PG8_BAR; PG8_WAIT_L(0); PG8_MMA(0, 1, At, B1); PG8_BAR;
            PG8_LDA(At, 1, 1); PG8_STAGE(PG8_SA(1, 0), a3, voffA);
            PG8_BAR; PG8_WAIT_L(0); PG8_MMA(1, 0, At, B0); PG8_BAR; PG8_SCHED;
            PG8_STAGE(PG8_SB(1, 1), b3 + hstep, voffB);
            PG8_WAIT_V(6); PG8_BAR; PG8_MMA(1, 1, At, B1); PG8_BAR;
            }
        }
        if constexpr (ALIGN_EPI) { if (wr == 0) PG8_BAR; }
        if constexpr (!Epi::AFTER_DRAIN) { E(acc, cur, wr, wc, fr, fq); S.done(cur); }
        if (!has_next) break;
#pragma unroll
        for (int a = 0; a < 2; ++a)
#pragma unroll
            for (int b = 0; b < 2; ++b)
#pragma unroll
                for (int m = 0; m < 4; ++m)
#pragma unroll
                    for (int n = 0; n < 2; ++n) acc[a][b][m][n] = (f32x4){0.f, 0.f, 0.f, 0.f};
        cur = nxt; cA = nA; cB = nB; ++ui;
        if constexpr (ALIGN_EPI) { if (wr == 1) PG8_BAR; }
    }
    PG8_WAIT_V(0);
    if constexpr (!ALIGN_EPI) { if (wr == 0) PG8_BAR; }
    PG8_BAR;
    if constexpr (Epi::AFTER_DRAIN) { E.fused(acc, cur, wr, wc, fr, fq, lds, wid, lane); S.done(cur); }
#undef PG8_SA
#undef PG8_SB
#undef PG8_STAGE
#undef PG8_LDA
#undef PG8_LDB
#undef PG8_MMA
#undef PG8_WAIT_V
#undef PG8_WAIT_L
#undef PG8_BAR
#undef PG8_SCHED
}
}

#ifndef PG8_SP2
#define PG8_SP2 true
#endif
#ifndef PG8_ALIGN
#define PG8_ALIGN true
#endif
#define GAS __attribute__((address_space(1)))
#define LAS __attribute__((address_space(3)))
typedef unsigned short bf16;
typedef unsigned v4u __attribute__((ext_vector_type(4)));
typedef float f32x4 __attribute__((ext_vector_type(4)));
typedef short bf16x8 __attribute__((ext_vector_type(8)));
typedef GAS unsigned gu32;
typedef GAS unsigned long long gu64;
#define RLX_AGENT __ATOMIC_RELAXED, __HIP_MEMORY_SCOPE_AGENT
#define LDS_WAIT() asm volatile("s_waitcnt lgkmcnt(0)" ::: "memory")
#define VM_WAIT() asm volatile("s_waitcnt vmcnt(0)" ::: "memory")
__device__ __forceinline__ unsigned long long rt() { return __builtin_amdgcn_s_memrealtime(); }
__device__ __forceinline__ unsigned f2bf(float f) { unsigned u = __builtin_bit_cast(unsigned, f); return (u + 0x7fffu + ((u >> 16) & 1u)) >> 16; }
__device__ __forceinline__ unsigned pk2(float lo, float hi) { return f2bf(lo) | (f2bf(hi) << 16); }

#define XB_TMO      128
#define XB_XCNT(j)  (256  + 64 * (j))
#define XB_XSUB(j)  (1280 + 64 * (j))
#define XB_XGEN(j)  (2304 + 64 * (j))
#define XB_TOP      3328
#define XB_TOPGEN   3392
#define XCD_BAR_WORDS 3456
#define XB_SPIN_CAP (1u << 18)

__device__ __forceinline__ unsigned xb_ld(unsigned* p)              { return __hip_atomic_load(p, __ATOMIC_RELAXED, __HIP_MEMORY_SCOPE_AGENT); }
__device__ __forceinline__ unsigned xb_add(unsigned* p, unsigned v) { return __hip_atomic_fetch_add(p, v, __ATOMIC_RELAXED, __HIP_MEMORY_SCOPE_AGENT); }
__device__ __forceinline__ unsigned xb_xcc_id() { return (unsigned)__builtin_amdgcn_s_getreg((3 << 11) | 20) & 0xFu; }
#define XB_SPIN(cond, bar) do { unsigned _sp = 0; while (cond) { __builtin_amdgcn_s_sleep(1); \
    if ((++_sp & 255u) == 0u) { if (xb_ld(&(bar)[XB_TMO])) break; if (_sp > XB_SPIN_CAP) { atomicAdd(&(bar)[XB_TMO], 1u); break; } } } } while (0)

struct XcdBarrier {
    unsigned* bar; unsigned x;
    volatile LAS unsigned* st;
    int wv;
};

__device__ __forceinline__ XcdBarrier xcd_barrier_post(unsigned* bar, volatile LAS unsigned* st) {
    XcdBarrier b; b.bar = bar; b.x = xb_xcc_id(); b.st = st;
    if (threadIdx.x == 0) (void)xb_add(&bar[XB_XCNT(b.x)], 1u);
    return b;
}
__device__ __forceinline__ void xcd_barrier_complete(unsigned* bar, unsigned x, unsigned& nloc, unsigned& nx) {
    const unsigned G = gridDim.x * gridDim.y * gridDim.z;
    unsigned sum, cnt, mine, sp = 0u;
    for (;;) {
        sum = 0u; cnt = 0u; mine = 0u;
#pragma unroll
        for (unsigned j = 0; j < 16; ++j) { const unsigned c = xb_ld(&bar[XB_XCNT(j)]); sum += c; cnt += (c > 0u) ? 1u : 0u; mine = (j == x) ? c : mine; }
        if (sum == G) break;
        __builtin_amdgcn_s_sleep(1);
        if ((++sp & 255u) == 0u) { if (xb_ld(&bar[XB_TMO])) break; if (sp > XB_SPIN_CAP) { atomicAdd(&bar[XB_TMO], 1u); break; } }
    }
    nloc = mine > 0u ? mine : 1u; nx = cnt > 0u ? cnt : 1u;
}

__device__ __forceinline__ void xcd_barrier(const XcdBarrier& b) {
    asm volatile("s_waitcnt vmcnt(0)" ::: "memory");
    __syncthreads();
    if (otid(b.wv) == 0) {
        unsigned* bar = b.bar;
        __builtin_amdgcn_s_waitcnt(0);
        unsigned nloc = b.st[0], nx = b.st[1];
        if (nloc == 0u) { xcd_barrier_complete(bar, b.x, nloc, nx); b.st[0] = nloc; b.st[1] = nx; }
        const unsigned old = xb_add(&bar[XB_XSUB(b.x)], 1u);
        const unsigned gen = old / nloc;
        if (old + 1u == (gen + 1u) * nloc) {
            __builtin_amdgcn_fence(__ATOMIC_RELEASE, "agent");
            asm volatile("s_waitcnt vmcnt(0)" ::: "memory");
            const unsigned og = xb_add(&bar[XB_TOP], 1u);
            const unsigned tg = og / nx;
            if (og + 1u == (tg + 1u) * nx) xb_add(&bar[XB_TOPGEN], 1u);
            else XB_SPIN(xb_ld(&bar[XB_TOPGEN]) == tg, bar);
            __builtin_amdgcn_fence(__ATOMIC_ACQUIRE, "agent");
            xb_add(&bar[XB_XGEN(b.x)], 1u);
            asm volatile("s_waitcnt vmcnt(0)" ::: "memory");
        } else {
            XB_SPIN(xb_ld(&bar[XB_XGEN(b.x)]) == gen, bar);
            __builtin_amdgcn_fence(__ATOMIC_ACQUIRE, "agent");
            asm volatile("s_waitcnt vmcnt(0)" ::: "memory");
        }
    }
    __syncthreads();
}


constexpr int NB = 8, SEQ = 2048, CTXL = 256, DM = 1024, NL = 4;
constexpr int ML = NB * SEQ, MC = NB * CTXL, MT = ML + MC;
constexpr int NIN = 2464, NINP = 2560, DFF = 2816, NUP = 5632, KMLA = 384, NMLA = 1024;
constexpr int NKEY = SEQ + CTXL, NKT = NKEY / 64;
constexpr float EPS = 1e-6f;
constexpr float LOG2E = 1.4426950408889634f;
constexpr int PC_CQ = 0, PC_CKV = 256, PC_KR = 384, PC_DQ = 512, PC_DK = 768, PC_DV = 1024, PC_NQ = 1280, PC_NK = 1536, PC_NV = 1792, PC_GQ = 2048, PC_GK = 2304, PC_GV = 2432;

constexpr size_t MiB = 1u << 20;
constexpr size_t WS_CTL = 0, CTL_ZERO_BYTES = 1 * MiB;
constexpr size_t WS_MODS = 1 * MiB;
constexpr size_t WS_ROPE32 = 2 * MiB;
constexpr size_t WS_ROPE64 = 2 * MiB + 262144;
constexpr size_t WS_W = 3 * MiB;
constexpr size_t W_IN = 0, W_OUT = W_IN + (size_t)NINP * DM * 2, W_UP = W_OUT + (size_t)DM * DM * 2, W_DOWN = W_UP + (size_t)NUP * DM * 2, W_MLA = W_DOWN + (size_t)DM * DFF * 2, W_LAYER = W_MLA + (size_t)NMLA * KMLA * 2;
static_assert(W_LAYER == 25427968, "weights per layer");
constexpr size_t WS_XC = 100 * MiB;
constexpr size_t WS_R2 = 108 * MiB;
constexpr size_t WS_XN = WS_R2, WS_MLAP = WS_R2, WS_CQKV = WS_R2 + 36 * MiB;
constexpr size_t WS_R1 = 158 * MiB;
constexpr size_t WS_P = WS_R1, WS_QKV = WS_R1 + 90 * MiB, WS_MIX = WS_R1, WS_ACT = WS_R1, WS_HALO = WS_R1 + 100 * MiB;
constexpr size_t WS_SLAB = WS_R1 + 110 * MiB;
constexpr size_t WS_END = WS_R1 + 198 * MiB;
static_assert(WS_W + NL * W_LAYER <= WS_XC, "weights fit");
static_assert((size_t)MT * NINP * 2 <= 90 * MiB && (size_t)MT * DFF * 2 <= 100 * MiB && (size_t)72 * 4 * NUP * 4 <= 8 * MiB, "R1 map");
constexpr size_t E_QA = 0, E_KA = E_QA + (size_t)NB * 4 * NKEY * 96, E_VA = E_KA + (size_t)NB * 4 * NKEY * 96, E_QD = E_VA + (size_t)NB * 4 * NKEY * 64,
                 E_KD = E_QD + (size_t)NB * 8 * NKEY * 32, E_VD = E_KD + (size_t)NB * 8 * NKEY * 32, E_QN = E_VD + (size_t)NB * 4 * NKEY * 64, E_KN = E_QN + (size_t)NB * 4 * NKEY * 64,
                 E_VN = E_KN + (size_t)NB * 4 * NKEY * 64, E_QG = E_VN + (size_t)NB * 4 * NKEY * 64, E_KG = E_QG + (size_t)NB * 4 * NKEY * 64, E_VG = E_KG + (size_t)NB * 2 * NKEY * 64,
                 E_END = E_VG + (size_t)NB * 2 * NKEY * 64;
static_assert(E_END * 2 <= 108 * MiB, "QKV map");
constexpr int CW_TMO = 0, CW_CODE = 1, CW_BAR = 4096;

constexpr int RING_OFF = 0, RING_BYTES = 131072;
constexpr int LDSCTL_OFF = RING_BYTES, MISC_OFF = LDSCTL_OFF + 320;
constexpr int EX_OFF = RING_BYTES + 1024;
constexpr int CWL_OFF = EX_OFF + 8192;
constexpr int LDS_BYTES = 147456;
static_assert(CWL_OFF + 4096 <= LDS_BYTES, "LDS map");
constexpr int NWAVES = 8;

typedef float f32x2v __attribute__((ext_vector_type(2)));
typedef unsigned u32x2v __attribute__((ext_vector_type(2)));

__device__ __forceinline__ float bf2f(unsigned short v) { return __uint_as_float((unsigned)v << 16); }
__device__ __forceinline__ float bflo(unsigned w) { return __uint_as_float(w << 16); }
__device__ __forceinline__ float bfhi(unsigned w) { return __uint_as_float(w & 0xffff0000u); }
template <int M> __device__ __forceinline__ float swz(float v) { static_assert(M >= 1 && M < 32, "xor mask within 32 lanes"); return __int_as_float(__builtin_amdgcn_ds_swizzle(__float_as_int(v), (M << 10) | 0x1f)); }
__device__ __forceinline__ float sum32(float v) { auto r = __builtin_amdgcn_permlane32_swap(__float_as_uint(v), __float_as_uint(v), false, false); return __uint_as_float(r[0]) + __uint_as_float(r[1]); }
__device__ __forceinline__ float max32(float v) { auto r = __builtin_amdgcn_permlane32_swap(__float_as_uint(v), __float_as_uint(v), false, false); return fmaxf(__uint_as_float(r[0]), __uint_as_float(r[1])); }
__device__ __forceinline__ float wave_sum(float v) { v += swz<1>(v); v += swz<2>(v); v += swz<4>(v); v += swz<8>(v); v += swz<16>(v); return sum32(v); }
template <int CTRL> __device__ __forceinline__ float dpp_mov(float v) { return __int_as_float(__builtin_amdgcn_update_dpp(0, __float_as_int(v), CTRL, 0xf, 0xf, false)); }
__device__ __forceinline__ float silu_f(float x) { return x / (1.f + __expf(-x)); }
__device__ __forceinline__ float rsq_f(float x) { return __builtin_amdgcn_rsqf(x); }
typedef __bf16 bf16x2h __attribute__((ext_vector_type(2)));
__device__ __forceinline__ unsigned pkc(float lo, float hi) { f32x2v v = {lo, hi}; bf16x2h b = __builtin_convertvector(v, bf16x2h); return __builtin_bit_cast(unsigned, b); }
__device__ __forceinline__ unsigned pkc1(float v) { return pkc(v, 0.f) & 0xffffu; }

__device__ __forceinline__ size_t q_off(int H, int DK, int b, int h, int q) { return ((size_t)(b * H + h) * NKEY + q) * DK; }
__device__ __forceinline__ size_t k_off(int H, int DK, int b, int h, int key, int d) { return ((((size_t)(b * H + h) * NKT + (key >> 6)) * (DK >> 3) + (d >> 3)) * 64 + (key & 63)) * 8 + (d & 7); }
__device__ __forceinline__ size_t v_off(int H, int b, int h, int key, int dv) {
    const int kk = key & 63, s = kk >> 4, i = kk & 15, hh = (i >> 2) & 1, j = (i & 3) + 4 * (i >> 3);
    return ((((size_t)(b * H + h) * NKT + (key >> 6)) * 8 + (s * 2 + hh)) * 64 + dv) * 8 + j;
}

constexpr int PT_OFF = LDSCTL_OFF + 512;
struct Ctx {
    LAS unsigned char* lds;
    int tid, lane, wave, G, gw, NGW;
};
extern __shared__ __attribute__((aligned(16))) unsigned char lds_raw[];
__device__ __forceinline__ Ctx make_ctx(const int wv) {
    unsigned zl = 0; asm volatile("" : "+s"(zl));
    Ctx C; C.lds = (LAS unsigned char*)lds_raw + zl;
    int w = wv; asm volatile("" : "+s"(w));
    const int t = otid(w);
    C.tid = t; C.lane = t & 63; C.wave = w;
    C.G = gridDim.x; { const int bx = blockIdx.x; const int vcu = (C.G % 8 == 0) ? (bx % 8) * (C.G / 8) + bx / 8 : bx; C.gw = vcu * NWAVES + C.wave; } C.NGW = C.G * NWAVES;
    return C;
}
__device__ __forceinline__ unsigned long long ptab(const Ctx& C, int i) {
    const unsigned long long p = ((const LAS unsigned long long*)(C.lds + PT_OFF))[i];
    const unsigned lo = __builtin_amdgcn_readfirstlane((unsigned)p), hi = __builtin_amdgcn_readfirstlane((unsigned)(p >> 32));
    return ((unsigned long long)hi << 32) | lo;
}
__device__ __forceinline__ const float* inp(const Ctx& C, int i) { return (const float*)ptab(C, i); }
__device__ __forceinline__ float* outp(const Ctx& C) { return (float*)ptab(C, 32); }
__device__ __forceinline__ unsigned char* wsp(const Ctx& C) { return (unsigned char*)ptab(C, 33); }
__device__ __forceinline__ bf16* wptr(const Ctx& C, int l, size_t off) { return (bf16*)(wsp(C) + WS_W + (size_t)l * W_LAYER + off); }
__device__ __forceinline__ float lambda_init(int l) { return l == 0 ? 0.2f : l == 1 ? (float)(0.8 - 0.6 * 0.7408182206817179) : l == 2 ? (float)(0.8 - 0.6 * 0.5488116360940264) : (float)(0.8 - 0.6 * 0.4065696597405991); }

namespace pg8 {
struct EpiResGate {
    static constexpr bool PERM = false, AFTER_DRAIN = false, ROWPERM = false;
    const float* base_lat; const float* base_ctx; float* out_lat; float* out_ctx; const float* gate; float* slab; int dry;
    __device__ __forceinline__ void operator()(const f32x4 (&acc)[2][2][4][2], const Unit& u, int wr, int wc, int fr, int fq) const {
        const bool lat = u.pm < 64; const int bidx = lat ? (u.pm >> 3) : 8;
        const size_t rowt = lat ? (size_t)u.pm * BM : (size_t)(u.pm - 64) * BM;
        const float* base = (lat ? base_lat : base_ctx) + rowt * DM; float* out = (lat ? out_lat : out_ctx) + rowt * DM;
        const int row0 = wr * 64 + fr, col0 = u.pn * BM + wc * 32 + 4 * fq;
        f32x4 gv[2][2];
#pragma unroll
        for (int bj = 0; bj < 2; ++bj)
#pragma unroll
            for (int n = 0; n < 2; ++n) gv[bj][n] = *(const f32x4*)(gate + (size_t)bidx * 6144 + col0 + bj * HALF + n * 16);
#pragma unroll
        for (int ai = 0; ai < 2; ++ai)
#pragma unroll
            for (int m = 0; m < 4; ++m) { const size_t off = (size_t)(row0 + ai * HALF + m * 16) * DM + col0;
#pragma unroll
                for (int bj = 0; bj < 2; ++bj)
#pragma unroll
                    for (int n = 0; n < 2; ++n) {
                        if (dry) { f32x4 d = gv[bj][n] * acc[ai][bj][m][n]; if (!u.nt) d += *(const f32x4*)(base + off + bj * HALF + n * 16); asm volatile("" :: "v"(d)); }
                        else if (u.nt) *(f32x4*)(slab + (size_t)u.sp * ((size_t)MC * DM) + rowt * DM + off + bj * HALF + n * 16) = gv[bj][n] * acc[ai][bj][m][n];
                        else { const f32x4 bs = *(const f32x4*)(base + off + bj * HALF + n * 16); *(f32x4*)(out + off + bj * HALF + n * 16) = bs + gv[bj][n] * acc[ai][bj][m][n]; } }
                if (m & 1) asm volatile("" ::: "memory"); }
    }
};
struct SplitOrder {
    StaticOrder lat; int G, c, nsub, q, r;
    __device__ __forceinline__ void init(int G_, int c_, bool with_ctx, int nt_total) { lat.init(ML, DM, G_, c_); G = G_; c = c_; nsub = with_ctx ? 128 : 0; q = (nt_total >> 1) >> 2; r = (nt_total >> 1) & 3; }
    __device__ __forceinline__ bool next(int i, Unit& u) const {
        const long L = (long)i * G + c;
        Unit a; const bool okl = lat.next(i, a);
        const int j = (int)(L - 256), cu = j >> 2, sp = j & 3; const bool sub = L >= 256;
        u.pm = sub ? 64 + (cu >> 2) : a.pm; u.pn = sub ? (cu & 3) : a.pn; u.kb = sub ? 2 * (sp * q + (sp < r ? sp : r)) : 0; u.nt = sub ? 2 * (q + (sp < r ? 1 : 0)) : 0; u.sp = sub ? sp : 0;
        return sub ? (j < nsub) : okl;
    }
    __device__ __forceinline__ void a_ready(const Unit&) const {}
    __device__ __forceinline__ void done(const Unit&) const {}
};
__device__ __forceinline__ f32x4 sel4(bool c, const f32x4 a, const f32x4 b) { f32x4 r; r[0] = c ? a[0] : b[0]; r[1] = c ? a[1] : b[1]; r[2] = c ? a[2] : b[2]; r[3] = c ? a[3] : b[3]; return r; }
__device__ __forceinline__ float silu1(float x) { return x * __builtin_amdgcn_rcpf(1.f + __expf(-x)); }
__device__ __forceinline__ float gate2(float gs, float as) { return (as * gs) * __builtin_amdgcn_rcpf(1.f + __builtin_amdgcn_exp2f(gs)); }
struct EpiConvGate {
    static constexpr bool PERM = true, AFTER_DRAIN = false, ROWPERM = true;
    bf16_t* ACT; float* HALO; const float* cw; const float* cb; PG8_LAS float* EX; int dry;
    __device__ __forceinline__ void operator()(const f32x4 (&acc)[2][2][4][2], const Unit& u, int wr, int wc, int fr, int fq) const {
        if (dry) {
#pragma unroll
            for (int ai = 0; ai < 2; ++ai)
#pragma unroll
                for (int bj = 0; bj < 2; ++bj)
#pragma unroll
                    for (int m = 0; m < 4; ++m)
#pragma unroll
                        for (int n = 0; n < 2; ++n) asm volatile("" :: "v"(acc[ai][bj][m][n]));
            return; }
        const int lane = fq * 16 + fr;
        const int jc = u.pn * 128 + wc * 32 + 8 * fq;
        PG8_LAS float* CWL = EX + 2048;
        unsigned cwl_lane = (unsigned)(uintptr_t)(CWL + wc * 32 + 8 * fq); asm volatile("" : "+v"(cwl_lane));
        {   const int tid = (wr * 4 + wc) * 64 + lane, row = tid >> 7, cp = tid & 127, bj = cp >> 6, cc = (cp & 63) * 2;
            const float* src = (row < 3 ? cw + (size_t)row * NUP : cb) + bj * DFF + u.pn * 128 + cc;
            const float sc = bj ? -1.4426950408889634f : -0.6931471805599453f;
            *(PG8_LAS f32x2v*)(CWL + row * 256 + bj * 128 + cc) = *(const f32x2v*)src * sc; }
        if (fr == 0) {
#pragma unroll
            for (int ai = 0; ai < 2; ++ai)
#pragma unroll
                for (int bj = 0; bj < 2; ++bj)
#pragma unroll
                    for (int n = 0; n < 2; ++n) *(PG8_LAS f32x4*)(EX + ((((wr * 4 + wc) * 2 + ai) * 2 + 0) * 64 + bj * 32 + 8 * fq + 4 * n)) = acc[ai][bj][0][n];
        }
        if (fr == 15) {
#pragma unroll
            for (int ai = 0; ai < 2; ++ai)
#pragma unroll
                for (int bj = 0; bj < 2; ++bj)
#pragma unroll
                    for (int n = 0; n < 2; ++n) *(PG8_LAS f32x4*)(EX + ((((wr * 4 + wc) * 2 + ai) * 2 + 1) * 64 + bj * 32 + 8 * fq + 4 * n)) = acc[ai][bj][3][n];
        }
        asm volatile("s_waitcnt lgkmcnt(0)" ::: "memory"); __builtin_amdgcn_s_barrier(); asm volatile("" ::: "memory");
        if (u.pm < 64) {
            float* hb = HALO + (size_t)u.pm * 4 * NUP;
            if (wr == 0 && fr == 0) {
#pragma unroll
                for (int mm = 0; mm < 2; ++mm)
#pragma unroll
                    for (int bj = 0; bj < 2; ++bj)
#pragma unroll
                        for (int n = 0; n < 2; ++n) *(f32x4*)(hb + (size_t)mm * NUP + bj * DFF + jc + 4 * n) = acc[0][bj][mm][n];
            }
            if (wr == 1 && fr == 15) {
#pragma unroll
                for (int mm = 2; mm < 4; ++mm)
#pragma unroll
                    for (int bj = 0; bj < 2; ++bj)
#pragma unroll
                        for (int n = 0; n < 2; ++n) *(f32x4*)(hb + (size_t)mm * NUP + bj * DFF + jc + 4 * n) = acc[1][bj][mm][n];
            }
        }
        const bool f0 = fr == 0, f15 = fr == 15;
        const PG8_LAS float* cl = (const PG8_LAS float*)(uintptr_t)cwl_lane;
#pragma unroll
        for (int ai = 0; ai < 2; ++ai) {
            const int g = 2 * ai + wr;
            const int gp = g - 1, gn = g + 1;
            unsigned pk[4][4];
#pragma unroll
            for (int n = 0; n < 2; ++n)
#pragma unroll
                for (int ep = 0; ep < 2; ++ep) {
                    f32x2v cv[2][4];
#pragma unroll
                    for (int bj = 0; bj < 2; ++bj) {
                        const int c = bj * 128 + 4 * n + 2 * ep;
                        const f32x2v w0 = *(const PG8_LAS f32x2v*)(cl + c), w1 = *(const PG8_LAS f32x2v*)(cl + 256 + c), w2 = *(const PG8_LAS f32x2v*)(cl + 512 + c), bb = *(const PG8_LAS f32x2v*)(cl + 768 + c);
                        f32x2v bprev = {0.f, 0.f}, bnext = {0.f, 0.f};
                        if (gp >= 0) bprev = *(const PG8_LAS f32x2v*)(EX + (((((gp & 1) * 4 + wc) * 2 + (gp >> 1)) * 2 + 1) * 64 + bj * 32 + 8 * fq + 4 * n + 2 * ep));
                        if (gn <= 3) bnext = *(const PG8_LAS f32x2v*)(EX + (((((gn & 1) * 4 + wc) * 2 + (gn >> 1)) * 2 + 0) * 64 + bj * 32 + 8 * fq + 4 * n + 2 * ep));
                        f32x2v x[4];
#pragma unroll
                        for (int m = 0; m < 4; ++m) x[m] = (f32x2v){acc[ai][bj][m][n][2 * ep], acc[ai][bj][m][n][2 * ep + 1]};
                        f32x2v pv, nx;
                        pv.x = dpp_mov<0x121>(x[3].x); pv.y = dpp_mov<0x121>(x[3].y); nx.x = dpp_mov<0x12f>(x[0].x); nx.y = dpp_mov<0x12f>(x[0].y);
                        pv.x = f0 ? bprev.x : pv.x; pv.y = f0 ? bprev.y : pv.y; nx.x = f15 ? bnext.x : nx.x; nx.y = f15 ? bnext.y : nx.y;
                        cv[bj][0] = __builtin_elementwise_fma(w2, x[1], __builtin_elementwise_fma(w1, x[0], __builtin_elementwise_fma(w0, pv, bb)));
                        cv[bj][1] = __builtin_elementwise_fma(w2, x[2], __builtin_elementwise_fma(w1, x[1], __builtin_elementwise_fma(w0, x[0], bb)));
                        cv[bj][2] = __builtin_elementwise_fma(w2, x[3], __builtin_elementwise_fma(w1, x[2], __builtin_elementwise_fma(w0, x[1], bb)));
                        cv[bj][3] = __builtin_elementwise_fma(w2, nx, __builtin_elementwise_fma(w1, x[3], __builtin_elementwise_fma(w0, x[2], bb)));
                    }
#pragma unroll
                    for (int m = 0; m < 4; ++m) pk[m][n * 2 + ep] = cvt_pk_bf16(gate2(cv[1][m].x, cv[0][m].x), gate2(cv[1][m].y, cv[0][m].y));
                    __builtin_amdgcn_sched_barrier(0);
                }
#pragma unroll
            for (int m = 0; m < 4; ++m) {
                const size_t row = (size_t)u.pm * BM + ai * HALF + wr * 64 + 4 * fr + m;
                u32x4 w; w.x = pk[m][0]; w.y = pk[m][1]; w.z = pk[m][2]; w.w = pk[m][3];
                *(u32x4*)(ACT + row * DFF + jc) = w;
            }
            __builtin_amdgcn_sched_barrier(0);
        }
    }
};
}

__device__ __forceinline__ void transpose_item(const float* W, int N, int k0, int n0, bf16* WT, int ldt, int kcol0, int orow0, LAS float* scr, int lane) {
    f32x4 w[8];
#pragma unroll
    for (int i = 0; i < 8; ++i) w[i] = *(const f32x4*)(W + (size_t)(k0 + 8 * i + (lane >> 3)) * N + n0 + 4 * (lane & 7));
#pragma unroll
    for (int i = 0; i < 8; ++i) { LAS float* d = scr + (8 * i + (lane >> 3)) * 33 + 4 * (lane & 7); d[0] = w[i][0]; d[1] = w[i][1]; d[2] = w[i][2]; d[3] = w[i][3]; }
    LDS_WAIT(); asm volatile("" ::: "memory");
    const int c = lane & 7;
#pragma unroll
    for (int j = 0; j < 4; ++j) { const int n = (lane >> 3) + 8 * j; const LAS float* s = scr + (8 * c) * 33 + n;
        v4u o; o.x = pkc(s[0 * 33], s[1 * 33]); o.y = pkc(s[2 * 33], s[3 * 33]); o.z = pkc(s[4 * 33], s[5 * 33]); o.w = pkc(s[6 * 33], s[7 * 33]);
        *(GAS v4u*)(WT + (size_t)(orow0 + n) * ldt + kcol0 + k0 + 8 * c) = o; }
    LDS_WAIT(); asm volatile("" ::: "memory");
}
__device__ __forceinline__ void phase_prologue(const int wv) {
    const Ctx C = make_ctx(wv);
    {
        LAS float* S = (LAS float*)(C.lds);
        LAS float* red = (LAS float*)(C.lds + 40960);
        const float* cin = inp(C, 1); const float* cctx = inp(C, 3); const float* wmod = inp(C, 4); const float* bmod = inp(C, 5);
        for (int i = C.tid; i < 9 * 1024; i += 512) { const int r = i >> 10, k = i & 1023; const float v = (r < 8) ? cin[r * 1024 + k] : cctx[k]; S[i] = v / (1.f + expf(-v)); }
        __syncthreads();
        for (int it = blockIdx.x; it < NL * 192; it += C.G) {
            const int l = it / 192, col0 = (it % 192) * 32;
            const float* W = wmod + (size_t)l * 1024 * 6144 + col0 + 4 * (C.lane & 7);
            f32x4 acc[9];
#pragma unroll
            for (int r = 0; r < 9; ++r) acc[r] = (f32x4){0.f, 0.f, 0.f, 0.f};
            const int kb = C.wave * 128 + (C.lane >> 3);
#pragma unroll 4
            for (int i = 0; i < 16; ++i) { const int k = kb + 8 * i; const f32x4 w = *(const f32x4*)(W + (size_t)k * 6144);
#pragma unroll
                for (int r = 0; r < 9; ++r) acc[r] += w * S[r * 1024 + k]; }
#pragma unroll
            for (int r = 0; r < 9; ++r)
#pragma unroll
                for (int e = 0; e < 4; ++e) { float v = acc[r][e]; v += swz<8>(v); v += swz<16>(v); acc[r][e] = sum32(v); }
            if (C.lane < 8) {
#pragma unroll
                for (int r = 0; r < 9; ++r) *(LAS f32x4*)(red + (C.wave * 9 + r) * 32 + 4 * C.lane) = acc[r];
            }
            __syncthreads();
            if (C.tid < 288) { const int r = C.tid >> 5, cc = C.tid & 31; float s = 0.f;
#pragma unroll
                for (int w = 0; w < 8; ++w) s += red[(w * 9 + r) * 32 + cc];
                ((float*)(wsp(C) + WS_MODS))[(size_t)(l * 9 + r) * 6144 + col0 + cc] = s + bmod[l * 6144 + col0 + cc]; }
            __syncthreads();
        }
    }
    {
        LAS float* scr = (LAS float*)(C.lds + 49152 + C.wave * 9216);
        constexpr int I_IN = 16 * 77, I_OUT = 16 * 32, I_UP = 16 * 176, I_DN = 44 * 32, I_UQ = 4 * 12, I_UKV = 2 * 16, I_L = I_IN + I_OUT + I_UP + I_DN + I_UQ + I_UKV;
        for (int it = C.gw; it < NL * I_L; it += C.NGW) {
            const int l = it / I_L; int r = it % I_L;
            if (r < I_IN) { const int kb = r / 77, nb = r % 77, n0 = nb * 32; transpose_item(inp(C, 7) + (size_t)l * DM * NIN, NIN, kb * 64, n0, wptr(C, l, W_IN), DM, 0, n0 < 416 ? n0 : n0 + 96, scr, C.lane); continue; } r -= I_IN;
            if (r < I_OUT) { const int kb = r / 32, nb = r % 32; transpose_item(inp(C, 8) + (size_t)l * DM * DM, DM, kb * 64, nb * 32, wptr(C, l, W_OUT), DM, 0, nb * 32, scr, C.lane); continue; } r -= I_OUT;
            if (r < I_UP) { const int kb = r / 176, nb = r % 176, n0 = nb * 32, bj = n0 >= DFF ? 1 : 0, j0 = n0 - bj * DFF;
                transpose_item(inp(C, 28) + (size_t)l * DM * NUP, NUP, kb * 64, n0, wptr(C, l, W_UP), DM, 0, 256 * (j0 >> 7) + 128 * bj + (j0 & 127), scr, C.lane); continue; } r -= I_UP;
            if (r < I_DN) { const int kb = r / 32, nb = r % 32; transpose_item(inp(C, 31) + (size_t)l * DFF * DM, DM, kb * 64, nb * 32, wptr(C, l, W_DOWN), DFF, 0, nb * 32, scr, C.lane); continue; } r -= I_DN;
            if (r < I_UQ) { const int kb = r / 12, nb = r % 12; transpose_item(inp(C, 10) + (size_t)l * 256 * 384, 384, kb * 64, nb * 32, wptr(C, l, W_MLA), KMLA, 0, nb * 32, scr, C.lane); continue; } r -= I_UQ;
            { const int kb = r / 16, nb = r % 16; transpose_item(inp(C, 12) + (size_t)l * 128 * 512, 512, kb * 64, nb * 32, wptr(C, l, W_MLA), KMLA, 256, 512 + nb * 32, scr, C.lane); }
        }
        const int gt = C.gw * 64 + C.lane, NGT = C.NGW * 64;
        const v4u z = {0u, 0u, 0u, 0u};
        for (int i = gt; i < NL * 96 * 128; i += NGT) { const int l = i / (96 * 128), r = i % (96 * 128); *(GAS v4u*)(wptr(C, l, W_IN) + (size_t)(416 + r / 128) * DM + (r % 128) * 8) = z; }
        for (int i = gt; i < NL * 1024 * 48; i += NGT) { const int l = i / (1024 * 48), r = (i / 48) % 1024, k = (i % 48) * 8;
            const bool zero = (r < 384) ? (k >= 256) : (r < 512) ? true : (k < 256);
            if (zero) *(GAS v4u*)(wptr(C, l, W_MLA) + (size_t)r * KMLA + k) = z; }
        float* r32 = (float*)(wsp(C) + WS_ROPE32); float* r64 = (float*)(wsp(C) + WS_ROPE64);
        for (int i = gt; i < 2048 * 48; i += NGT) {
            const int pos = i / 48, e = i % 48; const float row = (float)(pos >> 6), col = (float)(pos & 63);
            if (e < 16) { const int f = e & 7; const float inv = powf(10000.f, -(float)f / 8.f); const float a = (e < 8 ? row : col) * inv; r32[(pos * 16 + e) * 2] = cosf(a); r32[(pos * 16 + e) * 2 + 1] = sinf(a); }
            else { const int e2 = e - 16, f = e2 & 15; const float inv = powf(10000.f, -(float)f / 16.f); const float a = (e2 < 16 ? row : col) * inv; r64[(pos * 32 + e2) * 2] = cosf(a); r64[(pos * 32 + e2) * 2 + 1] = sinf(a); }
        }
    }
}

__device__ __forceinline__ void phase_norm(const int wv, int l, int which, int nrows) {
    const Ctx C = make_ctx(wv);
    const bool first = (l == 0 && which == 1);
    const bool slabbed = !first;
    const float* xl = first ? inp(C, 0) : outp(C); const float* xc = (l == 0 && which <= 2 && (first || which == 2)) ? inp(C, 2) : ((float*)(wsp(C) + WS_XC));
    float* XCw = (float*)(wsp(C) + WS_XC); const float* slab = (const float*)(wsp(C) + WS_SLAB);
    const float* gv = (which == 1 ? inp(C, 6) : inp(C, 27)) + l * DM;
    f32x4 g4[4];
#pragma unroll
    for (int j = 0; j < 4; ++j) g4[j] = *(const f32x4*)(gv + 4 * C.lane + 256 * j);
    bf16* XN = (bf16*)(wsp(C) + WS_XN); const float* mods = (const float*)(wsp(C) + WS_MODS);
    for (int R0 = C.gw; R0 < nrows; R0 += 3 * C.NGW) {
        f32x4 v[3][4]; float ss[3];
#pragma unroll
        for (int u = 0; u < 3; ++u) { const int R = R0 + u * C.NGW; ss[u] = 0.f;
            if (R < nrows) { const float* src = R < ML ? xl + (size_t)R * DM : xc + (size_t)(R - ML) * DM;
#pragma unroll
                for (int j = 0; j < 4; ++j) v[u][j] = *(const f32x4*)(src + 4 * C.lane + 256 * j);
                if (R >= ML && slabbed) {
#pragma unroll
                    for (int sp = 0; sp < 4; ++sp)
#pragma unroll
                        for (int j = 0; j < 4; ++j) v[u][j] += *(const f32x4*)(slab + ((size_t)sp * MC + (R - ML)) * DM + 4 * C.lane + 256 * j);
#pragma unroll
                    for (int j = 0; j < 4; ++j) *(f32x4*)(XCw + (size_t)(R - ML) * DM + 4 * C.lane + 256 * j) = v[u][j];
                }
#pragma unroll
                for (int j = 0; j < 4; ++j) { ss[u] += (v[u][j][0] * v[u][j][0] + v[u][j][1] * v[u][j][1]) + (v[u][j][2] * v[u][j][2] + v[u][j][3] * v[u][j][3]); } } }
#pragma unroll
        for (int u = 0; u < 3; ++u) ss[u] = wave_sum(ss[u]);
#pragma unroll
        for (int u = 0; u < 3; ++u) { const int R = R0 + u * C.NGW;
            if (R < nrows) { const float rs = rsq_f(ss[u] * (1.f / DM) + EPS);
                const int bidx = R < ML ? (R >> 11) : 8; const float* md = mods + (size_t)(l * 9 + bidx) * 6144 + (which == 1 ? 0 : 3072);
#pragma unroll
                for (int j = 0; j < 4; ++j) {
                    const f32x4 sh = *(const f32x4*)(md + 4 * C.lane + 256 * j), sc = *(const f32x4*)(md + 1024 + 4 * C.lane + 256 * j);
                    const f32x4 y = (v[u][j] * rs) * g4[j] * (sc + 1.f) + sh;
                    u32x2v w; w.x = pkc(y[0], y[1]); w.y = pkc(y[2], y[3]);
                    *(u32x2v*)(XN + (size_t)R * DM + 4 * C.lane + 256 * j) = w; } } }
    }
}

__device__ __forceinline__ void row_info(int R, int& b, int& qi, int& pos) {
    if (R < ML) { b = R >> 11; qi = R & 2047; pos = qi; } else { const int r = R - ML; b = r >> 8; qi = 2048 + (r & 255); pos = -1; }
}
template <int MAXO> __device__ __forceinline__ float red_xor(float v) { v += swz<1>(v); v += swz<2>(v); v += swz<4>(v); if (MAXO >= 8) v += swz<8>(v); if (MAXO >= 16) v += swz<16>(v); return v; }

constexpr int TB = 8;
__device__ __forceinline__ void phase_prep1(const int wv, int l) {
    const Ctx C = make_ctx(wv);
    LAS unsigned char* img = C.lds + C.wave * 16384;
    bf16* Q = ((bf16*)(wsp(C) + WS_QKV));
    const bf16* P = (const bf16*)(wsp(C) + WS_P); bf16* CQKV = (bf16*)(wsp(C) + WS_CQKV);
    const float* rope32 = (const float*)(wsp(C) + WS_ROPE32); const float* rope64 = (const float*)(wsp(C) + WS_ROPE64);
    const float C32 = 0.17677669529663687f * LOG2E, C64 = 0.125f * LOG2E;
    const int lane = C.lane;
    for (int item = C.gw; item < 3 * (MT / 16); item += C.NGW) {
        const int part = item / (MT / 16), g = item % (MT / 16), R0 = 16 * g;
        int b, qi0, pos0; row_info(R0, b, qi0, pos0);
        const int tile = qi0 >> 6, sidx = (qi0 >> 4) & 3;
        if (part == 0) {
            const int gi = lane >> 3, lg = lane & 7, d0 = 4 * lg, ti0 = ((lg & 4) ? 8 : 0) + 4 * (lg & 1); const bool rot = pos0 >= 0;
            const float* gq = inp(C, 15) + l * 32 + d0; const float* gk = inp(C, 16) + l * 32 + d0;
            float gqv[4], gkv[4];
#pragma unroll
            for (int e = 0; e < 4; ++e) { gqv[e] = gq[e]; gkv[e] = gk[e]; }
            for (int t0 = 0; t0 < 16; t0 += TB) {
            u32x2v wq4[TB], wk4[TB], wv4[TB]; f32x4 rt4[TB][2];
#pragma unroll
            for (int tt = 0; tt < TB; ++tt) { const bf16* pr = P + (size_t)(R0 + t0 + tt) * NINP; wq4[tt] = *(const u32x2v*)(pr + PC_DQ + 4 * lane); wk4[tt] = *(const u32x2v*)(pr + PC_DK + 4 * lane); wv4[tt] = *(const u32x2v*)(pr + PC_DV + 4 * lane);
                const float* rp = rope32 + ((rot ? pos0 + t0 + tt : 0) * 16 + ti0) * 2; rt4[tt][0] = *(const f32x4*)rp; rt4[tt][1] = *(const f32x4*)(rp + 4); }
#pragma unroll
            for (int tt = 0; tt < TB; ++tt) {
                const int t = t0 + tt;
                const u32x2v wq = wq4[tt], wk = wk4[tt], wvv = wv4[tt];
#pragma unroll
                for (int qk = 0; qk < 2; ++qk) {
                    const u32x2v w = qk ? wk : wq; float v[4] = {bflo(w.x), bfhi(w.x), bflo(w.y), bfhi(w.y)};
                    float ss = (v[0] * v[0] + v[1] * v[1]) + (v[2] * v[2] + v[3] * v[3]); ss = red_xor<4>(ss);
                    const float rs = rsq_f(ss * (1.f / 32.f) + EPS);
                    float y[4];
#pragma unroll
                    for (int e = 0; e < 4; ++e) y[e] = v[e] * rs * (qk ? gkv[e] : gqv[e]);
#pragma unroll
                    for (int e = 0; e < 4; ++e) { const float pp = swz<2>(y[e]); const float cs = rot ? rt4[tt][e >> 1][2 * (e & 1)] : 1.f, sn = rot ? rt4[tt][e >> 1][2 * (e & 1) + 1] : 0.f;
                        v[e] = y[e] * cs + ((lg & 2) ? pp : -pp) * sn; }
                    if (qk == 0) { u32x2v o; o.x = pkc(v[0] * C32, v[1] * C32); o.y = pkc(v[2] * C32, v[3] * C32); *(u32x2v*)(Q + E_QD + q_off(8, 32, b, gi, qi0 + t) + d0) = o; }
                    else { u32x2v o; o.x = pkc(v[0], v[1]); o.y = pkc(v[2], v[3]); *(LAS u32x2v*)(img + ((gi * 4 + (d0 >> 3)) * 16 + t) * 16 + (d0 & 7) * 2) = o; }
                }
                {   const int h = lane >> 4, dv0 = 4 * (lane & 15), hh = (t >> 2) & 1, j = (t & 3) + 4 * (t >> 3);
                    LAS unsigned short* vp = (LAS unsigned short*)(img + 8192 + ((h * 2 + hh) * 64 + dv0) * 16 + j * 2);
                    vp[0] = (unsigned short)(wvv.x & 0xffff); vp[8] = (unsigned short)(wvv.x >> 16); vp[16] = (unsigned short)(wvv.y & 0xffff); vp[24] = (unsigned short)(wvv.y >> 16); }
            }
            }
            LDS_WAIT(); asm volatile("" ::: "memory");
#pragma unroll
            for (int i = 0; i < 8; ++i) { const int pc = lane + 64 * i; const int gi2 = pc >> 6, ch = (pc >> 4) & 3, t = pc & 15;
                *(GAS v4u*)(Q + E_KD + k_off(8, 32, b, gi2, qi0 + t, 8 * ch)) = *(const LAS v4u*)(img + pc * 16); }
#pragma unroll
            for (int i = 0; i < 8; ++i) { const int pc = lane + 64 * i; const int h = pc >> 7, hh = (pc >> 6) & 1, dv = pc & 63;
                *(GAS v4u*)(Q + E_VD + ((((size_t)(b * 4 + h) * NKT + tile) * 8 + (sidx * 2 + hh)) * 64 + dv) * 8) = *(const LAS v4u*)(img + 8192 + pc * 16); }
        } else if (part == 1) {
            const int h = lane >> 4, d0 = 4 * (lane & 15);
            const float* gq = inp(C, 22) + l * 64 + d0; const float* gk = inp(C, 23) + l * 64 + d0;
            float gqv[4], gkv[4];
#pragma unroll
            for (int e = 0; e < 4; ++e) { gqv[e] = gq[e]; gkv[e] = gk[e]; }
            for (int t0 = 0; t0 < 16; t0 += TB) {
            u32x2v wq4[TB], wk4[TB], wv4[TB];
#pragma unroll
            for (int tt = 0; tt < TB; ++tt) { const bf16* pr = P + (size_t)(R0 + t0 + tt) * NINP; wq4[tt] = *(const u32x2v*)(pr + PC_NQ + 4 * lane); wk4[tt] = *(const u32x2v*)(pr + PC_NK + 4 * lane); wv4[tt] = *(const u32x2v*)(pr + PC_NV + 4 * lane); }
#pragma unroll
            for (int tt = 0; tt < TB; ++tt) {
                const int t = t0 + tt;
                const u32x2v wq = wq4[tt], wk = wk4[tt], wvv = wv4[tt];
#pragma unroll
                for (int qk = 0; qk < 2; ++qk) {
                    const u32x2v w = qk ? wk : wq; float v[4] = {bflo(w.x), bfhi(w.x), bflo(w.y), bfhi(w.y)};
                    float ss = (v[0] * v[0] + v[1] * v[1]) + (v[2] * v[2] + v[3] * v[3]); ss = red_xor<8>(ss);
                    const float rs = rsq_f(ss * (1.f / 64.f) + EPS);
#pragma unroll
                    for (int e = 0; e < 4; ++e) v[e] = v[e] * rs * (qk ? gkv[e] : gqv[e]);
                    if (qk == 0) { u32x2v o; o.x = pkc(v[0] * C64, v[1] * C64); o.y = pkc(v[2] * C64, v[3] * C64); *(u32x2v*)(Q + E_QN + q_off(4, 64, b, h, qi0 + t) + d0) = o; }
                    else { u32x2v o; o.x = pkc(v[0], v[1]); o.y = pkc(v[2], v[3]); *(LAS u32x2v*)(img + ((h * 8 + (d0 >> 3)) * 16 + t) * 16 + (d0 & 7) * 2) = o; }
                }
                {   const int hh = (t >> 2) & 1, j = (t & 3) + 4 * (t >> 3);
                    LAS unsigned short* vp = (LAS unsigned short*)(img + 8192 + ((h * 2 + hh) * 64 + d0) * 16 + j * 2);
                    vp[0] = (unsigned short)(wvv.x & 0xffff); vp[8] = (unsigned short)(wvv.x >> 16); vp[16] = (unsigned short)(wvv.y & 0xffff); vp[24] = (unsigned short)(wvv.y >> 16); }
            }
            }
            LDS_WAIT(); asm volatile("" ::: "memory");
#pragma unroll
            for (int i = 0; i < 8; ++i) { const int pc = lane + 64 * i; const int h2 = pc >> 7, ch = (pc >> 4) & 7, t = pc & 15;
                *(GAS v4u*)(Q + E_KN + k_off(4, 64, b, h2, qi0 + t, 8 * ch)) = *(const LAS v4u*)(img + pc * 16); }
#pragma unroll
            for (int i = 0; i < 8; ++i) { const int pc = lane + 64 * i; const int h2 = pc >> 7, hh = (pc >> 6) & 1, dv = pc & 63;
                *(GAS v4u*)(Q + E_VN + ((((size_t)(b * 4 + h2) * NKT + tile) * 8 + (sidx * 2 + hh)) * 64 + dv) * 8) = *(const LAS v4u*)(img + 8192 + pc * 16); }
        } else {
            const int h = lane >> 4, lh = lane & 15, d0 = 4 * lh;
            const int hk = lane >> 5, ll = lane & 31, dk0 = 2 * ll;
            const int tiq = ((lh & 8) ? 16 : 0) + 4 * (lh & 3), tik = ((ll & 16) ? 16 : 0) + 2 * (ll & 7); const bool rot = pos0 >= 0;
            const float* gq = inp(C, 25) + l * 64 + d0; const float* gk = inp(C, 26) + l * 64 + dk0;
            const float* ga = inp(C, 9) + l * 256 + 4 * lane; const float* gb = inp(C, 11) + l * 128 + 2 * lane;
            float gqv[4], gav[4], gkv[2], gbv[2];
#pragma unroll
            for (int e = 0; e < 4; ++e) { gqv[e] = gq[e]; gav[e] = ga[e]; }
            gkv[0] = gk[0]; gkv[1] = gk[1]; gbv[0] = gb[0]; gbv[1] = gb[1];
            for (int t0 = 0; t0 < 16; t0 += TB) {
            u32x2v wa4[TB], wq4[TB]; unsigned wb4[TB], wk4[TB], wv4[TB]; f32x4 rq4[TB][2], rk4[TB];
#pragma unroll
            for (int tt = 0; tt < TB; ++tt) { const bf16* pr = P + (size_t)(R0 + t0 + tt) * NINP; wa4[tt] = *(const u32x2v*)(pr + PC_CQ + 4 * lane); wq4[tt] = *(const u32x2v*)(pr + PC_GQ + 4 * lane);
                wb4[tt] = *(const unsigned*)(pr + PC_CKV + 2 * lane); wk4[tt] = *(const unsigned*)(pr + PC_GK + 2 * lane); wv4[tt] = *(const unsigned*)(pr + PC_GV + 2 * lane);
                const float* rp = rope64 + (rot ? pos0 + t0 + tt : 0) * 64; rq4[tt][0] = *(const f32x4*)(rp + 2 * tiq); rq4[tt][1] = *(const f32x4*)(rp + 2 * tiq + 4); rk4[tt] = *(const f32x4*)(rp + 2 * tik); }
#pragma unroll
            for (int tt = 0; tt < TB; ++tt) {
                const int t = t0 + tt; const int R = R0 + t;
                const u32x2v wa = wa4[tt], wq = wq4[tt]; const unsigned wb = wb4[tt], wk = wk4[tt], wvv = wv4[tt];
                {   float v[4] = {bflo(wa.x), bfhi(wa.x), bflo(wa.y), bfhi(wa.y)};
                    const float rs = rsq_f(wave_sum((v[0] * v[0] + v[1] * v[1]) + (v[2] * v[2] + v[3] * v[3])) * (1.f / 256.f) + EPS);
                    u32x2v o; o.x = pkc(v[0] * rs * gav[0], v[1] * rs * gav[1]); o.y = pkc(v[2] * rs * gav[2], v[3] * rs * gav[3]);
                    *(u32x2v*)(CQKV + (size_t)R * KMLA + 4 * lane) = o; }
                {   const float v0 = bflo(wb), v1 = bfhi(wb);
                    const float rs = rsq_f(wave_sum(v0 * v0 + v1 * v1) * (1.f / 128.f) + EPS);
                    *(unsigned*)(CQKV + (size_t)R * KMLA + 256 + 2 * lane) = pkc(v0 * rs * gbv[0], v1 * rs * gbv[1]); }
                {   float v[4] = {bflo(wq.x), bfhi(wq.x), bflo(wq.y), bfhi(wq.y)};
                    float ss = (v[0] * v[0] + v[1] * v[1]) + (v[2] * v[2] + v[3] * v[3]); ss = red_xor<8>(ss);
                    const float rs = rsq_f(ss * (1.f / 64.f) + EPS);
                    float y[4];
#pragma unroll
                    for (int e = 0; e < 4; ++e) y[e] = v[e] * rs * gqv[e];
#pragma unroll
                    for (int e = 0; e < 4; ++e) { const float pp = swz<4>(y[e]); const float cs = rot ? rq4[tt][e >> 1][2 * (e & 1)] : 1.f, sn = rot ? rq4[tt][e >> 1][2 * (e & 1) + 1] : 0.f;
                        v[e] = y[e] * cs + ((lh & 4) ? pp : -pp) * sn; }
                    u32x2v o; o.x = pkc(v[0] * C64, v[1] * C64); o.y = pkc(v[2] * C64, v[3] * C64); *(u32x2v*)(Q + E_QG + q_off(4, 64, b, h, qi0 + t) + d0) = o; }
                {   float v[2] = {bflo(wk), bfhi(wk)};
                    float ss = v[0] * v[0] + v[1] * v[1]; ss = red_xor<16>(ss);
                    const float rs = rsq_f(ss * (1.f / 64.f) + EPS);
                    float y[2] = {v[0] * rs * gkv[0], v[1] * rs * gkv[1]};
#pragma unroll
                    for (int e = 0; e < 2; ++e) { const float pp = swz<8>(y[e]); const float cs = rot ? rk4[tt][2 * e] : 1.f, sn = rot ? rk4[tt][2 * e + 1] : 0.f;
                        v[e] = y[e] * cs + ((ll & 8) ? pp : -pp) * sn; }
                    *(LAS unsigned*)(img + ((hk * 8 + (dk0 >> 3)) * 16 + t) * 16 + (dk0 & 7) * 2) = pkc(v[0], v[1]); }
                {   const int hh = (t >> 2) & 1, j = (t & 3) + 4 * (t >> 3);
                    LAS unsigned short* vp = (LAS unsigned short*)(img + 8192 + ((hk * 2 + hh) * 64 + dk0) * 16 + j * 2);
                    vp[0] = (unsigned short)(wvv & 0xffff); vp[8] = (unsigned short)(wvv >> 16); }
            }
            }
            LDS_WAIT(); asm volatile("" ::: "memory");
#pragma unroll
            for (int i = 0; i < 4; ++i) { const int pc = lane + 64 * i; const int h2 = pc >> 7, ch = (pc >> 4) & 7, t = pc & 15;
                *(GAS v4u*)(Q + E_KG + k_off(2, 64, b, h2, qi0 + t, 8 * ch)) = *(const LAS v4u*)(img + pc * 16); }
#pragma unroll
            for (int i = 0; i < 4; ++i) { const int pc = lane + 64 * i; const int h2 = pc >> 7, hh = (pc >> 6) & 1, dv = pc & 63;
                *(GAS v4u*)(Q + E_VG + ((((size_t)(b * 2 + h2) * NKT + tile) * 8 + (sidx * 2 + hh)) * 64 + dv) * 8) = *(const LAS v4u*)(img + 8192 + pc * 16); }
        }
        LDS_WAIT(); asm volatile("" ::: "memory");
    }
}

__device__ __forceinline__ void phase_prep2(const int wv, int l) {
    const Ctx C = make_ctx(wv);
    LAS unsigned char* img = C.lds + C.wave * 16384;
    bf16* Q = ((bf16*)(wsp(C) + WS_QKV));
    const bf16* P = (const bf16*)(wsp(C) + WS_P); const bf16* MLAP = (const bf16*)(wsp(C) + WS_MLAP);
    const float* rope32 = (const float*)(wsp(C) + WS_ROPE32);
    const float C96 = 0.10206207261596575f * LOG2E;
    const int lane = C.lane, h = lane >> 4, c = lane & 15; const bool on = c < 12;
    constexpr int TB = 4;
    for (int item = C.gw; item < 3 * (MT / 16); item += C.NGW) {
        const int pass = item / (MT / 16), g = item % (MT / 16), R0 = 16 * g;
        int b, qi0, pos0; row_info(R0, b, qi0, pos0);
        const int tile = qi0 >> 6, sidx = (qi0 >> 4) & 3;
        if (l == NL - 1 && pass == 0 && pos0 < 0) continue;
        const bool rot = pos0 >= 0;
        if (pass < 2) {
            float gv[8];
            { const float* gp = inp(C, pass ? 14 : 13) + l * 96 + 8 * (on ? c : 0);
#pragma unroll
              for (int e = 0; e < 8; ++e) gv[e] = gp[e]; }
            for (int t0 = 0; t0 < 16; t0 += TB) {
                v4u w4[TB]; f32x4 rt[TB][4];
#pragma unroll
                for (int tt = 0; tt < TB; ++tt) { const size_t R = R0 + t0 + tt;
                    const bf16* src = pass == 0 ? MLAP + R * NMLA + h * 96 + 8 * c : (c < 8 ? MLAP + R * NMLA + 512 + h * 128 + 8 * c : P + R * NINP + PC_KR + 8 * (c - 8));
                    const v4u z = {0u, 0u, 0u, 0u}; w4[tt] = on ? *(const GAS v4u*)src : z;
                    const float* rp = rope32 + ((rot ? pos0 + t0 + tt : 0) * 16 + (c >= 10 ? 8 : 0)) * 2;
#pragma unroll
                    for (int k4 = 0; k4 < 4; ++k4) rt[tt][k4] = *(const f32x4*)(rp + 4 * k4); }
#pragma unroll
                for (int tt = 0; tt < TB; ++tt) {
                    const int t = t0 + tt;
                    float v[8] = {bflo(w4[tt].x), bfhi(w4[tt].x), bflo(w4[tt].y), bfhi(w4[tt].y), bflo(w4[tt].z), bfhi(w4[tt].z), bflo(w4[tt].w), bfhi(w4[tt].w)};
                    float ss = ((v[0] * v[0] + v[1] * v[1]) + (v[2] * v[2] + v[3] * v[3])) + ((v[4] * v[4] + v[5] * v[5]) + (v[6] * v[6] + v[7] * v[7]));
                    ss = red_xor<8>(ss);
                    const float rs = rsq_f(ss * (1.f / 96.f) + EPS);
#pragma unroll
                    for (int e = 0; e < 8; ++e) v[e] = v[e] * rs * gv[e];
#pragma unroll
                    for (int e = 0; e < 8; ++e) { const float pp = swz<1>(v[e]); const bool rr = rot && c >= 8; const float cs = rr ? rt[tt][e >> 1][2 * (e & 1)] : 1.f, sn = rr ? rt[tt][e >> 1][2 * (e & 1) + 1] : 0.f;
                        v[e] = v[e] * cs + ((c & 1) ? pp : -pp) * sn; }
                    if (pass == 0) { v4u o; o.x = pkc(v[0] * C96, v[1] * C96); o.y = pkc(v[2] * C96, v[3] * C96); o.z = pkc(v[4] * C96, v[5] * C96); o.w = pkc(v[6] * C96, v[7] * C96);
                        if (on) *(GAS v4u*)(Q + E_QA + q_off(4, 96, b, h, qi0 + t) + 8 * c) = o; }
                    else { v4u o; o.x = pkc(v[0], v[1]); o.y = pkc(v[2], v[3]); o.z = pkc(v[4], v[5]); o.w = pkc(v[6], v[7]);
                        if (on) *(LAS v4u*)(img + ((h * 12 + c) * 16 + t) * 16) = o; }
                }
            }
            if (pass == 1) {
                LDS_WAIT(); asm volatile("" ::: "memory");
#pragma unroll
                for (int i = 0; i < 12; ++i) { const int pc = lane + 64 * i; const int h2 = pc / 192, ch = (pc >> 4) % 12, t = pc & 15;
                    *(GAS v4u*)(Q + E_KA + k_off(4, 96, b, h2, qi0 + t, 8 * ch)) = *(const LAS v4u*)(img + pc * 16); }
            }
        } else {
            for (int t0 = 0; t0 < 16; t0 += TB) {
                v4u w4[TB];
#pragma unroll
                for (int tt = 0; tt < TB; ++tt) { const size_t R = R0 + t0 + tt; const v4u z = {0u, 0u, 0u, 0u}; w4[tt] = c < 8 ? *(const GAS v4u*)(MLAP + R * NMLA + 512 + h * 128 + 64 + 8 * c) : z; }
#pragma unroll
                for (int tt = 0; tt < TB; ++tt) { const int t = t0 + tt, hh = (t >> 2) & 1, j = (t & 3) + 4 * (t >> 3);
                    LAS unsigned short* vp = (LAS unsigned short*)(img + ((h * 2 + hh) * 64 + 8 * c) * 16 + j * 2);
                    if (c < 8) { vp[0] = (unsigned short)(w4[tt].x & 0xffff); vp[8] = (unsigned short)(w4[tt].x >> 16); vp[16] = (unsigned short)(w4[tt].y & 0xffff); vp[24] = (unsigned short)(w4[tt].y >> 16);
                        vp[32] = (unsigned short)(w4[tt].z & 0xffff); vp[40] = (unsigned short)(w4[tt].z >> 16); vp[48] = (unsigned short)(w4[tt].w & 0xffff); vp[56] = (unsigned short)(w4[tt].w >> 16); } }
            }
            LDS_WAIT(); asm volatile("" ::: "memory");
#pragma unroll
            for (int i = 0; i < 8; ++i) { const int pc = lane + 64 * i; const int h2 = pc >> 7, hh = (pc >> 6) & 1, dv = pc & 63;
                *(GAS v4u*)(Q + E_VA + ((((size_t)(b * 4 + h2) * NKT + tile) * 8 + (sidx * 2 + hh)) * 64 + dv) * 8) = *(const LAS v4u*)(img + pc * 16); }
        }
        LDS_WAIT(); asm volatile("" ::: "memory");
    }
}

template <int DK, int HQ, int HK, int HV, bool NA>
__device__ __forceinline__ void naive_attn_one(const bf16* Qb, const bf16* Kb, const bf16* Vb, const float* rpb, int b, int hq, int hk, int hv, int qi, float (&o)[64]) {
    float q[DK];
    { const bf16* qp = Qb + q_off(HQ, DK, b, hq, qi);
#pragma unroll
      for (int c = 0; c < DK / 8; ++c) { const v4u w = *(const v4u*)(qp + 8 * c); q[8 * c] = bflo(w.x); q[8 * c + 1] = bfhi(w.x); q[8 * c + 2] = bflo(w.y); q[8 * c + 3] = bfhi(w.y); q[8 * c + 4] = bflo(w.z); q[8 * c + 5] = bfhi(w.z); q[8 * c + 6] = bflo(w.w); q[8 * c + 7] = bfhi(w.w); } }
    float m = -1e30f, ls = 0.f;
#pragma unroll
    for (int d = 0; d < 64; ++d) o[d] = 0.f;
    const bool isctx = qi >= SEQ;
    const int r = qi >> 6, qc = qi & 63;
    const int rs0 = min(max(r - 4, 0), 24), ws0 = min(max(qc - 8, 0), 48);
    const int nloc = isctx ? 0 : (NA ? 128 : SEQ);
    const int ntot = nloc + CTXL;
    for (int it = 0; it < ntot; ++it) {
        int key; float bias = 0.f;
        if (it < nloc) {
            if (NA) { const int kr = rs0 + (it >> 4), kc = ws0 + (it & 15); key = kr * 64 + kc; bias = rpb[(kr - r + 7) * 31 + min(max(kc - qc + 15, 0), 30)] * LOG2E; }
            else key = it;
        } else key = SEQ + (it - nloc);
        float s = bias;
#pragma unroll
        for (int c = 0; c < DK / 8; ++c) { const v4u w = *(const v4u*)(Kb + k_off(HK, DK, b, hk, key, 8 * c));
            s += q[8 * c] * bflo(w.x) + q[8 * c + 1] * bfhi(w.x) + q[8 * c + 2] * bflo(w.y) + q[8 * c + 3] * bfhi(w.y) + q[8 * c + 4] * bflo(w.z) + q[8 * c + 5] * bfhi(w.z) + q[8 * c + 6] * bflo(w.w) + q[8 * c + 7] * bfhi(w.w); }
        if (s > m) { const float a = exp2f(m - s); ls *= a;
#pragma unroll
            for (int d = 0; d < 64; ++d) o[d] *= a;
            m = s; }
        const float p = exp2f(s - m); ls += p;
        const bf16* vp = Vb + v_off(HV, b, hv, key, 0);
#pragma unroll
        for (int d = 0; d < 64; ++d) { o[d] += p * bf2f(vp[8 * d]); if ((d & 15) == 15) asm volatile("" ::: "memory"); }
    }
    const float inv = 1.f / ls;
#pragma unroll
    for (int d = 0; d < 64; ++d) o[d] *= inv;
}
__device__ __forceinline__ void store_mix(const Ctx& C, int b, int qi, int col0, const float (&o)[64]) {
    const size_t R = qi < SEQ ? (size_t)b * SEQ + qi : (size_t)ML + b * CTXL + (qi - SEQ);
    bf16* dst = ((bf16*)(wsp(C) + WS_MIX)) + R * DM + col0;
#pragma unroll
    for (int d = 0; d < 64; d += 8) { v4u w; w.x = pkc(o[d], o[d + 1]); w.y = pkc(o[d + 2], o[d + 3]); w.z = pkc(o[d + 4], o[d + 5]); w.w = pkc(o[d + 6], o[d + 7]); *(v4u*)(dst + d) = w; }
}
__device__ __forceinline__ void phase_attn_naive(const int wv, int l) {
    const Ctx C = make_ctx(wv);
    const bf16* Q = ((bf16*)(wsp(C) + WS_QKV));
    const int gt = C.gw * 64 + C.lane, NGT = C.NGW * 64;
    constexpr int PER = NB * 4 * NKEY;
    for (int idx = gt; idx < 5 * PER; idx += NGT) {
        const int mixer = idx < 3 * PER ? idx / PER : 3;
        const int r0 = mixer < 3 ? idx % PER : (idx - 3 * PER) >> 1, pair = idx & 1;
        const int b = r0 / (4 * NKEY), h = (r0 / NKEY) % 4, qi = r0 % NKEY;
        if (l == NL - 1 && qi >= SEQ) continue;
        float o[64];
        if (mixer == 0) { naive_attn_one<96, 4, 4, 4, false>(Q + E_QA, Q + E_KA, Q + E_VA, nullptr, b, h, h, h, qi, o); store_mix(C, b, qi, h * 64, o); }
        else if (mixer == 1) { naive_attn_one<64, 4, 4, 4, true>(Q + E_QN, Q + E_KN, Q + E_VN, inp(C, 24) + (size_t)(l * 4 + h) * 15 * 31, b, h, h, h, qi, o); store_mix(C, b, qi, 512 + h * 64, o); }
        else if (mixer == 2) { naive_attn_one<64, 4, 2, 2, false>(Q + E_QG, Q + E_KG, Q + E_VG, nullptr, b, h, h >> 1, h >> 1, qi, o); store_mix(C, b, qi, 768 + h * 64, o); }
        else {
            naive_attn_one<32, 8, 8, 4, false>(Q + E_QD, Q + E_KD, Q + E_VD, nullptr, b, 2 * h + pair, 2 * h + pair, h, qi, o);
            float s1 = 0.f, s2 = 0.f;
            for (int d = 0; d < 32; ++d) { s1 += inp(C, 17)[l * 32 + d] * inp(C, 18)[l * 32 + d]; s2 += inp(C, 19)[l * 32 + d] * inp(C, 20)[l * 32 + d]; }
            const float li = lambda_init(l), lam = expf(s1) - expf(s2) + li;
            float ss = 0.f;
#pragma unroll
            for (int d = 0; d < 64; ++d) { const float other = swz<1>(o[d]); o[d] = o[d] - lam * other; ss += o[d] * o[d]; }
            const float rs = rsq_f(ss * (1.f / 64.f) + EPS);
#pragma unroll
            for (int d = 0; d < 64; ++d) o[d] = o[d] * rs * inp(C, 21)[l * 64 + d] * (1.f - li);
            if (pair == 0) store_mix(C, b, qi, 256 + h * 64, o);
        }
    }
}

__device__ __forceinline__ void phase_fixup(const int wv, int l) {
    const Ctx C = make_ctx(wv);
    const int gt = C.gw * 64 + C.lane, NGT = C.NGW * 64;
    const float* cw = inp(C, 29) + (size_t)l * 3 * NUP; const float* cb = inp(C, 30) + (size_t)l * NUP;
    for (int idx = gt; idx < 56 * 2 * DFF; idx += NGT) {
        const int j = idx % DFF, w = (idx / DFF) & 1, bi = idx / (2 * DFF), pm = (bi / 7) * 8 + (bi % 7);
        const float* h0 = ((float*)(wsp(C) + WS_HALO)) + (size_t)pm * 4 * NUP; const float* h1 = h0 + 4 * NUP;
        float cva[2];
#pragma unroll
        for (int t = 0; t < 2; ++t) { const int c = t * DFF + j;
            const float up = w == 0 ? h0[2 * NUP + c] : h0[3 * NUP + c], uc = w == 0 ? h0[3 * NUP + c] : h1[c], un = w == 0 ? h1[c] : h1[NUP + c];
            cva[t] = cw[c] * up + cw[NUP + c] * uc + cw[2 * NUP + c] * un + cb[c]; }
        const size_t row = (size_t)pm * 256 + 255 + w;
        ((bf16*)(wsp(C) + WS_ACT))[row * DFF + j] = (bf16)f2bf(pg8::silu1(cva[1]) * cva[0]);
    }
}

#ifndef ATT_KNOB
#define ATT_KNOB 0
#endif
#if ATT_KNOB == 1
#define ATT_SB() do { if (NP == 2) __builtin_amdgcn_sched_barrier(0); } while (0)
#define ATT_PRIO(x) __builtin_amdgcn_s_setprio(x)
#elif ATT_KNOB == 2
#define ATT_SB() __builtin_amdgcn_sched_barrier(0)
#define ATT_PRIO(x) do {} while (0)
#else
#define ATT_SB() __builtin_amdgcn_sched_barrier(0)
#define ATT_PRIO(x) __builtin_amdgcn_s_setprio(x)
#endif
namespace att {
typedef float f32x16 __attribute__((ext_vector_type(16)));
typedef __bf16 bf16x2_t __attribute__((ext_vector_type(2)));
__device__ __forceinline__ unsigned cvtpk(float lo, float hi) { f32x2v v = {lo, hi}; bf16x2_t b = __builtin_convertvector(v, bf16x2_t); return __builtin_bit_cast(unsigned, b); }
__device__ __forceinline__ int crow(int r, int hi) { return (r & 3) + 8 * (r >> 2) + 4 * hi; }
constexpr int BUF0 = 0, BUFSZ = 20480, WSC = 4 * BUFSZ  , WSCSZ = 4224, RPB = WSC + 8 * WSCSZ  , RPB_TAB = RPB + 512;
static_assert(RPB_TAB + 15 * 31 * 4 + 1024 <= RING_BYTES, "attention LDS map");

struct UnitDesc { int b, hq0, hk0, hv, q0, t_lo, n_loc, col0; };

template <int DK, int NP, bool NA>
__device__ __forceinline__ void attn_unit(const Ctx& C, const bf16* Qb, int HQ, const bf16* Kb, int HK, const bf16* Vb, int HV, const UnitDesc U, const float Mb,
                                          const float* rpb  , const float lam, const float* subg, const float osc, bf16* MIX) {
    constexpr int KS = DK / 16;
    constexpr int KP = NP * DK * 8;
    constexpr int NLD = (KP + 512 + 511) / 512;
    const int lane = C.lane, wave = C.wave, tid = C.tid, c31 = lane & 31, hi = lane >> 5;
    LAS unsigned char* L = C.lds;
    const int n_it = U.n_loc + 4;
    constexpr int NI = (KP + 512) / 64;
    auto tile_of = [&](int it) { return it < U.n_loc ? U.t_lo + it : 32 + (it - U.n_loc); };
    const int n_st = (n_it + 1) >> 1;
#define ATT_ISSUE(st) do { _Pragma("unroll") for (int tt_ = 0; tt_ < 2; ++tt_) { const int it_ = 2 * (st) + tt_; if (it_ < n_it) { const int tile_ = tile_of(it_); \
        const unsigned dst_ = (unsigned)(((st) & 1) * 2 + tt_) * BUFSZ; \
        _Pragma("unroll") for (int j_ = 0; j_ < (NI + 7) / 8; ++j_) { const int ji = wave + 8 * j_; if (ji < NI) { const int pi = ji * 64 + lane; const bf16* src; \
            if (ji * 64 < KP) { const int ps = (ji * 64) / (DK * 8), pr = pi - ps * (DK * 8); src = Kb + ((size_t)((U.b * HK + U.hk0 + ps) * NKT + tile_)) * (DK * 64) + pr * 8; } \
            else src = Vb + ((size_t)((U.b * HV + U.hv) * NKT + tile_)) * 4096 + (pi - KP) * 8; \
            __builtin_amdgcn_global_load_lds((const unsigned*)src, (LAS unsigned*)(L + dst_ + ji * 1024), 16, 0, 0); } } } } } while (0)
    ATT_ISSUE(0);
    bf16x8 qf[NP][KS];
    const int qrow = U.q0 + wave * 32 + c31;
#pragma unroll
    for (int p = 0; p < NP; ++p) { const bf16* qp = Qb + q_off(HQ, DK, U.b, U.hq0 + p, qrow) + 8 * hi;
#pragma unroll
        for (int ks = 0; ks < KS; ++ks) qf[p][ks] = *(const bf16x8*)(qp + 16 * ks); }
    int my_lo = 0, my_r = 0;
    if (NA) {
        for (int i = tid; i < 15 * 31; i += 512) ((LAS float*)(L + RPB_TAB))[i] = rpb[i] * LOG2E;
        my_r = (U.q0 >> 6) + (wave >> 1); my_lo = min(max(my_r - 4, 0), 24);
    }
    f32x16 o[NP][2]; f32x16 lacc[NP];
    const bf16x8 ones = {0x3f80, 0x3f80, 0x3f80, 0x3f80, 0x3f80, 0x3f80, 0x3f80, 0x3f80};
#pragma unroll
    for (int p = 0; p < NP; ++p) {
#pragma unroll
        for (int r = 0; r < 16; ++r) lacc[p][r] = 0.f;
#pragma unroll
        for (int d0 = 0; d0 < 2; ++d0)
#pragma unroll
            for (int r = 0; r < 16; ++r) o[p][d0][r] = 0.f; }
    const float shift = Mb > 40.f ? Mb - 40.f : 0.f;
#define ATT_KLOAD(KF_, KB_) do { _Pragma("unroll") for (int p_ = 0; p_ < NP; ++p_) _Pragma("unroll") for (int ks_ = 0; ks_ < KS; ++ks_) { \
        KF_[p_][2 * ks_] = *(const LAS bf16x8*)((KB_) + p_ * (DK * 128) + (2 * ks_ + hi) * 1024 + c31 * 16); \
        KF_[p_][2 * ks_ + 1] = *(const LAS bf16x8*)((KB_) + p_ * (DK * 128) + (2 * ks_ + hi) * 1024 + 512 + c31 * 16); } } while (0)
#define ATT_TILE(KF_, KB_, TILE_, LOCAL_, PF_) do { \
        const LAS unsigned char* vb_ = (KB_) + KP * 16; bf16x8 vf[8]; \
        _Pragma("unroll") for (int p = 0; p < NP; ++p) { \
            f32x16 p0, p1; \
            _Pragma("unroll") for (int r = 0; r < 16; ++r) { p0[r] = 0.f; p1[r] = 0.f; } \
            ATT_SB(); ATT_PRIO(1); \
            _Pragma("unroll") for (int ks = 0; ks < KS; ++ks) { \
                p0 = __builtin_amdgcn_mfma_f32_32x32x16_bf16(KF_[p][2 * ks], qf[p][ks], p0, 0, 0, 0); \
                p1 = __builtin_amdgcn_mfma_f32_32x32x16_bf16(KF_[p][2 * ks + 1], qf[p][ks], p1, 0, 0, 0); } \
            ATT_PRIO(0); ATT_SB(); \
            if (p == 0) { _Pragma("unroll") for (int s_ = 0; s_ < 4; ++s_) _Pragma("unroll") for (int d0 = 0; d0 < 2; ++d0) vf[2 * s_ + d0] = *(const LAS bf16x8*)(vb_ + ((2 * s_ + hi) * 64 + 32 * d0 + c31) * 16); } \
            if (p == NP - 1) { PF_; } \
            ATT_SB(); \
            if (shift > 0.f) { _Pragma("unroll") for (int r = 0; r < 16; ++r) { p0[r] -= shift; p1[r] -= shift; } } \
            if (LOCAL_) { \
                const int qc = (wave & 1) * 32 + c31, ws = min(max(qc - 8, 0), 48); \
                const LAS float* bt = (const LAS float*)(L + RPB_TAB) + ((TILE_) - my_r + 7) * 31 + 15 - qc + 4 * hi; \
                const int kb0 = 4 * hi - ws; \
                _Pragma("unroll") for (int r = 0; r < 16; ++r) { const int kc = (r & 3) + 8 * (r >> 2); \
                    const float b0 = bt[kc], b1 = bt[kc + 32]; \
                    p0[r] = ((unsigned)(kc + kb0) < 16u) ? __builtin_amdgcn_exp2f(p0[r] + b0) : 0.f; \
                    p1[r] = ((unsigned)(kc + 32 + kb0) < 16u) ? __builtin_amdgcn_exp2f(p1[r] + b1) : 0.f; } \
            } else { \
                _Pragma("unroll") for (int r = 0; r < 16; ++r) { p0[r] = __builtin_amdgcn_exp2f(p0[r]); p1[r] = __builtin_amdgcn_exp2f(p1[r]); } \
            } \
            v4u pa[4]; \
            pa[0].x = cvtpk(p0[0], p0[1]); pa[0].y = cvtpk(p0[2], p0[3]); pa[0].z = cvtpk(p0[4], p0[5]); pa[0].w = cvtpk(p0[6], p0[7]); \
            pa[1].x = cvtpk(p0[8], p0[9]); pa[1].y = cvtpk(p0[10], p0[11]); pa[1].z = cvtpk(p0[12], p0[13]); pa[1].w = cvtpk(p0[14], p0[15]); \
            pa[2].x = cvtpk(p1[0], p1[1]); pa[2].y = cvtpk(p1[2], p1[3]); pa[2].z = cvtpk(p1[4], p1[5]); pa[2].w = cvtpk(p1[6], p1[7]); \
            pa[3].x = cvtpk(p1[8], p1[9]); pa[3].y = cvtpk(p1[10], p1[11]); pa[3].z = cvtpk(p1[12], p1[13]); pa[3].w = cvtpk(p1[14], p1[15]); \
            ATT_SB(); ATT_PRIO(1); \
            _Pragma("unroll") for (int s_ = 0; s_ < 4; ++s_) { _Pragma("unroll") for (int d0 = 0; d0 < 2; ++d0) \
                o[p][d0] = __builtin_amdgcn_mfma_f32_32x32x16_bf16(__builtin_bit_cast(bf16x8, pa[s_]), vf[2 * s_ + d0], o[p][d0], 0, 0, 0); \
                lacc[p] = __builtin_amdgcn_mfma_f32_32x32x16_bf16(__builtin_bit_cast(bf16x8, pa[s_]), ones, lacc[p], 0, 0, 0); } \
            ATT_PRIO(0); ATT_SB(); \
        } } while (0)
    asm volatile("s_waitcnt vmcnt(0)" ::: "memory"); __syncthreads();
    bf16x8 kfA[NP][2 * KS], kfB[NP][2 * KS];
    for (int st = 0; st < n_st; ++st) {
        if (st + 1 < n_st) ATT_ISSUE(st + 1);
        const int it0 = 2 * st, it1 = it0 + 1;
        const int tile0 = tile_of(it0), tile1 = tile_of(it1);
        const bool has1 = it1 < n_it;
        const bool loc0 = NA && it0 < U.n_loc, loc1 = NA && it1 < U.n_loc;
        const bool act0 = !loc0 || (tile0 >= my_lo && tile0 < my_lo + 8), act1 = has1 && (!loc1 || (tile1 >= my_lo && tile1 < my_lo + 8));
        const LAS unsigned char* kb0p = L + ((st & 1) * 2) * BUFSZ; const LAS unsigned char* kb1p = kb0p + BUFSZ;
        if (act0) {
            ATT_KLOAD(kfA, kb0p);
            if (NP == 1) { ATT_TILE(kfA, kb0p, tile0, loc0, if (act1) ATT_KLOAD(kfB, kb1p)); }
            else { ATT_TILE(kfA, kb0p, tile0, loc0, (void)0); }
        }
        if (act1) {
            if (NP != 1 || !act0) ATT_KLOAD(kfB, kb1p);
            ATT_TILE(kfB, kb1p, tile1, loc1, (void)0);
        }
        asm volatile("s_waitcnt vmcnt(0)" ::: "memory"); __syncthreads();
    }
#undef ATT_TILE
#undef ATT_KLOAD
#undef ATT_ISSUE
    LAS float* lsc = (LAS float*)(L + WSC + wave * WSCSZ);
    LAS unsigned short* ost = (LAS unsigned short*)(L + WSC + wave * WSCSZ + 128);
#pragma unroll
    for (int p = 0; p < NP; ++p) {
#pragma unroll
        for (int r = 0; r < 16; ++r) { const float iv = __builtin_amdgcn_rcpf(lacc[p][r]); o[p][0][r] *= iv; o[p][1][r] *= iv; }
        __builtin_amdgcn_sched_barrier(0);
    }
    f32x16 (&res)[2] = o[0];
    if (NP == 2) {
        const float g0 = subg[c31] * osc, g1 = subg[32 + c31] * osc;
#pragma unroll
        for (int r = 0; r < 16; ++r) { res[0][r] -= lam * o[NP - 1][0][r]; res[1][r] -= lam * o[NP - 1][1][r];
            float ss = res[0][r] * res[0][r] + res[1][r] * res[1][r];
            ss += swz<1>(ss); ss += swz<2>(ss); ss += swz<4>(ss); ss += swz<8>(ss); ss += swz<16>(ss);
            const float rs = rsq_f(ss * (1.f / 64.f) + EPS); res[0][r] *= rs * g0; res[1][r] *= rs * g1; }
    }
#pragma unroll
    for (int r = 0; r < 16; ++r)
#pragma unroll
        for (int d0 = 0; d0 < 2; ++d0) ost[crow(r, hi) * 64 + d0 * 32 + c31] = (unsigned short)pkc1(res[d0][r]);
    LDS_WAIT(); asm volatile("" ::: "memory");
    {
        const int qw = U.q0 + wave * 32;
        const size_t R0 = qw < SEQ ? (size_t)U.b * SEQ + qw : (size_t)ML + U.b * CTXL + (qw - SEQ);
#pragma unroll
        for (int i = 0; i < 4; ++i) { const int row = i * 8 + (lane >> 3), ch = lane & 7;
            const v4u v = *(const LAS v4u*)(ost + row * 64 + ch * 8);
            *(GAS v4u*)(MIX + (R0 + row) * DM + U.col0 + ch * 8) = v; }
    }
    LDS_WAIT(); asm volatile("" ::: "memory");
    __syncthreads();
}
}

__device__ __forceinline__ float maxabs_n(const float* g, int n, int lane) { float m = 0.f; for (int i = lane; i < n; i += 64) m = fmaxf(m, fabsf(g[i]));
    m = fmaxf(m, swz<1>(m)); m = fmaxf(m, swz<2>(m)); m = fmaxf(m, swz<4>(m)); m = fmaxf(m, swz<8>(m)); m = fmaxf(m, swz<16>(m)); return max32(m); }

template <int TY>
__device__ __forceinline__ void phase_attn_ty(const int wv, int l) {
    const Ctx C = make_ctx(wv);
    const bf16* Q = ((const bf16*)(wsp(C) + WS_QKV)); bf16* MIX = (bf16*)(wsp(C) + WS_MIX);
    const int NUT = (l == NL - 1) ? 256 : 384;
    const int vcu = C.gw >> 3;
    float Mb, lam = 0.f, osc = 1.f; const float* subg = nullptr;
    if (TY == 0) { Mb = LOG2E * 5.656854249492381f * maxabs_n(inp(C, 15) + l * 32, 32, C.lane) * maxabs_n(inp(C, 16) + l * 32, 32, C.lane);
        float s1 = 0.f, s2 = 0.f;
        for (int d = 0; d < 32; ++d) { s1 += inp(C, 17)[l * 32 + d] * inp(C, 18)[l * 32 + d]; s2 += inp(C, 19)[l * 32 + d] * inp(C, 20)[l * 32 + d]; }
        const float li = lambda_init(l); lam = expf(s1) - expf(s2) + li; osc = 1.f - li; subg = inp(C, 21) + l * 64; }
    else if (TY == 1) Mb = LOG2E * 9.797958971132712f * maxabs_n(inp(C, 13) + l * 96, 96, C.lane) * maxabs_n(inp(C, 14) + l * 96, 96, C.lane);
    else if (TY == 2) Mb = LOG2E * 8.f * maxabs_n(inp(C, 25) + l * 64, 64, C.lane) * maxabs_n(inp(C, 26) + l * 64, 64, C.lane);
    else Mb = LOG2E * 8.f * maxabs_n(inp(C, 22) + l * 64, 64, C.lane) * maxabs_n(inp(C, 23) + l * 64, 64, C.lane) + LOG2E * maxabs_n(inp(C, 24) + (size_t)l * 4 * 15 * 31, 4 * 15 * 31, C.lane);
    Mb = __uint_as_float(__builtin_amdgcn_readfirstlane(__float_as_uint(Mb)));
    for (int uu = vcu; uu < NUT; uu += C.G) {
        att::UnitDesc U; int h;
        if (uu < 256) { h = (uu >> 3) & 3; U.b = uu >> 5; U.q0 = (uu & 7) * 256; U.t_lo = 0; U.n_loc = 32; }
        else { const int i_ = uu - 256; if ((i_ >> 5) != TY) continue; h = i_ & 3; U.b = (i_ >> 2) & 7; U.q0 = SEQ; U.t_lo = 32; U.n_loc = 0; }
        if (TY == 0) { U.hq0 = 2 * h; U.hk0 = 2 * h; U.hv = h; U.col0 = 256 + 64 * h; att::attn_unit<32, 2, false>(C, Q + E_QD, 8, Q + E_KD, 8, Q + E_VD, 4, U, Mb, nullptr, lam, subg, osc, MIX); }
        else if (TY == 1) { U.hq0 = h; U.hk0 = h; U.hv = h; U.col0 = 64 * h; att::attn_unit<96, 1, false>(C, Q + E_QA, 4, Q + E_KA, 4, Q + E_VA, 4, U, Mb, nullptr, 0.f, nullptr, 1.f, MIX); }
        else if (TY == 2) { U.hq0 = h; U.hk0 = h >> 1; U.hv = h >> 1; U.col0 = 768 + 64 * h; att::attn_unit<64, 1, false>(C, Q + E_QG, 4, Q + E_KG, 2, Q + E_VG, 2, U, Mb, nullptr, 0.f, nullptr, 1.f, MIX); }
        else { if (uu < 256) { const int r0 = U.q0 >> 6; U.t_lo = min(max(r0 - 4, 0), 24); U.n_loc = min(max(r0 - 1, 0), 24) + 8 - U.t_lo; }
            U.hq0 = h; U.hk0 = h; U.hv = h; U.col0 = 512 + 64 * h; att::attn_unit<64, 1, true>(C, Q + E_QN, 4, Q + E_KN, 4, Q + E_VN, 4, U, Mb, inp(C, 24) + (size_t)(l * 4 + h) * 15 * 31, 0.f, nullptr, 1.f, MIX); }
    }
}
__device__ __forceinline__ void phase_attn(const int wv, int l) { phase_attn_ty<0>(wv, l); phase_attn_ty<1>(wv, l); phase_attn_ty<2>(wv, l); phase_attn_ty<3>(wv, l); }

#ifndef ATTN_NAIVE
#define ATTN_NAIVE 0
#endif
#ifndef PROBE_REP_S
#define PROBE_REP_S -1
#endif
#ifndef PROBE_DRY7
#define PROBE_DRY7 0
#endif
#ifndef PROBE_PRO
#define PROBE_PRO 0
#endif
#ifndef MK_PER_PHASE
#define MK_PER_PHASE 0
#endif
constexpr int PH_PRO = 0, PH_NORM0 = 1, PH_L0 = 2, PH_PER_LAYER = 11 + (PROBE_REP_S >= 0 ? 1 : 0);
constexpr int N_PHASES = PH_L0 + NL * PH_PER_LAYER - 1;
struct Args { const float* in[32]; float* out; unsigned char* ws; int ph_lo, ph_hi; };

__global__ void __launch_bounds__(NWAVES * 64, 2) fwd_kernel(Args args) {
    const int wv = __builtin_amdgcn_readfirstlane((int)threadIdx.x >> 6);
    const Ctx C = make_ctx(wv);
    for (int u = C.tid; u < 1024 / 4; u += NWAVES * 64) ((LAS unsigned*)(C.lds + LDSCTL_OFF))[u] = 0u;
    __syncthreads();
    if (C.tid < 34) ((LAS unsigned long long*)(C.lds + PT_OFF))[C.tid] = ((const __attribute__((address_space(4))) unsigned long long*)__builtin_amdgcn_kernarg_segment_ptr())[C.tid];
    volatile LAS unsigned* MISC = (volatile LAS unsigned*)(C.lds + MISC_OFF);
    __syncthreads();
    gu32* ctl = (gu32*)(wsp(C) + WS_CTL);
    XcdBarrier bar; bar.bar = (unsigned*)(ctl + CW_BAR); bar.x = 0; bar.st = nullptr; bar.wv = wv;
    const bool multi = (args.ph_hi - args.ph_lo) > 1;
    if (multi) { bar = xcd_barrier_post((unsigned*)(ctl + CW_BAR), MISC + 8); bar.wv = wv; }

    for (int ph = args.ph_lo; ph < args.ph_hi; ++ph) {
        const Ctx C = make_ctx(wv);
        if (ph == PH_PRO) { phase_prologue(wv);
#if PROBE_PRO
            __syncthreads(); phase_prologue(wv);
#endif
        }
        else if (ph == PH_NORM0) phase_norm(wv, 0, 1, MT);
        else {
            const int l = (ph - PH_L0) / PH_PER_LAYER, s_raw = (ph - PH_L0) % PH_PER_LAYER, s = (PROBE_REP_S >= 0 && s_raw > PROBE_REP_S) ? s_raw - 1 : s_raw;
            const int Mrows = (l == NL - 1) ? ML : MT;
            {
            if (s == 0 || s == 2) {
                const bool mla = s == 2;
                pg8::Gemm g{mla ? (bf16*)(wsp(C) + WS_CQKV) : (bf16*)(wsp(C) + WS_XN), wptr(C, l, mla ? W_MLA : W_IN), MT, mla ? NMLA : NINP, mla ? KMLA : DM}; pg8::StaticOrder S; S.init(MT, mla ? NMLA : NINP, C.G, (int)blockIdx.x);
                pg8::EpiBf16<0> E{mla ? (bf16*)(wsp(C) + WS_MLAP) : (bf16*)(wsp(C) + WS_P), mla ? NMLA : NINP, nullptr, 0, 0, 1.f};
                pg8::gemm_phase<pg8::EpiBf16<0>, pg8::StaticOrder, true, true>(C.lds + RING_OFF, g, S, E, C.wave);
            } else if (s == 1) phase_prep1(wv, l);
            else if (s == 3) phase_prep2(wv, l);
#if ATTN_NAIVE
            else if (s == 4) phase_attn_naive(wv, l);
#else
            else if (s == 4) phase_attn(wv, l);
#endif
            else if (s == 5 || s == 9) {
                const bool dn = s == 9;
                pg8::Gemm g{dn ? (bf16*)(wsp(C) + WS_ACT) : (bf16*)(wsp(C) + WS_MIX), wptr(C, l, dn ? W_DOWN : W_OUT), Mrows, DM, dn ? DFF : DM}; pg8::SplitOrder S; S.init(C.G, (int)blockIdx.x, l != NL - 1, dn ? DFF / 64 : DM / 64);
                const bool first = (l == 0 && !dn);
                pg8::EpiResGate E{first ? inp(C, 0) : outp(C), first ? inp(C, 2) : (float*)(wsp(C) + WS_XC), outp(C), (float*)(wsp(C) + WS_XC), (float*)(wsp(C) + WS_MODS) + (size_t)l * 9 * 6144 + (dn ? 5120 : 2048), (float*)(wsp(C) + WS_SLAB), (PROBE_REP_S >= 0 && s_raw == PROBE_REP_S) ? 1 : 0};
                pg8::gemm_phase<pg8::EpiResGate, pg8::SplitOrder, true, true>(C.lds + RING_OFF, g, S, E, C.wave);
            } else if (s == 6) phase_norm(wv, l, 2, Mrows);
            else if (s == 7) {
                pg8::Gemm g{(bf16*)(wsp(C) + WS_XN), wptr(C, l, W_UP), Mrows, NUP, DM}; pg8::StaticOrder S; S.init(Mrows, NUP, C.G, (int)blockIdx.x);
                pg8::EpiConvGate E{(bf16*)(wsp(C) + WS_ACT), (float*)(wsp(C) + WS_HALO), inp(C, 29) + (size_t)l * 3 * NUP, inp(C, 30) + (size_t)l * NUP, (PG8_LAS float*)(C.lds + EX_OFF), (PROBE_DRY7 && s_raw == PROBE_REP_S) ? 1 : 0};
                pg8::gemm_phase<pg8::EpiConvGate, pg8::StaticOrder, true, true>(C.lds + RING_OFF, g, S, E, C.wave);
            } else if (s == 8) phase_fixup(wv, l);
            else phase_norm(wv, l + 1, 1, MT);
            }
        }
        if (ph + 1 < args.ph_hi) { XcdBarrier bb = bar; asm volatile("" : "+s"(bb.bar), "+s"(bb.x)); xcd_barrier(bb); }
    }
}

extern "C" void kernel_launch(void* const* d_in, const int* in_sizes, int n_in, void* d_out, int out_size, void* d_ws, size_t ws_size, hipStream_t stream) {
    static int grid = 0;
    if (grid == 0) {
        if (n_in != 32 || out_size != ML * DM || ws_size < WS_END) { fprintf(stderr, "kernel_launch: unexpected shapes (n_in %d out %d ws %zu)\n", n_in, out_size, ws_size); grid = -1; return; }
        int dev = 0, cus = 0;
        if (hipGetDevice(&dev) != hipSuccess || hipDeviceGetAttribute(&cus, hipDeviceAttributeMultiprocessorCount, dev) != hipSuccess) { grid = -1; return; }
        if (hipFuncSetAttribute((const void*)fwd_kernel, hipFuncAttributeMaxDynamicSharedMemorySize, LDS_BYTES) != hipSuccess) { fprintf(stderr, "kernel_launch: hipFuncSetAttribute failed\n"); grid = -1; return; }
        (void)hipGetLastError();
        grid = cus;
    }
    if (grid < 0) return;
    (void)hipMemsetAsync((char*)d_ws + WS_CTL, 0, CTL_ZERO_BYTES, stream);
    Args a{};
    for (int i = 0; i < 32; ++i) a.in[i] = (const float*)d_in[i];
    a.out = (float*)d_out; a.ws = (unsigned char*)d_ws;
#if MK_PER_PHASE
    for (int ph = 0; ph < N_PHASES; ++ph) { a.ph_lo = ph; a.ph_hi = ph + 1; hipLaunchKernelGGL(fwd_kernel, dim3(grid), dim3(NWAVES * 64), LDS_BYTES, stream, a); }
#else
    a.ph_lo = 0; a.ph_hi = N_PHASES; hipLaunchKernelGGL(fwd_kernel, dim3(grid), dim3(NWAVES * 64), LDS_BYTES, stream, a);
#endif
}
```
